# Optimizing an MI355X kernel written in HIP

```python
import jax, jax.numpy as jnp
from jax import lax
import numpy as np

D_MODEL = 1024
BATCH = 2
SEQ = 8192
DEPTH = 2

EPS = 1e-6
NEG_INF = -1e30
CHUNK = 128
A_GROUPS = 4
A_WIDTH = D_MODEL
A_GROUP_DIM = A_WIDTH // A_GROUPS
B_WIDTH = D_MODEL
POOL_WINDOWS = (2, 4, 8, 16)
B_GROUPS = len(POOL_WINDOWS)
B_GROUP_DIM = B_WIDTH // B_GROUPS
MIX0_IN = 3 * A_WIDTH + 2 * B_WIDTH
MIX0_OUT = A_WIDTH + B_WIDTH
N_HEADS = 16
N_KV_HEADS = 4
HEAD_DIM = 64
GQA_GROUP = N_HEADS // N_KV_HEADS
C_WIDTH = N_HEADS * HEAD_DIM
KV_WIDTH = N_KV_HEADS * HEAD_DIM
MIX1_IN = 2 * C_WIDTH + 2 * KV_WIDTH
WINDOW = 128
ATTN_BLOCK = 128
ROPE_THETA = 500000.0
ROT_DIM = HEAD_DIM // 4

kernel_name = "hybrid_gmlp_pool_swa_encoder"


def rms_norm(x, g):
    xf = x.astype(jnp.float32)
    y = xf * lax.rsqrt(jnp.mean(xf * xf, axis=-1, keepdims=True) + EPS)
    return (y * g.astype(jnp.float32)).astype(x.dtype)


def spatial_gating_mixer(u, v, w_s, b_s, g_v):
    bn, s, _ = u.shape
    u = jax.nn.gelu(u)
    v = rms_norm(jax.nn.gelu(v), g_v)
    v = v.reshape(bn, s // CHUNK, CHUNK, A_GROUPS, A_GROUP_DIM)
    mixed = jnp.einsum('hij,bcjhd->bcihd', w_s, v) + b_s.T[None, None, :, :, None]
    return u * mixed.reshape(bn, s, A_WIDTH)


def multiscale_pool_mixer(xb, w_g, scale):
    bn, s, _ = xb.shape
    xf = xb.astype(jnp.float32)
    cs = jnp.concatenate([jnp.zeros((bn, 1, B_WIDTH), jnp.float32), lax.cumsum(xf, axis=1)], axis=1)
    t = jnp.arange(s)
    outs = []
    for gi, w in enumerate(POOL_WINDOWS):
        lo = jnp.clip(t - w // 2, 0, s)
        hi = jnp.clip(t + w // 2, 0, s)
        sl = slice(gi * B_GROUP_DIM, (gi + 1) * B_GROUP_DIM)
        csg = cs[:, :, sl]
        win_sum = jnp.take(csg, hi, axis=1) - jnp.take(csg, lo, axis=1)
        mean = win_sum / (hi - lo).astype(jnp.float32)[None, :, None]
        outs.append(mean - xf[:, :, sl])
    p = jnp.stack(outs, axis=2).astype(xb.dtype)
    y = jnp.einsum('bsgd,gde->bsge', p, w_g).reshape(bn, s, B_WIDTH)
    return y * scale


def partial_rope(x, pos):
    inv = ROPE_THETA ** (-jnp.arange(0, ROT_DIM, 2, dtype=jnp.float32) / ROT_DIM)
    ang = pos.astype(jnp.float32)[:, None] * inv[None, :]
    cos = jnp.cos(ang)[None, :, None, :]
    sin = jnp.sin(ang)[None, :, None, :]
    xr = x[..., :ROT_DIM].astype(jnp.float32)
    x1, x2 = xr[..., :ROT_DIM // 2], xr[..., ROT_DIM // 2:]
    rot = jnp.concatenate([x1 * cos - x2 * sin, x2 * cos + x1 * sin], axis=-1)
    return jnp.concatenate([rot.astype(x.dtype), x[..., ROT_DIM:]], axis=-1)


def windowed_gqa(q, k, v, sink):
    bn, s = q.shape[:2]
    nb = s // ATTN_BLOCK
    qb = q.reshape(bn, nb, ATTN_BLOCK, N_KV_HEADS, GQA_GROUP, HEAD_DIM)

    def band(t):
        tp = jnp.pad(t, ((0, 0), (ATTN_BLOCK, ATTN_BLOCK), (0, 0), (0, 0)))
        tp = tp.reshape(bn, nb + 2, ATTN_BLOCK, N_KV_HEADS, HEAD_DIM)
        return jnp.concatenate([tp[:, :nb], tp[:, 1:nb + 1], tp[:, 2:]], axis=2)

    kb, vb = band(k), band(v)
    scores = jnp.einsum('bnqkgd,bnskd->bnkgqs', qb, kb).astype(jnp.float32) * (HEAD_DIM ** -0.5)
    qi = jnp.arange(nb)[:, None, None] * ATTN_BLOCK + jnp.arange(ATTN_BLOCK)[None, :, None]
    kj = (jnp.arange(nb)[:, None, None] - 1) * ATTN_BLOCK + jnp.arange(3 * ATTN_BLOCK)[None, None, :]
    allowed = (jnp.abs(qi - kj) <= WINDOW) & (kj >= 0) & (kj < s)
    scores = jnp.where(allowed[None, :, None, None], scores, NEG_INF)
    sink_col = jnp.broadcast_to(sink.astype(jnp.float32).reshape(1, 1, N_KV_HEADS, GQA_GROUP, 1, 1),
                                scores.shape[:-1] + (1,))
    probs = jax.nn.softmax(jnp.concatenate([scores, sink_col], axis=-1), axis=-1)[..., :-1]
    out = jnp.einsum('bnkgqs,bnskd->bnqkgd', probs.astype(v.dtype), vb)
    return out.reshape(bn, s, C_WIDTH)


def setup_inputs(seed: int = 0) -> dict:
    key = jax.random.key(seed)
    ks = jax.random.split(key, 16)
    f32 = jnp.float32
    nrm = lambda k, shp, sc: jax.random.normal(k, shp, f32) * sc
    return {
        "x": nrm(ks[0], (BATCH, SEQ, D_MODEL), 1.0),
        "norm_0": 1.0 + nrm(ks[1], (D_MODEL,), 0.05),
        "w_in_0": nrm(ks[2], (D_MODEL, MIX0_IN), D_MODEL ** -0.5),
        "a_v_norm_0": 1.0 + nrm(ks[3], (A_WIDTH,), 0.05),
        "a_spatial_w_0": nrm(ks[4], (A_GROUPS, CHUNK, CHUNK), CHUNK ** -0.5),
        "a_spatial_b_0": 1.0 + nrm(ks[5], (A_GROUPS, CHUNK), 0.1),
        "b_group_w_0": nrm(ks[6], (B_GROUPS, B_GROUP_DIM, B_GROUP_DIM), B_GROUP_DIM ** -0.5),
        "b_scale_0": 1.0 + nrm(ks[7], (B_WIDTH,), 0.05),
        "w_out_0": nrm(ks[8], (MIX0_OUT, D_MODEL), MIX0_OUT ** -0.5),
        "norm_1": 1.0 + nrm(ks[9], (D_MODEL,), 0.05),
        "w_in_1": nrm(ks[10], (D_MODEL, MIX1_IN), D_MODEL ** -0.5),
        "sink_1": nrm(ks[11], (N_HEADS,), 0.5),
        "w_out_1": nrm(ks[12], (C_WIDTH, D_MODEL), C_WIDTH ** -0.5),
        "final_norm": 1.0 + nrm(ks[13], (D_MODEL,), 0.05),
    }


def reference(x, norm_0, w_in_0, a_v_norm_0, a_spatial_w_0, a_spatial_b_0, b_group_w_0, b_scale_0,
              w_out_0, norm_1, w_in_1, sink_1, w_out_1, final_norm):
    bn, s, _ = x.shape
    pos = jnp.arange(s)
    for layer in range(DEPTH):
        if layer % 2 == 0:
            h = rms_norm(x, norm_0)
            z = h @ w_in_0
            a_u, a_v, a_gate, b_x, b_gate = jnp.split(
                z, [A_WIDTH, 2 * A_WIDTH, 3 * A_WIDTH, 3 * A_WIDTH + B_WIDTH], axis=-1)
            ya = spatial_gating_mixer(a_u, a_v, a_spatial_w_0, a_spatial_b_0, a_v_norm_0) * jax.nn.silu(a_gate)
            yb = multiscale_pool_mixer(b_x, b_group_w_0, b_scale_0) * jax.nn.silu(b_gate)
            x = x + jnp.concatenate([ya, yb], axis=-1) @ w_out_0
        else:
            h = rms_norm(x, norm_1)
            z = h @ w_in_1
            q, k, v, gate = jnp.split(z, [C_WIDTH, C_WIDTH + KV_WIDTH, C_WIDTH + 2 * KV_WIDTH], axis=-1)
            q = partial_rope(q.reshape(bn, s, N_HEADS, HEAD_DIM), pos)
            k = partial_rope(k.reshape(bn, s, N_KV_HEADS, HEAD_DIM), pos)
            v = v.reshape(bn, s, N_KV_HEADS, HEAD_DIM)
            y = windowed_gqa(q, k, v, sink_1) * jax.nn.silu(gate)
            x = x + y @ w_out_1
    return rms_norm(x, final_norm)
```

```cpp
#include <hip/hip_runtime.h>
#include <hip/hip_cooperative_groups.h>
#include <cstdio>
#include <cstdint>
namespace cg = cooperative_groups;
namespace pg8 {
#define PG8_LAS __attribute__((address_space(3)))
typedef unsigned short bf16_t;
typedef short bf16x8 __attribute__((ext_vector_type(8)));
typedef float f32x4 __attribute__((ext_vector_type(4)));
typedef unsigned u32x4 __attribute__((ext_vector_type(4)));
constexpr int BM = 256, BK = 64, HALF = 128, HTB = HALF * BK * 2  , STAGE_BYTES = 8 * HTB, NXCD = 8, WGM = 8;

__host__ __device__ __forceinline__ int lds_byte(int r, int c) { const int st = (r >> 4) * 2 + (c >> 5), rr = r & 15, cc = c & 31, ob = rr * 64 + cc * 2; return st * 1024 + (ob ^ (((ob >> 9) & 1) << 5)); }
__host__ __device__ __forceinline__ void stage_rc(int b, int& R, int& C) { const int st = b / 1024, sb = b % 1024, swz = sb ^ (((sb >> 9) & 1) << 5); R = (st >> 1) * 16 + swz / 64; C = (st & 1) * 32 + (swz % 64) / 2; }
__host__ __device__ __forceinline__ int perm32(int rho) { const int n = rho >> 4, i = rho & 15; return 8 * (i >> 2) + 4 * n + (i & 3); }

struct Unit { int pm, pn; };
struct Gemm { const bf16_t* A; const bf16_t* Bt; int M, N, K; };

struct StaticOrder {
    int nM, nN, nwg, G, c;
    __host__ __device__ void init(int M, int N, int G_, int c_) { nM = M / BM; nN = N / BM; nwg = nM * nN; G = G_; c = c_; }
    __host__ __device__ bool next(int i, Unit& u) const {
        const long L = (long)i * G + c; if (L >= nwg) return false;
        int wgid = (int)L; { const int q = nwg / NXCD, r = nwg % NXCD, xcd = wgid % NXCD, off = wgid / NXCD; wgid = (xcd < r ? xcd * (q + 1) : r * (q + 1) + (xcd - r) * q) + off; }
        const int nig = WGM * nN, gid = wgid / nig, fm = gid * WGM, gsz = (nM - fm) < WGM ? (nM - fm) : WGM;
        u.pm = fm + ((wgid % nig) % gsz); u.pn = (wgid % nig) / gsz; return true;
    }
    __device__ __forceinline__ void a_ready(const Unit&) const {}
    __device__ __forceinline__ void done(const Unit&) const {}
};

__device__ __forceinline__ unsigned cvt_pk_bf16(float lo, float hi) { unsigned r; asm volatile("v_cvt_pk_bf16_f32 %0, %1, %2" : "=v"(r) : "v"(lo), "v"(hi)); return r; }
template <class Epi, class Sched, bool ALIGN_EPI = false, bool SP2 = false>
__device__ __forceinline__ void gemm_phase(PG8_LAS unsigned char* lds, const Gemm g, const Sched& S, const Epi& E) {
    int tid_ = threadIdx.x; asm volatile("" : "+v"(tid_));
    const int tid = tid_, wid = __builtin_amdgcn_readfirstlane(tid >> 6), lane = tid & 63, wr = wid >> 2, wc = wid & 3, fr = lane & 15, fq = lane >> 4;
    const int K = g.K, nt = K / BK;
    unsigned voffA[2], voffB[2];
#pragma unroll
    for (int i = 0; i < 2; ++i) { int R, C; stage_rc(tid * 16 + i * 8192, R, C); const int Rb = Epi::PERM ? ((R & ~31) + perm32(R & 31)) : R;
        voffA[i] = (unsigned)(R * K + C) * 2u; voffB[i] = (unsigned)(Rb * K + C) * 2u; }
    const size_t kstep = (size_t)(BK * 2);
    const size_t hstep = (size_t)HALF * K * 2;
    const size_t tstep = 2 * hstep;
    const unsigned ldsw = (unsigned)wid * 1024u;
    const int aoff = lds_byte(wr * 64 + fr, fq * 8), boff = lds_byte(wc * 32 + fr, fq * 8);
#define PG8_SA(b, h) (((b) * 2 + (h)) * HTB)
#define PG8_SB(b, h) ((4 + (b) * 2 + (h)) * HTB)
#define PG8_STAGE(bufoff, gbase, voff) do { _Pragma("unroll") for (int _i = 0; _i < 2; ++_i) \
        __builtin_amdgcn_global_load_lds((const unsigned*)((const char*)(gbase) + (voff)[_i]), (PG8_LAS unsigned*)(lds + (bufoff) + ldsw + _i * 8192), 16, 0, 0); } while (0)
#define PG8_LDA(dst, b, h) do { _Pragma("unroll") for (int m = 0; m < 4; ++m) _Pragma("unroll") for (int k = 0; k < 2; ++k) dst[m][k] = *(const PG8_LAS bf16x8*)(lds + PG8_SA(b, h) + aoff + m * 2048 + k * 1024); } while (0)
#define PG8_LDB(dst, b, h) do { _Pragma("unroll") for (int n = 0; n < 2; ++n) _Pragma("unroll") for (int k = 0; k < 2; ++k) dst[n][k] = *(const PG8_LAS bf16x8*)(lds + PG8_SB(b, h) + boff + n * 2048 + k * 1024); } while (0)
#define PG8_MMA(ai, bj, At, Bt) do { __builtin_amdgcn_s_setprio(1); _Pragma("unroll") for (int m = 0; m < 4; ++m) _Pragma("unroll") for (int n = 0; n < 2; ++n) _Pragma("unroll") for (int k = 0; k < 2; ++k) \
        acc[ai][bj][m][n] = __builtin_amdgcn_mfma_f32_16x16x32_bf16(Bt[n][k], At[m][k], acc[ai][bj][m][n], 0, 0, 0); __builtin_amdgcn_s_setprio(0); } while (0)
#define PG8_WAIT_V(n) asm volatile("s_waitcnt vmcnt(" #n ")" ::: "memory")
#define PG8_WAIT_L(n) asm volatile("s_waitcnt lgkmcnt(" #n ")" ::: "memory")
#define PG8_BAR __builtin_amdgcn_s_barrier()
#define PG8_SCHED __builtin_amdgcn_sched_barrier(0)
    Unit cur, nxt; int ui = 0;
    if (!S.next(0, cur)) return;
    f32x4 acc[2][2][4][2];
#pragma unroll
    for (int a = 0; a < 2; ++a)
#pragma unroll
        for (int b = 0; b < 2; ++b)
#pragma unroll
            for (int m = 0; m < 4; ++m)
#pragma unroll
                for (int n = 0; n < 2; ++n) acc[a][b][m][n] = (f32x4){0.f, 0.f, 0.f, 0.f};
    bf16x8 At[4][2], B0[2][2], B1[2][2];
    const char* cA = (const char*)g.A + (size_t)cur.pm * tstep; const char* cB = (const char*)g.Bt + (size_t)cur.pn * tstep;
    S.a_ready(cur);
    if constexpr (SP2) {
        PG8_STAGE(PG8_SB(0, 0), cB, voffB); PG8_STAGE(PG8_SB(0, 1), cB + hstep, voffB); PG8_STAGE(PG8_SA(0, 0), cA, voffA); PG8_STAGE(PG8_SA(0, 1), cA + hstep, voffA);
        if (wr == 1) PG8_BAR;
        PG8_WAIT_V(2); PG8_BAR;
        PG8_STAGE(PG8_SB(1, 0), cB + kstep, voffB); PG8_STAGE(PG8_SA(1, 0), cA + kstep, voffA); PG8_STAGE(PG8_SB(1, 1), cB + hstep + kstep, voffB);
        PG8_WAIT_V(6); PG8_BAR;
    } else {
        PG8_STAGE(PG8_SB(0, 0), cB, voffB); PG8_STAGE(PG8_SA(0, 0), cA, voffA); PG8_STAGE(PG8_SB(0, 1), cB + hstep, voffB); PG8_STAGE(PG8_SA(0, 1), cA + hstep, voffA);
        if (wr == 1) PG8_BAR;
        PG8_WAIT_V(4); PG8_BAR;
        PG8_STAGE(PG8_SB(1, 0), cB + kstep, voffB); PG8_STAGE(PG8_SA(1, 0), cA + kstep, voffA); PG8_STAGE(PG8_SB(1, 1), cB + hstep + kstep, voffB);
        PG8_WAIT_V(6); PG8_BAR;
    }
    for (;;) {
        const bool has_next = S.next(ui + 1, nxt);
        const char* nA = has_next ? (const char*)g.A + (size_t)nxt.pm * tstep : cA; const char* nB = has_next ? (const char*)g.Bt + (size_t)nxt.pn * tstep : cB;
        for (int t = 0; t < nt; t += 2) {
            const bool last = (t == nt - 2);
            const char* a1 = cA + (size_t)(t + 1) * kstep;
            const char* a2 = last ? nA : cA + (size_t)(t + 2) * kstep; const char* b2 = last ? nB : cB + (size_t)(t + 2) * kstep;
            const char* a3 = a2 + kstep; const char* b3 = b2 + kstep;
            if (last && has_next) S.a_ready(nxt);
            if constexpr (SP2) {
            PG8_LDB(B0, 0, 0); PG8_LDB(B1, 0, 1); PG8_SCHED; PG8_LDA(At, 0, 0); PG8_STAGE(PG8_SA(1, 1), a1 + hstep, voffA);
            PG8_WAIT_V(8); PG8_WAIT_L(0); PG8_BAR; PG8_MMA(0, 0, At, B0); PG8_MMA(0, 1, At, B1); PG8_BAR; PG8_SCHED;
            PG8_LDA(At, 0, 1); PG8_STAGE(PG8_SB(0, 0), b2, voffB); PG8_STAGE(PG8_SB(0, 1), b2 + hstep, voffB); PG8_STAGE(PG8_SA(0, 0), a2, voffA);
            PG8_WAIT_V(8); PG8_WAIT_L(0); PG8_BAR; PG8_MMA(1, 0, At, B0); PG8_MMA(1, 1, At, B1); PG8_BAR; PG8_SCHED;
            PG8_LDB(B0, 1, 0); PG8_LDB(B1, 1, 1); PG8_SCHED; PG8_LDA(At, 1, 0); PG8_STAGE(PG8_SA(0, 1), a2 + hstep, voffA);
            PG8_WAIT_V(8); PG8_WAIT_L(0); PG8_BAR; PG8_MMA(0, 0, At, B0); PG8_MMA(0, 1, At, B1); PG8_BAR; PG8_SCHED;
            PG8_LDA(At, 1, 1); PG8_STAGE(PG8_SB(1, 0), b3, voffB); PG8_STAGE(PG8_SB(1, 1), b3 + hstep, voffB); PG8_STAGE(PG8_SA(1, 0), a3, voffA);
            PG8_WAIT_V(8); PG8_WAIT_L(0); PG8_BAR; PG8_MMA(1, 0, At, B0); PG8_MMA(1, 1, At, B1); PG8_BAR; PG8_SCHED;
            } else {
            PG8_LDB(B0, 0, 0); PG8_SCHED; PG8_LDA(At, 0, 0); PG8_STAGE(PG8_SA(1, 1), a1 + hstep, voffA);
            PG8_WAIT_L(8); PG8_BAR; PG8_WAIT_L(0); PG8_MMA(0, 0, At, B0); PG8_BAR; PG8_SCHED;
            PG8_LDB(B1, 0, 1); PG8_STAGE(PG8_SB(0, 0), b2, voffB);
            PG8_BAR; PG8_WAIT_L(0); PG8_MMA(0, 1, At, B1); PG8_BAR;
            PG8_LDA(At, 0, 1); PG8_STAGE(PG8_SA(0, 0), a2, voffA);
            PG8_BAR; PG8_WAIT_L(0); PG8_MMA(1, 0, At, B0); PG8_BAR; PG8_SCHED;
            PG8_STAGE(PG8_SB(0, 1), b2 + hstep, voffB);
            PG8_WAIT_V(6); PG8_BAR; PG8_MMA(1, 1, At, B1); PG8_BAR;
            PG8_LDB(B0, 1, 0); PG8_SCHED; PG8_LDA(At, 1, 0); PG8_STAGE(PG8_SA(0, 1), a2 + hstep, voffA);
            PG8_WAIT_L(8); PG8_BAR; PG8_WAIT_L(0); PG8_MMA(0, 0, At, B0); PG8_BAR; PG8_SCHED;
            PG8_LDB(B1, 1, 1); PG8_STAGE(PG8_SB(1, 0), b3, voffB);
            PG8_BAR; PG8_WAIT_L(0); PG8_MMA(0, 1, At, B1); PG8_BAR;
            PG8_LDA(At, 1, 1); PG8_STAGE(PG8_SA(1, 0), a3, voffA);
            PG8_BAR; PG8_WAIT_L(0); PG8_MMA(1, 0, At, B0); PG8_BAR; PG8_SCHED;
            PG8_STAGE(PG8_SB(1, 1), b3 + hstep, voffB);
            PG8_WAIT_V(6); PG8_BAR; PG8_MMA(1, 1, At, B1); PG8_BAR;
            }
        }
        if constexpr (ALIGN_EPI) { if (wr == 0) PG8_BAR; }
        if constexpr (!Epi::AFTER_DRAIN) { E(acc, cur, wr, wc, fr, fq); S.done(cur); }
        if (!has_next) break;
#pragma unroll
        for (int a = 0; a < 2; ++a)
#pragma unroll
            for (int b = 0; b < 2; ++b)
#pragma unroll
                for (int m = 0; m < 4; ++m)
#pragma unroll
                    for (int n = 0; n < 2; ++n) acc[a][b][m][n] = (f32x4){0.f, 0.f, 0.f, 0.f};
        cur = nxt; cA = nA; cB = nB; ++ui;
        if constexpr (ALIGN_EPI) { if (wr == 1) PG8_BAR; }
    }
    PG8_WAIT_V(0);
    if constexpr (!ALIGN_EPI) { if (wr == 0) PG8_BAR; }
    PG8_BAR;
    if constexpr (Epi::AFTER_DRAIN) { E.fused(acc, cur, wr, wc, fr, fq, lds, wid, lane); S.done(cur); }
#undef PG8_SA
#undef PG8_SB
#undef PG8_STAGE
#undef PG8_LDA
#undef PG8_LDB
#undef PG8_MMA
#undef PG8_WAIT_V
#undef PG8_WAIT_L
#undef PG8_BAR
#undef PG8_SCHED
}
}

#define LAS __attribute__((address_space(3)))
typedef unsigned short bf16;
typedef float f32x4 __attribute__((ext_vector_type(4)));
typedef float f32x2 __attribute__((ext_vector_type(2)));
typedef unsigned u32x4 __attribute__((ext_vector_type(4)));
typedef unsigned u32x2 __attribute__((ext_vector_type(2)));
typedef short bf16x8 __attribute__((ext_vector_type(8)));
typedef short s16x4 __attribute__((ext_vector_type(4)));

constexpr int SEQ = 8192, DM = 1024, MTOK = 16384;
constexpr int LDS_BYTES = 147456;
constexpr float EPS = 1e-6f;
constexpr float LOG2E = 1.4426950408889634f;
constexpr float QSCALE = 0.125f * LOG2E;

constexpr size_t MiB = 1u << 20;
constexpr size_t WS_W0T  = 0;
constexpr size_t WS_WO0T = 10 * MiB;
constexpr size_t WS_W1T  = 14 * MiB;
constexpr size_t WS_WO1T = 19 * MiB;
constexpr size_t WS_WGT  = 21 * MiB;
constexpr size_t WS_ROPE = 21 * MiB + 512 * 1024;
constexpr size_t WS_R0   = 22 * MiB;
constexpr size_t WS_VSS  = 23 * MiB;
constexpr size_t WS_SS1  = 24 * MiB;
constexpr size_t WS_SS2  = 25 * MiB;
constexpr size_t WS_XB   = 26 * MiB;
constexpr size_t WS_Z    = 58 * MiB;
constexpr size_t WS_UG = WS_Z, WS_GV = WS_Z + 32 * MiB, WS_BX = WS_Z + 64 * MiB, WS_BG = WS_Z + 96 * MiB;
constexpr size_t WS_Q  = WS_Z;
constexpr size_t WS_G  = WS_Z + 32 * MiB;
constexpr size_t WS_Y1 = WS_Z + 64 * MiB;
constexpr size_t WS_K  = WS_Z + 128 * MiB;
constexpr size_t WS_VT = WS_Z + 136 * MiB;
constexpr size_t WS_END = WS_Z + 144 * MiB;

__device__ __forceinline__ unsigned cvtpk(float lo, float hi) { return pg8::cvt_pk_bf16(lo, hi); }
__device__ __forceinline__ float bflo(unsigned u) { return __builtin_bit_cast(float, u << 16); }
__device__ __forceinline__ float bfhi(unsigned u) { return __builtin_bit_cast(float, u & 0xffff0000u); }
__device__ __forceinline__ float fast_exp2(float x) { return __builtin_amdgcn_exp2f(x); }
__device__ __forceinline__ float fast_rcp(float x) { return __builtin_amdgcn_rcpf(x); }
__device__ __forceinline__ float silu_f(float x) { return x * fast_rcp(1.f + fast_exp2(-x * LOG2E)); }
__device__ __forceinline__ float gelu_f(float x) { const float t = x * (1.f + 0.044715f * x * x) * (-1.5957691216057308f * LOG2E); return x * fast_rcp(1.f + fast_exp2(t)); }
__device__ __forceinline__ f32x2 exp2_2(f32x2 v) { return (f32x2){fast_exp2(v.x), fast_exp2(v.y)}; }
__device__ __forceinline__ f32x2 rcp_2(f32x2 v) { return (f32x2){fast_rcp(v.x), fast_rcp(v.y)}; }
__device__ __forceinline__ f32x2 min_2(f32x2 v, float m) { return (f32x2){fminf(v.x, m), fminf(v.y, m)}; }
constexpr float GC1 = -1.5957691216057308f * LOG2E, GC2 = 0.044715f;
__device__ __forceinline__ f32x2 gelu_arg(f32x2 u) { return min_2((u * u * (GC1 * GC2) + GC1) * u, 126.f); }
__device__ __forceinline__ f32x2 gelu_2(f32x2 u) { return u * rcp_2(exp2_2(gelu_arg(u)) + 1.f); }
__device__ __forceinline__ f32x2 silu_2(f32x2 g) { return g * rcp_2(exp2_2(min_2(g * (-LOG2E), 126.f)) + 1.f); }
__device__ __forceinline__ f32x2 gelu_silu_2(f32x2 u, f32x2 g) {
    const f32x2 e1 = exp2_2(gelu_arg(u)), e2 = exp2_2(min_2(g * (-LOG2E), 126.f));
    const f32x2 d = e1 + 1.f, d2 = e2 * d + d;
    return (u * g) * rcp_2(d2);
}
__device__ __forceinline__ void swap16(float v, float& a, float& b) { const auto r = __builtin_amdgcn_permlane16_swap(__builtin_bit_cast(unsigned, v), __builtin_bit_cast(unsigned, v), false, false); a = __builtin_bit_cast(float, (unsigned)r[0]); b = __builtin_bit_cast(float, (unsigned)r[1]); }
__device__ __forceinline__ void swap32(float v, float& a, float& b) { const auto r = __builtin_amdgcn_permlane32_swap(__builtin_bit_cast(unsigned, v), __builtin_bit_cast(unsigned, v), false, false); a = __builtin_bit_cast(float, (unsigned)r[0]); b = __builtin_bit_cast(float, (unsigned)r[1]); }
__device__ __forceinline__ float max2f(float a, float b) { float r; asm("v_max_f32_e32 %0, %1, %2" : "=v"(r) : "v"(a), "v"(b)); return r; }
__device__ __forceinline__ float fq_sum(float v) { float a, b; swap16(v, a, b); v = a + b; swap32(v, a, b); return a + b; }
__device__ __forceinline__ float fq_max(float v) { float a, b; swap16(v, a, b); v = max2f(a, b); swap32(v, a, b); return max2f(a, b); }
__device__ __forceinline__ float wave_sum(float v) {
#pragma unroll
    for (int o = 1; o < 64; o <<= 1) v += __shfl_xor(v, o);
    return v;
}
__device__ __forceinline__ float sum16(const float* p) {
    const f32x4 a = *(const f32x4*)p, b = *(const f32x4*)(p + 4), c = *(const f32x4*)(p + 8), d = *(const f32x4*)(p + 12);
    return ((a.x + a.y) + (a.z + a.w)) + ((b.x + b.y) + (b.z + b.w)) + (((c.x + c.y) + (c.z + c.w)) + ((d.x + d.y) + (d.z + d.w)));
}
#define LDS_WAIT() asm volatile("s_waitcnt lgkmcnt(0)" ::: "memory")

struct Args {
    const float* in[14];
    float* out; unsigned char* ws;
    int use_cg_sync, pad;
};

__device__ __forceinline__ void transpose_item(const float* __restrict__ W, int K, int N, bf16* __restrict__ WT, const float* __restrict__ g, int k0, int dst_n0, int src_n0, bool permqk, LAS float* scr, int lane, int kd = -1) {
    if (kd < 0) kd = k0;
    float wv[32];
#pragma unroll
    for (int i = 0; i < 32; ++i) { const int kk = 2 * i + (lane >> 5); wv[i] = __builtin_nontemporal_load(W + (size_t)(k0 + kk) * N + src_n0 + (lane & 31)); }
    if (g) {
#pragma unroll
        for (int i = 0; i < 32; ++i) wv[i] *= g[k0 + 2 * i + (lane >> 5)];
    }
#pragma unroll
    for (int i = 0; i < 32; ++i) scr[(2 * i + (lane >> 5)) * 33 + (lane & 31)] = wv[i];
    LDS_WAIT(); asm volatile("" ::: "memory");
    const int c = lane & 7;
#pragma unroll
    for (int j = 0; j < 4; ++j) { const int n = (lane >> 3) + 8 * j; int ns = n;
        if (permqk && n < 16) ns = (n & 3) | ((n & 4) << 1) | ((n & 8) >> 1);
        const LAS float* s = scr + (8 * c) * 33 + ns;
        u32x4 o; o.x = cvtpk(s[0 * 33], s[1 * 33]); o.y = cvtpk(s[2 * 33], s[3 * 33]); o.z = cvtpk(s[4 * 33], s[5 * 33]); o.w = cvtpk(s[6 * 33], s[7 * 33]);
        *(u32x4*)(WT + (size_t)(dst_n0 + n) * K + kd + 8 * c) = o; }
    LDS_WAIT(); asm volatile("" ::: "memory");
}

__device__ __forceinline__ void p0_prep(const Args& a, LAS unsigned char* lds) {
    int tid_ = threadIdx.x; asm volatile("" : "+v"(tid_));
    const int tid = tid_, lane = tid & 63, wave = __builtin_amdgcn_readfirstlane(tid >> 6);
    const int G = gridDim.x, gw = blockIdx.x * 8 + wave, NGW = G * 8;
    LAS float* scr = (LAS float*)(lds + wave * 16384);
    unsigned char* ws = a.ws;
    const float* x = a.in[0];
    constexpr int I_W0 = 16 * 160, I_WO0 = 32 * 32, I_W1 = 16 * 80, I_WO1 = 16 * 32, I_WG = 4 * 4 * 8;
    constexpr int NITEMS = I_W0 + I_WO0 + I_W1 + I_WO1 + I_WG;
    for (int it = gw; it < NITEMS; it += NGW) {
        int r = it;
        if (r < I_W0) {
            const int kb = r / 160, nb = r % 160, n0 = nb * 32; int src;
            if (n0 < 2048) { const int pn = n0 >> 8, within = n0 & 255, bj = within >> 7, ch = 128 * pn + (within & 127); src = bj ? 2048 + ch : ch; }
            else if (n0 < 3072) src = 1024 + (n0 - 2048);
            else src = n0;
            transpose_item(a.in[2], 1024, 5120, (bf16*)(ws + WS_W0T), a.in[1], kb * 64, n0, src, false, scr, lane); continue; }
        r -= I_W0;
        if (r < I_WO0) { const int kb = r / 32, nb = r % 32; transpose_item(a.in[8], 2048, 1024, (bf16*)(ws + WS_WO0T), nullptr, kb * 64, nb * 32, nb * 32, false, scr, lane, (kb * 64 + 1024) & 2047); continue; }
        r -= I_WO0;
        if (r < I_W1) { const int kb = r / 80, nb = r % 80, n0 = nb * 32; const bool pq = (n0 < 1280) && ((n0 & 63) == 0);
            transpose_item(a.in[10], 1024, 2560, (bf16*)(ws + WS_W1T), a.in[9], kb * 64, n0, n0, pq, scr, lane); continue; }
        r -= I_W1;
        if (r < I_WO1) { const int kb = r / 32, nb = r % 32; transpose_item(a.in[12], 1024, 1024, (bf16*)(ws + WS_WO1T), nullptr, kb * 64, nb * 32, nb * 32, false, scr, lane); continue; }
        r -= I_WO1;
        { const int gi = r / 32, rr = r % 32, kb = rr / 8, nb = rr % 8;
          transpose_item(a.in[6] + (size_t)gi * 65536, 256, 256, (bf16*)(ws + WS_WGT) + (size_t)gi * 65536, nullptr, kb * 64, nb * 32, nb * 32, false, scr, lane); }
    }
    {
        bf16* XB = (bf16*)(ws + WS_XB); float* R0 = (float*)(ws + WS_R0);
        for (int m0 = gw; m0 < MTOK; m0 += 4 * NGW) {
            f32x4 v[4][4];
#pragma unroll
            for (int r = 0; r < 4; ++r) { const int m = min(m0 + r * NGW, MTOK - 1); const f32x4* xr = (const f32x4*)(x + (size_t)m * DM) + lane;
#pragma unroll
                for (int j = 0; j < 4; ++j) v[r][j] = __builtin_nontemporal_load(xr + 64 * j); }
#pragma unroll
            for (int r = 0; r < 4; ++r) { const int m = m0 + r * NGW; float s = 0.f;
#pragma unroll
                for (int j = 0; j < 4; ++j) s += (v[r][j].x * v[r][j].x + v[r][j].y * v[r][j].y) + (v[r][j].z * v[r][j].z + v[r][j].w * v[r][j].w);
                s = wave_sum(s);
                if (m < MTOK) {
                    u32x2* o = (u32x2*)(XB + (size_t)m * DM) + lane;
#pragma unroll
                    for (int j = 0; j < 4; ++j) { u32x2 w; w.x = cvtpk(v[r][j].x, v[r][j].y); w.y = cvtpk(v[r][j].z, v[r][j].w); o[64 * j] = w; }
                    if (lane == 0) R0[m] = 1.f / sqrtf(s * (1.f / DM) + EPS);
                } }
        }
    }
    {
        unsigned* T = (unsigned*)(ws + WS_ROPE);
        for (int e = blockIdx.x * 512 + tid; e < SEQ * 8; e += G * 512) {
            const int pos = e >> 3, i = e & 7;
            const float inv = (float)exp2(-(double)i * (18.931568569324174 / 8.0));
            const float ang = (float)pos * inv;
            const double rev = (double)ang * 0.15915494309189535; const double fr = rev - rint(rev);
            const float rf = (float)fr;
            T[e] = (unsigned)__builtin_bit_cast(unsigned short, (_Float16)__builtin_amdgcn_cosf(rf)) | ((unsigned)__builtin_bit_cast(unsigned short, (_Float16)__builtin_amdgcn_sinf(rf)) << 16);
        }
    }
}

#define EPI_ARGS const f32x4 (&acc)[2][2][4][2], const pg8::Unit& u, int wr, int wc, int fr, int fq


struct EpiIn0 {
    static constexpr bool PERM = true, AFTER_DRAIN = false;
    const float* r0; bf16 *UG, *GV, *BX, *BG; float* vss;
    __device__ __forceinline__ void operator()(EPI_ARGS) const {
        const int row0 = u.pm * 256 + wr * 64 + fr, pn = u.pn;
        float rs8[2][4];
#pragma unroll
        for (int ai = 0; ai < 2; ++ai)
#pragma unroll
            for (int m = 0; m < 4; ++m) rs8[ai][m] = r0[row0 + ai * 128 + m * 16];
        if (pn < 8) {
            const int col = 128 * pn + 32 * wc + 8 * fq;
#pragma unroll
            for (int ai = 0; ai < 2; ++ai)
#pragma unroll
                for (int m = 0; m < 4; ++m) { const int row = row0 + ai * 128 + m * 16; const float rs = rs8[ai][m];
                    u32x4 w;
#pragma unroll
                    for (int n = 0; n < 2; ++n) { const f32x4 au = acc[ai][0][m][n] * rs, ag = acc[ai][1][m][n] * rs;
                        const f32x2 o0 = gelu_silu_2((f32x2){au.x, au.y}, (f32x2){ag.x, ag.y}), o1 = gelu_silu_2((f32x2){au.z, au.w}, (f32x2){ag.z, ag.w});
                        w[2 * n] = cvtpk(o0.x, o0.y); w[2 * n + 1] = cvtpk(o1.x, o1.y); }
                    *(u32x4*)(UG + (size_t)row * 1024 + col) = w; }
        } else if (pn < 12) {
            const int col = 256 * (pn - 8) + 32 * wc + 8 * fq;
#pragma unroll
            for (int ai = 0; ai < 2; ++ai)
#pragma unroll
                for (int m = 0; m < 4; ++m) { const int row = row0 + ai * 128 + m * 16; const float rs = rs8[ai][m]; float ss = 0.f;
#pragma unroll
                    for (int bj = 0; bj < 2; ++bj) { u32x4 w;
#pragma unroll
                        for (int n = 0; n < 2; ++n) { const f32x4 av = acc[ai][bj][m][n] * rs;
                            const f32x2 o0 = gelu_2((f32x2){av.x, av.y}), o1 = gelu_2((f32x2){av.z, av.w});
                            const f32x2 q = o0 * o0 + o1 * o1; ss += q.x + q.y;
                            w[2 * n] = cvtpk(o0.x, o0.y); w[2 * n + 1] = cvtpk(o1.x, o1.y); }
                        *(u32x4*)(GV + (size_t)row * 1024 + col + bj * 128) = w; }
                    ss = fq_sum(ss);
                    if (fq == 0) vss[(size_t)row * 16 + (pn - 8) * 4 + wc] = ss; }
        } else {
            const bool isg = pn >= 16; bf16* O = isg ? BG : BX;
            const int col = 256 * (pn - (isg ? 16 : 12)) + 32 * wc + 8 * fq;
#pragma unroll
            for (int ai = 0; ai < 2; ++ai)
#pragma unroll
                for (int m = 0; m < 4; ++m) { const int row = row0 + ai * 128 + m * 16; const float rs = rs8[ai][m];
#pragma unroll
                    for (int bj = 0; bj < 2; ++bj) { u32x4 w;
#pragma unroll
                        for (int n = 0; n < 2; ++n) { const f32x4 av = acc[ai][bj][m][n] * rs;
                            f32x2 o0 = (f32x2){av.x, av.y}, o1 = (f32x2){av.z, av.w};
                            if (isg) { o0 = silu_2(o0); o1 = silu_2(o1); }
                            w[2 * n] = cvtpk(o0.x, o0.y); w[2 * n + 1] = cvtpk(o1.x, o1.y); }
                        *(u32x4*)(O + (size_t)row * 1024 + col + bj * 128) = w; } }
        }
    }
};

template <bool XIN_BF16, bool OUT_F32, bool OUT_BF16>
struct EpiRes {
    static constexpr bool PERM = true, AFTER_DRAIN = false;
    const void* xin; float* xo; bf16* xb; float* ss;
    __device__ __forceinline__ void load_batch(f32x4 (&x)[2][2][2], int row0, int col0, int b) const {
#pragma unroll
        for (int mm = 0; mm < 2; ++mm)
#pragma unroll
            for (int bj = 0; bj < 2; ++bj) { const size_t off = (size_t)(row0 + (b >> 1) * 128 + (2 * (b & 1) + mm) * 16) * 1024 + col0 + bj * 128;
                if (XIN_BF16) { const u32x4 r = *(const u32x4*)((const bf16*)xin + off); x[mm][bj][0] = (f32x4){bflo(r.x), bfhi(r.x), bflo(r.y), bfhi(r.y)}; x[mm][bj][1] = (f32x4){bflo(r.z), bfhi(r.z), bflo(r.w), bfhi(r.w)}; }
                else { x[mm][bj][0] = *(const f32x4*)((const float*)xin + off); x[mm][bj][1] = *(const f32x4*)((const float*)xin + off + 4); } }
    }
    __device__ __forceinline__ void operator()(EPI_ARGS) const {
        const int row0 = u.pm * 256 + wr * 64 + fr, col0 = u.pn * 256 + 32 * wc + 8 * fq;
        f32x4 xa[2][2][2], xb2[2][2][2];
        load_batch(xa, row0, col0, 0);
#pragma unroll
        for (int b = 0; b < 4; ++b) {
            if (b + 1 < 4) { if (b & 1) load_batch(xa, row0, col0, b + 1); else load_batch(xb2, row0, col0, b + 1); }
            const int ai = b >> 1;
#pragma unroll
            for (int mm = 0; mm < 2; ++mm) { const int m = 2 * (b & 1) + mm, row = row0 + ai * 128 + m * 16; float s = 0.f;
#pragma unroll
                for (int bj = 0; bj < 2; ++bj) { const size_t off = (size_t)row * 1024 + col0 + bj * 128;
                    const f32x4 v0 = ((b & 1) ? xb2[mm][bj][0] : xa[mm][bj][0]) + acc[ai][bj][m][0], v1 = ((b & 1) ? xb2[mm][bj][1] : xa[mm][bj][1]) + acc[ai][bj][m][1];
                    if (OUT_F32) { *(f32x4*)(xo + off) = v0; *(f32x4*)(xo + off + 4) = v1; }
                    s += (v0.x * v0.x + v0.y * v0.y) + (v0.z * v0.z + v0.w * v0.w) + (v1.x * v1.x + v1.y * v1.y) + (v1.z * v1.z + v1.w * v1.w);
                    if (OUT_BF16) { u32x4 w; w.x = cvtpk(v0.x, v0.y); w.y = cvtpk(v0.z, v0.w); w.z = cvtpk(v1.x, v1.y); w.w = cvtpk(v1.z, v1.w); *(u32x4*)(xb + off) = w; } }
                s = fq_sum(s);
                if (fq == 0) ss[(size_t)row * 16 + u.pn * 4 + wc] = s; }
        }
    }
};

struct EpiIn1 {
    static constexpr bool PERM = true, AFTER_DRAIN = false;
    const float* ss1; const unsigned* rope; bf16 *Q, *K, *VT, *G;
    __device__ __forceinline__ void operator()(EPI_ARGS) const {
        const int row0 = u.pm * 256 + wr * 64 + fr, pn = u.pn;
        const bool dorope = (pn < 5) && ((wc & 1) == 0) && (fq < 2);
        float rs8[2][4];
        {
            f32x4 part[2][4];
#pragma unroll
            for (int ai = 0; ai < 2; ++ai)
#pragma unroll
                for (int m = 0; m < 4; ++m) part[ai][m] = *(const f32x4*)(ss1 + (size_t)(row0 + ai * 128 + m * 16) * 16 + 4 * fq);
#pragma unroll
            for (int ai = 0; ai < 2; ++ai)
#pragma unroll
                for (int m = 0; m < 4; ++m) { const f32x4 pq = part[ai][m]; rs8[ai][m] = 1.f / sqrtf(fq_sum((pq.x + pq.y) + (pq.z + pq.w)) * (1.f / DM) + EPS); }
        }
        u32x4 cst[2][4];
#pragma unroll
        for (int ai = 0; ai < 2; ++ai)
#pragma unroll
            for (int m = 0; m < 4; ++m) { cst[ai][m] = (u32x4){0x3c00u, 0x3c00u, 0x3c00u, 0x3c00u};
                if (dorope) cst[ai][m] = *(const u32x4*)(rope + (size_t)((row0 + ai * 128 + m * 16) & (SEQ - 1)) * 8 + 4 * fq); }
#pragma unroll
        for (int ai = 0; ai < 2; ++ai)
#pragma unroll
            for (int m = 0; m < 4; ++m) { const int row = row0 + ai * 128 + m * 16;
                const float rs = rs8[ai][m];
                const u32x4 ct = cst[ai][m];
#pragma unroll
                for (int bj = 0; bj < 2; ++bj) {
                    f32x4 z0 = acc[ai][bj][m][0] * rs, z1 = acc[ai][bj][m][1] * rs;
                    const int colt = 128 * bj + 32 * wc + 8 * fq;
                    if (pn < 5) {
                        if (dorope) {
                            float c[4], s[4];
#pragma unroll
                            for (int j = 0; j < 4; ++j) { c[j] = (float)__builtin_bit_cast(_Float16, (unsigned short)(ct[j] & 0xffffu)); s[j] = (float)__builtin_bit_cast(_Float16, (unsigned short)(ct[j] >> 16)); }
#pragma unroll
                            for (int j = 0; j < 4; ++j) { const float a1 = z0[j], a2 = z1[j]; z0[j] = a1 * c[j] - a2 * s[j]; z1[j] = a2 * c[j] + a1 * s[j]; }
                        }
                        if (pn < 4) { z0 = z0 * QSCALE; z1 = z1 * QSCALE; }
                        u32x4 w; w.x = cvtpk(z0.x, z0.y); w.y = cvtpk(z0.z, z0.w); w.z = cvtpk(z1.x, z1.y); w.w = cvtpk(z1.z, z1.w);
                        if (pn < 4) *(u32x4*)(Q + (size_t)row * 1024 + 256 * pn + colt) = w;
                        else        *(u32x4*)(K + (size_t)row * 256 + colt) = w;
                    } else if (pn == 5) {
                        u32x4 w; w.x = cvtpk(z0.x, z0.y); w.y = cvtpk(z0.z, z0.w); w.z = cvtpk(z1.x, z1.y); w.w = cvtpk(z1.z, z1.w);
                        *(u32x4*)(VT + (size_t)row * 256 + colt) = w;
                    } else {
                        const f32x2 s0 = silu_2((f32x2){z0.x, z0.y}), s1 = silu_2((f32x2){z0.z, z0.w}), s2 = silu_2((f32x2){z1.x, z1.y}), s3 = silu_2((f32x2){z1.z, z1.w});
                        u32x4 w; w.x = cvtpk(s0.x, s0.y); w.y = cvtpk(s1.x, s1.y); w.z = cvtpk(s2.x, s2.y); w.w = cvtpk(s3.x, s3.y);
                        *(u32x4*)(G + (size_t)row * 1024 + 256 * (pn - 6) + colt) = w;
                    }
                } }
    }
};

#define MFMA16(a, b, c) __builtin_amdgcn_mfma_f32_16x16x32_bf16((a), (b), (c), 0, 0, 0)

typedef short v4i16_t __attribute__((ext_vector_type(4)));
__device__ __forceinline__ float max3f(float a, float b, float c) { float r; asm("v_max3_f32 %0, %1, %2, %3" : "=v"(r) : "v"(a), "v"(b), "v"(c)); return r; }
__device__ __forceinline__ s16x4 trread(const LAS bf16* p) { return __builtin_bit_cast(s16x4, __builtin_amdgcn_ds_read_tr16_b64_v4i16((LAS v4i16_t*)p)); }
__device__ __forceinline__ bf16x8 cat8(s16x4 a, s16x4 b) { return __builtin_shufflevector(a, b, 0, 1, 2, 3, 4, 5, 6, 7); }

__device__ __forceinline__ int unit_tile(int u) { return 16 * (u & 7) + (u >> 5); }
__device__ __forceinline__ int unit_grp(int u) { return (u >> 3) & 3; }

__device__ __forceinline__ void issue_a(const Args& a, int c, int h, int tid, u32x4 (&pf)[9]) {
    const bf16* GV = (const bf16*)(a.ws + WS_GV);
#pragma unroll
    for (int it = 0; it < 8; ++it) { const int item = it * 512 + tid, cl = item & 31, j = item >> 5; pf[it] = *(const u32x4*)(GV + (size_t)(128 * c + j) * 1024 + 256 * h + 8 * cl); }
}
__device__ __forceinline__ void issue_b(const Args& a, int tt, int g, int tid, u32x4 (&pf)[9]) {
    const int b = tt >> 6, t0 = (tt & 63) * 128;
    const bf16* base = (const bf16*)(a.ws + WS_BX) + (size_t)b * SEQ * 1024 + 256 * g;
#pragma unroll
    for (int it = 0; it < 9; ++it) { const int item = it * 512 + tid, cl = item & 31, rr = item >> 5, pos = t0 - 8 + rr;
        pf[it] = (u32x4){0u, 0u, 0u, 0u};
        if (pos >= 0 && pos < SEQ) pf[it] = *(const u32x4*)(base + (size_t)pos * 1024 + 8 * cl); }
}
__device__ __forceinline__ void issue_next(const Args& a, int nkind, int nidx, int tid, u32x4 (&pf)[9]) {
    if (nkind == 0) issue_a(a, unit_tile(nidx), unit_grp(nidx), tid, pf); else if (nkind == 1) issue_b(a, unit_tile(nidx), unit_grp(nidx), tid, pf);
}

__device__ __forceinline__ void mixer_a_unit(const Args& a, LAS unsigned char* lds, int c, int h, u32x4 (&pf)[9], int nkind, int nidx) {
    int tid_ = threadIdx.x; asm volatile("" : "+v"(tid_));
    const int tid = tid_, lane = tid & 63, w = __builtin_amdgcn_readfirstlane(tid >> 6), fr = lane & 15, fq = lane >> 4;
    constexpr int VS2 = 264, WS_ = 136;
    LAS bf16* V = (LAS bf16*)lds;
    LAS bf16* Ws = (LAS bf16*)(lds + 67584);
    LAS float* rvs = (LAS float*)(lds + 67584 + 34816);
    const unsigned char* ws = a.ws;
    const bf16* UG = (const bf16*)(ws + WS_UG); const float* vss = (const float*)(ws + WS_VSS);
    bf16* Y0 = (bf16*)a.out;
    const float* wsp = a.in[4] + (size_t)h * 16384; const float* bsp = a.in[5] + h * 128; const float* gv = a.in[3];
    f32x4 wsr[8];
#pragma unroll
    for (int it = 0; it < 8; ++it) { const int item = it * 512 + tid, j4 = item & 31, i = item >> 5; wsr[it] = *(const f32x4*)(wsp + i * 128 + 4 * j4); }
    if (tid < 128) rvs[tid] = 1.f / sqrtf(sum16(vss + (size_t)(128 * c + tid) * 16) * (1.f / 1024.f) + EPS);
#pragma unroll
    for (int it = 0; it < 8; ++it) { const int item = it * 512 + tid, cl = item & 31, j = item >> 5; *(LAS u32x4*)(V + j * VS2 + 8 * cl) = pf[it]; }
    issue_next(a, nkind, nidx, tid, pf);
    __syncthreads();
#pragma unroll
    for (int it = 0; it < 8; ++it) { const int item = it * 512 + tid, j4 = item & 31, i = item >> 5;
        const f32x4 r = *(const LAS f32x4*)(rvs + 4 * j4); const f32x4 v = wsr[it];
        u32x2 o; o.x = cvtpk(v.x * r.x, v.y * r.y); o.y = cvtpk(v.z * r.z, v.w * r.w);
        *(LAS u32x2*)(Ws + i * WS_ + 4 * j4) = o; }
    u32x4 ugr[8];
#pragma unroll
    for (int it = 0; it < 8; ++it) ugr[it] = *(const u32x4*)(UG + (size_t)(128 * c + 16 * it + fr) * 1024 + 256 * h + 32 * w + 8 * fq);
    __syncthreads();
    f32x4 acc[2][8];
#pragma unroll
    for (int dt = 0; dt < 2; ++dt)
#pragma unroll
        for (int it = 0; it < 8; ++it) acc[dt][it] = (f32x4){0.f, 0.f, 0.f, 0.f};
    const LAS bf16* vb = V + (8 * fq + ((lane >> 2) & 3)) * VS2 + 32 * w + 8 * (lane & 3);
#pragma unroll
    for (int ks = 0; ks < 4; ++ks) {
        bf16x8 af[2], bfr[8];
#pragma unroll
        for (int dt = 0; dt < 2; ++dt) { const LAS bf16* p = vb + (32 * ks) * VS2 + 4 * dt; af[dt] = cat8(trread(p), trread(p + 4 * VS2)); }
#pragma unroll
        for (int it = 0; it < 8; ++it) bfr[it] = *(const LAS bf16x8*)(Ws + (16 * it + fr) * WS_ + 32 * ks + 8 * fq);
#pragma unroll
        for (int dt = 0; dt < 2; ++dt)
#pragma unroll
            for (int it = 0; it < 8; ++it) acc[dt][it] = MFMA16(af[dt], bfr[it], acc[dt][it]);
    }
    {   const int col = 256 * h + 32 * w + 8 * fq; const f32x4 g0 = *(const f32x4*)(gv + col), g1 = *(const f32x4*)(gv + col + 4);
#pragma unroll
        for (int it = 0; it < 8; ++it) { const int i = 16 * it + fr, row = 128 * c + i; const float bs = bsp[i];
            const u32x4 ug = ugr[it];
            const f32x4 m0 = acc[0][it] * g0 + bs, m1 = acc[1][it] * g1 + bs;
            u32x4 o; o.x = cvtpk(bflo(ug.x) * m0.x, bfhi(ug.x) * m0.y); o.y = cvtpk(bflo(ug.y) * m0.z, bfhi(ug.y) * m0.w); o.z = cvtpk(bflo(ug.z) * m1.x, bfhi(ug.z) * m1.y); o.w = cvtpk(bflo(ug.w) * m1.z, bfhi(ug.w) * m1.w);
            *(u32x4*)(Y0 + (size_t)row * 2048 + 1024 + col) = o; } }
    __syncthreads();
}

__device__ __forceinline__ void mixer_b_unit(const Args& a, LAS unsigned char* lds, int tt, int g, u32x4 (&pf)[9], int nkind, int nidx) {
    int tid_ = threadIdx.x; asm volatile("" : "+v"(tid_));
    const int tid = tid_, lane = tid & 63, w = __builtin_amdgcn_readfirstlane(tid >> 6), fr = lane & 15, fq = lane >> 4;
    constexpr int PS = 264;
    LAS bf16* Bs = (LAS bf16*)lds;
    LAS bf16* P = (LAS bf16*)(lds + 76032);
    const unsigned char* ws = a.ws;
    const bf16* BG = (const bf16*)(ws + WS_BG); const bf16* WGT = (const bf16*)(ws + WS_WGT) + (size_t)g * 65536;
    bf16* Y0 = (bf16*)a.out; const float* bscale = a.in[7];
    const int b = tt >> 6, t0 = (tt & 63) * 128;
#pragma unroll
    for (int it = 0; it < 9; ++it) { const int item = it * 512 + tid, cl = item & 31, rr = item >> 5; *(LAS u32x4*)(Bs + rr * PS + 8 * cl) = pf[it]; }
    bf16x8 wf[8][2];
#pragma unroll
    for (int ks = 0; ks < 8; ++ks)
#pragma unroll
        for (int et = 0; et < 2; ++et) wf[ks][et] = *(const bf16x8*)(WGT + (size_t)(32 * w + 8 * (fr >> 2) + 4 * et + (fr & 3)) * 256 + 32 * ks + 8 * fq);
    u32x4 bgr[8];
#pragma unroll
    for (int it = 0; it < 8; ++it) bgr[it] = *(const u32x4*)(BG + (size_t)(128 * tt + 16 * it + fr) * 1024 + 256 * g + 32 * w + 8 * fq);
    __syncthreads();
    {
        const int cl = tid & 31, tr = tid >> 5, half = 1 << g;
        const LAS bf16* col = Bs + 8 * cl;
        float s[8];
#pragma unroll
        for (int e = 0; e < 8; ++e) s[e] = 0.f;
        for (int rr = 8 * tr + 8 - half; rr < 8 * tr + 8 + half; ++rr) { const u32x4 r = *(const LAS u32x4*)(col + rr * PS);
#pragma unroll
            for (int e = 0; e < 4; ++e) { s[2 * e] += bflo(r[e]); s[2 * e + 1] += bfhi(r[e]); } }
        for (int k = 0; k < 8; ++k) { const int tl = 8 * tr + k, t = t0 + tl; const int lo = max(t - half, 0), hi = min(t + half, SEQ); const float inv = 1.f / (float)(hi - lo);
            const u32x4 r = *(const LAS u32x4*)(col + (tl + 8) * PS);
            u32x4 o;
#pragma unroll
            for (int e = 0; e < 4; ++e) o[e] = cvtpk(s[2 * e] * inv - bflo(r[e]), s[2 * e + 1] * inv - bfhi(r[e]));
            *(LAS u32x4*)(P + tl * PS + 8 * cl) = o;
            const u32x4 qa = *(const LAS u32x4*)(col + (tl + 8 + half) * PS), qs = *(const LAS u32x4*)(col + (tl + 8 - half) * PS);
#pragma unroll
            for (int e = 0; e < 4; ++e) { s[2 * e] += bflo(qa[e]) - bflo(qs[e]); s[2 * e + 1] += bfhi(qa[e]) - bfhi(qs[e]); } }
    }
    __syncthreads();
    f32x4 acc[2][8];
#pragma unroll
    for (int et = 0; et < 2; ++et)
#pragma unroll
        for (int it = 0; it < 8; ++it) acc[et][it] = (f32x4){0.f, 0.f, 0.f, 0.f};
#pragma unroll
    for (int ks = 0; ks < 8; ++ks) {
        bf16x8 bfr[8];
#pragma unroll
        for (int it = 0; it < 8; ++it) bfr[it] = *(const LAS bf16x8*)(P + (16 * it + fr) * PS + 32 * ks + 8 * fq);
#pragma unroll
        for (int et = 0; et < 2; ++et)
#pragma unroll
            for (int it = 0; it < 8; ++it) acc[et][it] = MFMA16(wf[ks][et], bfr[it], acc[et][it]);
    }
    issue_next(a, nkind, nidx, tid, pf);
    {   const int col = 256 * g + 32 * w + 8 * fq; const f32x4 s0 = *(const f32x4*)(bscale + col), s1 = *(const f32x4*)(bscale + col + 4);
#pragma unroll
        for (int it = 0; it < 8; ++it) { const int row = 128 * tt + 16 * it + fr;
            const u32x4 bg = bgr[it];
            const f32x4 y0 = acc[0][it] * s0, y1 = acc[1][it] * s1;
            u32x4 o; o.x = cvtpk(bflo(bg.x) * y0.x, bfhi(bg.x) * y0.y); o.y = cvtpk(bflo(bg.y) * y0.z, bfhi(bg.y) * y0.w); o.z = cvtpk(bflo(bg.z) * y1.x, bfhi(bg.z) * y1.y); o.w = cvtpk(bflo(bg.w) * y1.z, bfhi(bg.w) * y1.w);
            *(u32x4*)(Y0 + (size_t)row * 2048 + (col - 256 * g) + 256 * g) = o; } }
    __syncthreads();
}

__device__ __forceinline__ void attn_issue(const Args& a, int u, int tid, u32x4 (&kr)[6], u32x4 (&vr)[6]) {
    if (u >= 512) return;
    const int gq = unit_tile(u), b = gq >> 6, qb = gq & 63, kvh = unit_grp(u), kb0 = (qb - 1) * 128;
    const bf16* Kg = (const bf16*)(a.ws + WS_K); const bf16* Vg = (const bf16*)(a.ws + WS_VT);
#pragma unroll
    for (int it = 0; it < 6; ++it) { const int item = it * 512 + tid, ch = item & 7, key = item >> 3; const int pos = kb0 + key;
        kr[it] = (u32x4){0u, 0u, 0u, 0u}; vr[it] = (u32x4){0u, 0u, 0u, 0u};
        if (pos >= 0 && pos < SEQ) { const size_t off = (size_t)(b * SEQ + pos) * 256 + kvh * 64 + 8 * ch; kr[it] = *(const u32x4*)(Kg + off); vr[it] = *(const u32x4*)(Vg + off); } }
}
__device__ __forceinline__ void attn_unit(const Args& a, LAS unsigned char* lds, int b, int qb, int kvh, u32x4 (&kr)[6], u32x4 (&vr)[6], int unext) {
    int tid_ = threadIdx.x; asm volatile("" : "+v"(tid_));
    const int tid = tid_, lane = tid & 63, w = __builtin_amdgcn_readfirstlane(tid >> 6), fr = lane & 15, fq = lane >> 4;
    constexpr int KS = 72, VS = 80;
    LAS bf16* Ks = (LAS bf16*)lds;
    LAS bf16* Vs = (LAS bf16*)(lds + 55296);
    const unsigned char* ws = a.ws;
    const bf16* Qg = (const bf16*)(ws + WS_Q); const bf16* Gg = (const bf16*)(ws + WS_G);
    bf16* Y1 = (bf16*)(a.ws + WS_Y1);
    const int kb0 = (qb - 1) * 128;
    const int head = kvh * 4 + (w >> 1);
    const size_t qbase = (size_t)(b * SEQ + qb * 128 + (w & 1) * 64 + fr) * 1024 + head * 64;
#pragma unroll
    for (int it = 0; it < 6; ++it) { const int item = it * 512 + tid, ch = item & 7, key = item >> 3; *(LAS u32x4*)(Ks + key * KS + 8 * ch) = kr[it];
        const u32x4 v = vr[it]; *(LAS u32x4*)(Vs + key * VS + 8 * ch) = (key & 1) ? (u32x4){v.z, v.w, v.x, v.y} : v; }
    attn_issue(a, unext, tid, kr, vr);
    bf16x8 q0 = *(const bf16x8*)(Qg + qbase + 8 * fq), q1 = *(const bf16x8*)(Qg + qbase + 32 + 8 * fq);
    __syncthreads();
    const float sink2 = a.in[11][head] * LOG2E;
    const bool edge = (qb == 0) || (qb == SEQ / 128 - 1);
    const LAS bf16* vtb = Vs + (4 * fq + ((lane >> 2) & 3)) * VS + 8 * (lane & 3);
    const int vsw = 4 * ((lane >> 2) & 1);
    for (int it = 0; it < 4; ++it) {
        const int rowoff = (w & 1) * 64 + 16 * it;
        const size_t qoff = qbase + (size_t)(16 * it) * 1024;
        const u32x4 g0 = *(const u32x4*)(Gg + qoff + 8 * fq), g1 = *(const u32x4*)(Gg + qoff + 32 + 8 * fq);
        const bf16x8 qa = q0, qb2 = q1;
        if (it < 3) { q0 = *(const bf16x8*)(Qg + qoff + 16 * 1024 + 8 * fq); q1 = *(const bf16x8*)(Qg + qoff + 16 * 1024 + 32 + 8 * fq); }
        const int kt0 = (rowoff >> 4) & ~1;
        f32x4 S[18];
        const LAS bf16* kpb = Ks + (16 * kt0 + fr) * KS + 8 * fq;
#pragma unroll
        for (int j = 0; j < 18; ++j) { const LAS bf16* kp = kpb + j * (16 * KS);
            f32x4 s = {0.f, 0.f, 0.f, 0.f};
            s = MFMA16(*(const LAS bf16x8*)kp, qa, s); s = MFMA16(*(const LAS bf16x8*)(kp + 32), qb2, s); S[j] = s;
            }
        const int qpos = qb * 128 + rowoff + fr, kbase = kb0 + 16 * kt0 + 4 * fq;
        const int klo = max(qpos - 128, 0), khi = min(qpos + 128, SEQ - 1);
        int mbase = kbase - klo; const unsigned mspan = (unsigned)(khi - klo);
        asm volatile("" : "+v"(mbase));
#define ATT_MASK_TILE(j) do { _Pragma("unroll") for (int r = 0; r < 4; ++r) { const bool ok = (unsigned)(mbase + (16 * (j) + r)) <= mspan; S[j][r] = ok ? S[j][r] : -1e30f; } } while (0)
        if (edge) {
#pragma unroll
            for (int j = 0; j < 18; ++j) ATT_MASK_TILE(j);
        } else {
            ATT_MASK_TILE(0); ATT_MASK_TILE(1); ATT_MASK_TILE(16); ATT_MASK_TILE(17);
        }
#undef ATT_MASK_TILE
        float mx = sink2;
#pragma unroll
        for (int j = 0; j < 18; ++j) { mx = max3f(mx, S[j][0], S[j][1]); mx = max3f(mx, S[j][2], S[j][3]); }
        mx = fq_max(mx);
        f32x2 l2 = {0.f, 0.f};
#pragma unroll
        for (int j = 0; j < 18; ++j) { const f32x2 p0 = exp2_2((f32x2){S[j][0], S[j][1]} - mx), p1 = exp2_2((f32x2){S[j][2], S[j][3]} - mx);
            S[j] = (f32x4){p0.x, p0.y, p1.x, p1.y}; l2 += p0 + p1; }
        float l = l2.x + l2.y;
        l = fq_sum(l);
        l += fast_exp2(sink2 - mx);
        const float rl = 1.f / l;
        const LAS bf16* vpb = vtb + (16 * kt0) * VS;
        f32x4 O[4];
#pragma unroll
        for (int dt = 0; dt < 4; ++dt) O[dt] = (f32x4){0.f, 0.f, 0.f, 0.f};
#pragma unroll
        for (int jp = 0; jp < 9; ++jp) {
            u32x4 pw; pw.x = cvtpk(S[2 * jp][0], S[2 * jp][1]); pw.y = cvtpk(S[2 * jp][2], S[2 * jp][3]); pw.z = cvtpk(S[2 * jp + 1][0], S[2 * jp + 1][1]); pw.w = cvtpk(S[2 * jp + 1][2], S[2 * jp + 1][3]);
            const bf16x8 pf = __builtin_bit_cast(bf16x8, pw);
            const LAS bf16* vp = vpb + jp * (32 * VS);
#pragma unroll
            for (int dt = 0; dt < 4; ++dt) { const LAS bf16* p = vp + 32 * (dt >> 1) + ((dt & 1) ? 4 - vsw : vsw);
                O[dt] = MFMA16(cat8(trread(p), trread(p + 16 * VS)), pf, O[dt]); }
        }
        {
            const f32x4 a0 = O[0] * rl, a1 = O[1] * rl, a2 = O[2] * rl, a3 = O[3] * rl;
            u32x4 o0, o1;
            o0.x = cvtpk(a0.x * bflo(g0.x), a0.y * bfhi(g0.x)); o0.y = cvtpk(a0.z * bflo(g0.y), a0.w * bfhi(g0.y)); o0.z = cvtpk(a1.x * bflo(g0.z), a1.y * bfhi(g0.z)); o0.w = cvtpk(a1.z * bflo(g0.w), a1.w * bfhi(g0.w));
            o1.x = cvtpk(a2.x * bflo(g1.x), a2.y * bfhi(g1.x)); o1.y = cvtpk(a2.z * bflo(g1.y), a2.w * bfhi(g1.y)); o1.z = cvtpk(a3.x * bflo(g1.z), a3.y * bfhi(g1.z)); o1.w = cvtpk(a3.z * bflo(g1.w), a3.w * bfhi(g1.w));
            *(u32x4*)(Y1 + qoff + 8 * fq) = o0; *(u32x4*)(Y1 + qoff + 32 + 8 * fq) = o1;
        }
    }
    __syncthreads();
}

#define RLX_AGENT __ATOMIC_RELAXED, __HIP_MEMORY_SCOPE_AGENT
#define XB_TMO      128
#define XB_XCNT(j)  (256  + 64 * (j))
#define XB_XSUB(j)  (1280 + 64 * (j))
#define XB_XGEN(j)  (2304 + 64 * (j))
#define XB_TOP      3328
#define XB_TOPGEN   3392
#define XCD_BAR_WORDS 3456
#define XB_SPIN_CAP (1u << 18)

__device__ __forceinline__ unsigned xb_ld(unsigned* p)              { return __hip_atomic_load(p, __ATOMIC_RELAXED, __HIP_MEMORY_SCOPE_AGENT); }
__device__ __forceinline__ unsigned xb_add(unsigned* p, unsigned v) { return __hip_atomic_fetch_add(p, v, __ATOMIC_RELAXED, __HIP_MEMORY_SCOPE_AGENT); }
__device__ __forceinline__ unsigned xb_xcc_id() { return (unsigned)__builtin_amdgcn_s_getreg((3 << 11) | 20) & 0xFu; }
#define XB_SPIN(cond, bar) do { unsigned _sp = 0; while (cond) { __builtin_amdgcn_s_sleep(1); \
    if ((++_sp & 255u) == 0u) { if (xb_ld(&(bar)[XB_TMO])) break; if (_sp > XB_SPIN_CAP) { atomicAdd(&(bar)[XB_TMO], 1u); break; } } } } while (0)

struct XcdBarrier {
    unsigned* bar; unsigned x;
    volatile LAS unsigned* st;
};

__device__ __forceinline__ XcdBarrier xcd_barrier_post(unsigned* bar, volatile LAS unsigned* st) {
    XcdBarrier b; b.bar = bar; b.x = xb_xcc_id(); b.st = st;
    if (threadIdx.x == 0) (void)xb_add(&bar[XB_XCNT(b.x)], 1u);
    return b;
}
__device__ __forceinline__ void xcd_barrier_complete(unsigned* bar, unsigned x, unsigned& nloc, unsigned& nx) {
    const unsigned G = gridDim.x * gridDim.y * gridDim.z;
    unsigned sum, cnt, mine, sp = 0u;
    for (;;) {
        sum = 0u; cnt = 0u; mine = 0u;
#pragma unroll
        for (unsigned j = 0; j < 16; ++j) { const unsigned c = xb_ld(&bar[XB_XCNT(j)]); sum += c; cnt += (c > 0u) ? 1u : 0u; mine = (j == x) ? c : mine; }
        if (sum == G) break;
        __builtin_amdgcn_s_sleep(1);
        if ((++sp & 255u) == 0u) { if (xb_ld(&bar[XB_TMO])) break; if (sp > XB_SPIN_CAP) { atomicAdd(&bar[XB_TMO], 1u); break; } }
    }
    nloc = mine > 0u ? mine : 1u; nx = cnt > 0u ? cnt : 1u;
}

__device__ __forceinline__ void xcd_barrier(const XcdBarrier& b) {
    asm volatile("s_waitcnt vmcnt(0)" ::: "memory");
    __syncthreads();
    if (threadIdx.x == 0) {
        unsigned* bar = b.bar;
        __builtin_amdgcn_s_waitcnt(0);
        unsigned nloc = b.st[0], nx = b.st[1];
        if (nloc == 0u) { xcd_barrier_complete(bar, b.x, nloc, nx); b.st[0] = nloc; b.st[1] = nx; }
        const unsigned old = xb_add(&bar[XB_XSUB(b.x)], 1u);
        const unsigned gen = old / nloc;
        if (old + 1u == (gen + 1u) * nloc) {
            __builtin_amdgcn_fence(__ATOMIC_RELEASE, "agent");
            asm volatile("s_waitcnt vmcnt(0)" ::: "memory");
            const unsigned og = xb_add(&bar[XB_TOP], 1u);
            const unsigned tg = og / nx;
            if (og + 1u == (tg + 1u) * nx) xb_add(&bar[XB_TOPGEN], 1u);
            else XB_SPIN(xb_ld(&bar[XB_TOPGEN]) == tg, bar);
            __builtin_amdgcn_fence(__ATOMIC_ACQUIRE, "agent");
            xb_add(&bar[XB_XGEN(b.x)], 1u);
            asm volatile("s_waitcnt vmcnt(0)" ::: "memory");
        } else {
            XB_SPIN(xb_ld(&bar[XB_XGEN(b.x)]) == gen, bar);
            __builtin_amdgcn_fence(__ATOMIC_ACQUIRE, "agent");
            asm volatile("s_waitcnt vmcnt(0)" ::: "memory");
        }
    }
    __syncthreads();
}

#define XB_MISMATCH 192
__device__ __forceinline__ void xcd_local_barrier(const XcdBarrier& b) {
    asm volatile("s_waitcnt vmcnt(0)" ::: "memory");
    __syncthreads();
    if (threadIdx.x == 0) {
        unsigned* bar = b.bar;
        __builtin_amdgcn_s_waitcnt(0);
        const unsigned nloc = b.st[0];
        const unsigned old = xb_add(&bar[XB_XSUB(b.x)], 1u);
        const unsigned gen = old / nloc;
        if (old + 1u == (gen + 1u) * nloc) xb_add(&bar[XB_XGEN(b.x)], 1u);
        else XB_SPIN(xb_ld(&bar[XB_XGEN(b.x)]) == gen, bar);
        __builtin_amdgcn_fence(__ATOMIC_ACQUIRE, "agent");
        asm volatile("s_waitcnt vmcnt(0)" ::: "memory");
    }
    __syncthreads();
}

__device__ __forceinline__ void xcd_barrier_arrive(const XcdBarrier& b) {
    asm volatile("s_waitcnt vmcnt(0)" ::: "memory");
    __syncthreads();
    if (threadIdx.x == 0) {
        unsigned* bar = b.bar;
        __builtin_amdgcn_s_waitcnt(0);
        const unsigned nloc = b.st[0], nx = b.st[1];
        const unsigned old = xb_add(&bar[XB_XSUB(b.x)], 1u);
        const unsigned gen = old / nloc;
        if (old + 1u == (gen + 1u) * nloc) {
            __builtin_amdgcn_fence(__ATOMIC_RELEASE, "agent");
            asm volatile("s_waitcnt vmcnt(0)" ::: "memory");
            const unsigned og = xb_add(&bar[XB_TOP], 1u);
            const unsigned tg = og / nx;
            if (og + 1u == (tg + 1u) * nx) xb_add(&bar[XB_TOPGEN], 1u);
            xb_add(&bar[XB_XGEN(b.x)], 1u);
        } else {
            XB_SPIN(xb_ld(&bar[XB_XGEN(b.x)]) == gen, bar);
        }
        __builtin_amdgcn_fence(__ATOMIC_ACQUIRE, "agent");
        asm volatile("s_waitcnt vmcnt(0)" ::: "memory");
    }
    __syncthreads();
}
__device__ __forceinline__ void xcd_barrier_wait_top(const XcdBarrier& b, unsigned target) {
    if (threadIdx.x == 0) {
        unsigned* bar = b.bar;
        XB_SPIN(xb_ld(&bar[XB_TOPGEN]) < target, bar);
        __builtin_amdgcn_fence(__ATOMIC_ACQUIRE, "agent");
        asm volatile("s_waitcnt vmcnt(0)" ::: "memory");
    }
    __syncthreads();
}

constexpr size_t WS_BAR = 22 * MiB + 256 * 1024;
constexpr int LDS_ST_OFF = 147392;

__device__ __forceinline__ XcdBarrier mkbar(const Args& a, LAS unsigned char* lds) { XcdBarrier b; b.bar = (unsigned*)(a.ws + WS_BAR); b.x = xb_xcc_id(); b.st = (volatile LAS unsigned*)(lds + LDS_ST_OFF); return b; }

struct EpiFinal {
    static constexpr bool PERM = true, AFTER_DRAIN = true;
    const bf16* x1b; float* out; float* ss; const float* gfin; unsigned char* wsb; int fast;
    __device__ __forceinline__ void fused(const f32x4 (&acc)[2][2][4][2], const pg8::Unit& u, int wr, int wc, int fr, int fq, LAS unsigned char* lds, int wid, int lane) const {
        const int row0 = u.pm * 256 + wr * 64 + fr, col0 = u.pn * 256 + 32 * wc + 8 * fq;
        f32x4 v[2][4][2][2];
#pragma unroll
        for (int ai = 0; ai < 2; ++ai)
#pragma unroll
            for (int m = 0; m < 4; ++m) { const int row = row0 + ai * 128 + m * 16; float s = 0.f;
#pragma unroll
                for (int bj = 0; bj < 2; ++bj) { const size_t off = (size_t)row * 1024 + col0 + bj * 128;
                    const u32x4 r = *(const u32x4*)(x1b + off);
                    const f32x4 v0 = (f32x4){bflo(r.x), bfhi(r.x), bflo(r.y), bfhi(r.y)} + acc[ai][bj][m][0], v1 = (f32x4){bflo(r.z), bfhi(r.z), bflo(r.w), bfhi(r.w)} + acc[ai][bj][m][1];
                    v[ai][m][bj][0] = v0; v[ai][m][bj][1] = v1;
                    s += (v0.x * v0.x + v0.y * v0.y) + (v0.z * v0.z + v0.w * v0.w) + (v1.x * v1.x + v1.y * v1.y) + (v1.z * v1.z + v1.w * v1.w); }
                s = fq_sum(s);
                if (fq == 0) ss[(size_t)row * 16 + u.pn * 4 + wc] = s; }
        { XcdBarrier b; b.bar = (unsigned*)(wsb + WS_BAR); b.x = xb_xcc_id(); b.st = (volatile LAS unsigned*)(lds + LDS_ST_OFF); if (fast) xcd_local_barrier(b); else xcd_barrier(b); }
        f32x4 g[2][2];
#pragma unroll
        for (int bj = 0; bj < 2; ++bj) { g[bj][0] = *(const f32x4*)(gfin + col0 + bj * 128); g[bj][1] = *(const f32x4*)(gfin + col0 + bj * 128 + 4); }
#pragma unroll
        for (int ai = 0; ai < 2; ++ai)
#pragma unroll
            for (int m = 0; m < 4; ++m) { const int row = row0 + ai * 128 + m * 16;
                const float rs = 1.f / sqrtf(sum16(ss + (size_t)row * 16) * (1.f / DM) + EPS);
#pragma unroll
                for (int bj = 0; bj < 2; ++bj) { const size_t off = (size_t)row * 1024 + col0 + bj * 128;
                    *(f32x4*)(out + off) = v[ai][m][bj][0] * rs * g[bj][0]; *(f32x4*)(out + off + 4) = v[ai][m][bj][1] * rs * g[bj][1]; } }
    }
};

#ifndef PH
#define PH 0xFF
#endif
__global__ void __launch_bounds__(512, 2) fwd_megakernel(Args a) {
    extern __shared__ __attribute__((aligned(16))) unsigned char lds_raw[];
    LAS unsigned char* lds = (LAS unsigned char*)lds_raw;
    cg::grid_group grid = cg::this_grid();
    unsigned char* ws = a.ws;
    const int G = gridDim.x, bid = blockIdx.x;

    volatile LAS unsigned* st = (volatile LAS unsigned*)(lds + LDS_ST_OFF);
    unsigned* barw = (unsigned*)(ws + WS_BAR);
    if (threadIdx.x < 4) st[threadIdx.x] = 0u;
    __syncthreads();
    (void)xcd_barrier_post(barw, st);
    if (threadIdx.x == 0) atomicOr(barw + 64 + (bid & 7), 1u << xb_xcc_id());
    if (a.use_cg_sync) grid.sync();
#if (PH >> 0) & 1
    p0_prep(a, lds);
#ifdef DUP_P0
    p0_prep(a, lds);
#endif
#endif
    xcd_barrier(mkbar(a, lds));
    bool fast = (G == 256);
#pragma unroll
    for (int g8 = 0; g8 < 8; ++g8) { const unsigned m = (unsigned)__builtin_amdgcn_readfirstlane((int)xb_ld(barw + 64 + g8)); fast = fast && (m != 0u) && ((m & (m - 1u)) == 0u); }
#ifdef PROBE_FAST
    if (!fast) return;
#endif
#define LOCAL_BAR() do { if (fast) xcd_local_barrier(mkbar(a, lds)); else xcd_barrier(mkbar(a, lds)); } while (0)
#ifdef DUP_BAR
#define GRID_BAR() do { xcd_barrier(mkbar(a, lds)); xcd_barrier(mkbar(a, lds)); } while (0)
#else
#define GRID_BAR() xcd_barrier(mkbar(a, lds))
#endif
#if (PH >> 1) & 1
    {
        pg8::Gemm g{(const bf16*)(ws + WS_XB), (const bf16*)(ws + WS_W0T), MTOK, 5120, 1024}; pg8::StaticOrder S; S.init(MTOK, 5120, G, bid);
        EpiIn0 E{(const float*)(ws + WS_R0), (bf16*)(ws + WS_UG), (bf16*)(ws + WS_GV), (bf16*)(ws + WS_BX), (bf16*)(ws + WS_BG), (float*)(ws + WS_VSS)};
        pg8::gemm_phase<EpiIn0, pg8::StaticOrder, true, true>(lds, g, S, E);
    }
#endif
    if (fast) xcd_barrier_arrive(mkbar(a, lds)); else xcd_barrier(mkbar(a, lds));
#if (PH >> 2) & 1
    {
        u32x4 pf[9];
        int tid_ = threadIdx.x; asm volatile("" : "+v"(tid_));
        int kind = 0, idx = bid;
        if (idx >= 512) kind = 2;
        issue_next(a, kind, idx, tid_, pf);
        while (kind < 2) {
            int nkind = kind, nidx = idx + G;
            if (nidx >= 512) { nkind = kind + 1; nidx = bid; }
            if (fast && kind == 0 && nkind == 1) xcd_barrier_wait_top(mkbar(a, lds), 2u);
            if (kind == 0) mixer_a_unit(a, lds, unit_tile(idx), unit_grp(idx), pf, nkind, nidx);
            else           mixer_b_unit(a, lds, unit_tile(idx), unit_grp(idx), pf, nkind, nidx);
            kind = nkind; idx = nidx;
        }
    }
#endif
    LOCAL_BAR();
#if (PH >> 3) & 1
    {
        pg8::Gemm g{(const bf16*)a.out, (const bf16*)(ws + WS_WO0T), MTOK, 1024, 2048}; pg8::StaticOrder S; S.init(MTOK, 1024, G, bid);
        typedef EpiRes<true, false, true> Epi3;
        Epi3 E{(const void*)(ws + WS_XB), nullptr, (bf16*)(ws + WS_XB), (float*)(ws + WS_SS1)};
        pg8::gemm_phase<Epi3, pg8::StaticOrder, true, true>(lds, g, S, E);
#ifdef DUP_G2
        pg8::gemm_phase<Epi3, pg8::StaticOrder, true, true>(lds, g, S, E);
#endif
    }
#endif
    LOCAL_BAR();
#if (PH >> 4) & 1
    {
        pg8::Gemm g{(const bf16*)(ws + WS_XB), (const bf16*)(ws + WS_W1T), MTOK, 2560, 1024}; pg8::StaticOrder S; S.init(MTOK, 2560, G, bid);
        EpiIn1 E{(const float*)(ws + WS_SS1), (const unsigned*)(ws + WS_ROPE), (bf16*)(ws + WS_Q), (bf16*)(ws + WS_K), (bf16*)(ws + WS_VT), (bf16*)(ws + WS_G)};
        pg8::gemm_phase<EpiIn1, pg8::StaticOrder, true, true>(lds, g, S, E);
#ifdef DUP_G3
        pg8::gemm_phase<EpiIn1, pg8::StaticOrder, true, true>(lds, g, S, E);
#endif
    }
#endif
    GRID_BAR();
#if (PH >> 5) & 1
#ifndef DUP_ATT
#define DUP_ATT 1
#endif
    {
        u32x4 kr[6], vr[6];
        int tid_ = threadIdx.x; asm volatile("" : "+v"(tid_));
        attn_issue(a, bid, tid_, kr, vr);
        for (int u = bid; u < 512; u += G) attn_unit(a, lds, unit_tile(u) >> 6, unit_tile(u) & 63, unit_grp(u), kr, vr, u + G);
    }
#endif
    LOCAL_BAR();
#if (PH >> 6) & 1
    if (G == 256) {
        pg8::Gemm g{(const bf16*)(ws + WS_Y1), (const bf16*)(ws + WS_WO1T), MTOK, 1024, 1024}; pg8::StaticOrder S; S.init(MTOK, 1024, G, bid);
        EpiFinal E{(const bf16*)(ws + WS_XB), a.out, (float*)(ws + WS_SS2), a.in[13], a.ws, fast ? 1 : 0};
        pg8::gemm_phase<EpiFinal, pg8::StaticOrder, false, true>(lds, g, S, E);
#ifdef DUP_G4
        pg8::gemm_phase<EpiFinal, pg8::StaticOrder, false, true>(lds, g, S, E);
#endif
    } else {
        {
            pg8::Gemm g{(const bf16*)(ws + WS_Y1), (const bf16*)(ws + WS_WO1T), MTOK, 1024, 1024}; pg8::StaticOrder S; S.init(MTOK, 1024, G, bid);
            typedef EpiRes<true, true, false> Epi6;
            Epi6 E{(const void*)(ws + WS_XB), a.out, nullptr, (float*)(ws + WS_SS2)};
            pg8::gemm_phase<Epi6, pg8::StaticOrder, true, true>(lds, g, S, E);
        }
        GRID_BAR();
        int tid_ = threadIdx.x; asm volatile("" : "+v"(tid_));
        const int tid = tid_, lane = tid & 63, wave = __builtin_amdgcn_readfirstlane(tid >> 6), gw = bid * 8 + wave, NGW = G * 8;
        const float* ss2 = (const float*)(ws + WS_SS2); const f32x4* fn = (const f32x4*)a.in[13] + lane;
        f32x4 gn[4];
#pragma unroll
        for (int j = 0; j < 4; ++j) gn[j] = fn[64 * j];
        for (int m = gw; m < MTOK; m += NGW) {
            const float rs = 1.f / sqrtf(sum16(ss2 + (size_t)m * 16) * (1.f / DM) + EPS);
            f32x4* xr = (f32x4*)(a.out + (size_t)m * DM) + lane;
#pragma unroll
            for (int j = 0; j < 4; ++j) xr[64 * j] = xr[64 * j] * rs * gn[j];
        }
    }
#endif
}

extern "C" void kernel_launch(void* const* d_in, const int* in_sizes, int n_in, void* d_out, int out_size, void* d_ws, size_t ws_size, hipStream_t stream) {
    static int grid = 0;
    if (grid == 0) {
        if (n_in != 14 || out_size != MTOK * DM || ws_size < WS_END) { fprintf(stderr, "kernel_launch: unexpected problem shape (n_in %d out %d ws %zu)\n", n_in, out_size, ws_size); grid = -1; return; }
        int dev = 0, cus = 0, per_cu = 0;
        hipGetDevice(&dev);
        hipDeviceGetAttribute(&cus, hipDeviceAttributeMultiprocessorCount, dev);
        if (hipFuncSetAttribute((const void*)fwd_megakernel, hipFuncAttributeMaxDynamicSharedMemorySize, LDS_BYTES) != hipSuccess) { fprintf(stderr, "kernel_launch: hipFuncSetAttribute failed\n"); grid = -1; return; }
        if (hipOccupancyMaxActiveBlocksPerMultiprocessor(&per_cu, (const void*)fwd_megakernel, 512, LDS_BYTES) != hipSuccess || per_cu < 1) { fprintf(stderr, "kernel_launch: occupancy query failed (%d)\n", per_cu); (void)hipGetLastError(); grid = -1; return; }
        grid = cus * per_cu;
    }
    if (grid < 0) return;
    if (hipMemsetAsync((char*)d_ws + WS_BAR, 0, XCD_BAR_WORDS * 4, stream) != hipSuccess) { fprintf(stderr, "kernel_launch: hipMemsetAsync failed\n"); return; }
    Args a{};
    for (int i = 0; i < 14; ++i) a.in[i] = (const float*)d_in[i];
    a.out = (float*)d_out; a.ws = (unsigned char*)d_ws;
    void* args[] = {&a};
    hipError_t e = hipLaunchCooperativeKernel((const void*)fwd_megakernel, dim3(grid), dim3(512), args, LDS_BYTES, stream);
    if (e != hipSuccess) fprintf(stderr, "kernel_launch: cooperative launch failed: %s (grid %d)\n", hipGetErrorString(e), grid);
}
```

```cpp
#include <hip/hip_runtime.h>
#include <hip/hip_cooperative_groups.h>
#include <cstdio>
#include <cstdint>
namespace cg = cooperative_groups;
namespace pg8 {
#define PG8_LAS __attribute__((address_space(3)))
typedef unsigned short bf16_t;
typedef short bf16x8 __attribute__((ext_vector_type(8)));
typedef float f32x4 __attribute__((ext_vector_type(4)));
typedef unsigned u32x4 __attribute__((ext_vector_type(4)));
constexpr int BM = 256, BK = 64, HALF = 128, HTB = HALF * BK * 2  , STAGE_BYTES = 8 * HTB, NXCD = 8, WGM = 8;

__host__ __device__ __forceinline__ int lds_byte(int r, int c) { const int st = (r >> 4) * 2 + (c >> 5), rr = r & 15, cc = c & 31, ob = rr * 64 + cc * 2; return st * 1024 + (ob ^ (((ob >> 9) & 1) << 5)); }
__host__ __device__ __forceinline__ void stage_rc(int b, int& R, int& C) { const int st = b / 1024, sb = b % 1024, swz = sb ^ (((sb >> 9) & 1) << 5); R = (st >> 1) * 16 + swz / 64; C = (st & 1) * 32 + (swz % 64) / 2; }
__host__ __device__ __forceinline__ int perm32(int rho) { const int n = rho >> 4, i = rho & 15; return 8 * (i >> 2) + 4 * n + (i & 3); }

struct Unit { int pm, pn; };
struct Gemm { const bf16_t* A; const bf16_t* Bt; int M, N, K; };

struct StaticOrder {
    int nM, nN, nwg, G, c;
    __host__ __device__ void init(int M, int N, int G_, int c_) { nM = M / BM; nN = N / BM; nwg = nM * nN; G = G_; c = c_; }
    __host__ __device__ bool next(int i, Unit& u) const {
        const long L = (long)i * G + c; if (L >= nwg) return false;
        int wgid = (int)L; { const int q = nwg / NXCD, r = nwg % NXCD, xcd = wgid % NXCD, off = wgid / NXCD; wgid = (xcd < r ? xcd * (q + 1) : r * (q + 1) + (xcd - r) * q) + off; }
        const int nig = WGM * nN, gid = wgid / nig, fm = gid * WGM, gsz = (nM - fm) < WGM ? (nM - fm) : WGM;
        u.pm = fm + ((wgid % nig) % gsz); u.pn = (wgid % nig) / gsz; return true;
    }
    __device__ __forceinline__ void a_ready(const Unit&) const {}
    __device__ __forceinline__ void done(const Unit&) const {}
};

__device__ __forceinline__ unsigned cvt_pk_bf16(float lo, float hi) { unsigned r; asm volatile("v_cvt_pk_bf16_f32 %0, %1, %2" : "=v"(r) : "v"(lo), "v"(hi)); return r; }
template <class Epi, class Sched, bool ALIGN_EPI = false, bool SP2 = false>
__device__ __forceinline__ void gemm_phase(PG8_LAS unsigned char* lds, const Gemm g, const Sched& S, const Epi& E) {
    int tid_ = threadIdx.x; asm volatile("" : "+v"(tid_));
    const int tid = tid_, wid = __builtin_amdgcn_readfirstlane(tid >> 6), lane = tid & 63, wr = wid >> 2, wc = wid & 3, fr = lane & 15, fq = lane >> 4;
    const int K = g.K, nt = K / BK;
    unsigned voffA[2], voffB[2];
#pragma unroll
    for (int i = 0; i < 2; ++i) { int R, C; stage_rc(tid * 16 + i * 8192, R, C); const int Rb = Epi::PERM ? ((R & ~31) + perm32(R & 31)) : R;
        voffA[i] = (unsigned)(R * K + C) * 2u; voffB[i] = (unsigned)(Rb * K + C) * 2u; }
    const size_t kstep = (size_t)(BK * 2);
    const size_t hstep = (size_t)HALF * K * 2;
    const size_t tstep = 2 * hstep;
    const unsigned ldsw = (unsigned)wid * 1024u;
    const int aoff = lds_byte(wr * 64 + fr, fq * 8), boff = lds_byte(wc * 32 + fr, fq * 8);
#define PG8_SA(b, h) (((b) * 2 + (h)) * HTB)
#define PG8_SB(b, h) ((4 + (b) * 2 + (h)) * HTB)
#define PG8_STAGE(bufoff, gbase, voff) do { _Pragma("unroll") for (int _i = 0; _i < 2; ++_i) \
        __builtin_amdgcn_global_load_lds((const unsigned*)((const char*)(gbase) + (voff)[_i]), (PG8_LAS unsigned*)(lds + (bufoff) + ldsw + _i * 8192), 16, 0, 0); } while (0)
#define PG8_LDA(dst, b, h) do { _Pragma("unroll") for (int m = 0; m < 4; ++m) _Pragma("unroll") for (int k = 0; k < 2; ++k) dst[m][k] = *(const PG8_LAS bf16x8*)(lds + PG8_SA(b, h) + aoff + m * 2048 + k * 1024); } while (0)
#define PG8_LDB(dst, b, h) do { _Pragma("unroll") for (int n = 0; n < 2; ++n) _Pragma("unroll") for (int k = 0; k < 2; ++k) dst[n][k] = *(const PG8_LAS bf16x8*)(lds + PG8_SB(b, h) + boff + n * 2048 + k * 1024); } while (0)
#define PG8_MMA(ai, bj, At, Bt) do { __builtin_amdgcn_s_setprio(1); _Pragma("unroll") for (int m = 0; m < 4; ++m) _Pragma("unroll") for (int n = 0; n < 2; ++n) _Pragma("unroll") for (int k = 0; k < 2; ++k) \
        acc[ai][bj][m][n] = __builtin_amdgcn_mfma_f32_16x16x32_bf16(Bt[n][k], At[m][k], acc[ai][bj][m][n], 0, 0, 0); __builtin_amdgcn_s_setprio(0); } while (0)
#define PG8_WAIT_V(n) asm volatile("s_waitcnt vmcnt(" #n ")" ::: "memory")
#define PG8_WAIT_L(n) asm volatile("s_waitcnt lgkmcnt(" #n ")" ::: "memory")
#define PG8_BAR __builtin_amdgcn_s_barrier()
#define PG8_SCHED __builtin_amdgcn_sched_barrier(0)
    Unit cur, nxt; int ui = 0;
    if (!S.next(0, cur)) return;
    f32x4 acc[2][2][4][2];
#pragma unroll
    for (int a = 0; a < 2; ++a)
#pragma unroll
        for (int b = 0; b < 2; ++b)
#pragma unroll
            for (int m = 0; m < 4; ++m)
#pragma unroll
                for (int n = 0; n < 2; ++n) acc[a][b][m][n] = (f32x4){0.f, 0.f, 0.f, 0.f};
    bf16x8 At[4][2], B0[2][2], B1[2][2];
    const char* cA = (const char*)g.A + (size_t)cur.pm * tstep; const char* cB = (const char*)g.Bt + (size_t)cur.pn * tstep;
    S.a_ready(cur);
    if constexpr (SP2) {
        PG8_STAGE(PG8_SB(0, 0), cB, voffB); PG8_STAGE(PG8_SB(0, 1), cB + hstep, voffB); PG8_STAGE(PG8_SA(0, 0), cA, voffA); PG8_STAGE(PG8_SA(0, 1), cA + hstep, voffA);
        if (wr == 1) PG8_BAR;
        PG8_WAIT_V(2); PG8_BAR;
        PG8_STAGE(PG8_SB(1, 0), cB + kstep, voffB); PG8_STAGE(PG8_SA(1, 0), cA + kstep, voffA); PG8_STAGE(PG8_SB(1, 1), cB + hstep + kstep, voffB);
        PG8_WAIT_V(6); PG8_BAR;
    } else {
        PG8_STAGE(PG8_SB(0, 0), cB, voffB); PG8_STAGE(PG8_SA(0, 0), cA, voffA); PG8_STAGE(PG8_SB(0, 1), cB + hstep, voffB); PG8_STAGE(PG8_SA(0, 1), cA + hstep, voffA);
        if (wr == 1) PG8_BAR;
        PG8_WAIT_V(4); PG8_BAR;
        PG8_STAGE(PG8_SB(1, 0), cB + kstep, voffB); PG8_STAGE(PG8_SA(1, 0), cA + kstep, voffA); PG8_STAGE(PG8_SB(1, 1), cB + hstep + kstep, voffB);
        PG8_WAIT_V(6); PG8_BAR;
    }
    for (;;) {
        const bool has_next = S.next(ui + 1, nxt);
        const char* nA = has_next ? (const char*)g.A + (size_t)nxt.pm * tstep : cA; const char* nB = has_next ? (const char*)g.Bt + (size_t)nxt.pn * tstep : cB;
        for (int t = 0; t < nt; t += 2) {
            const bool last = (t == nt - 2);
            const char* a1 = cA + (size_t)(t + 1) * kstep;
            const char* a2 = last ? nA : cA + (size_t)(t + 2) * kstep; const char* b2 = last ? nB : cB + (size_t)(t + 2) * kstep;
            const char* a3 = a2 + kstep; const char* b3 = b2 + kstep;
            if (last && has_next) S.a_ready(nxt);
            if constexpr (SP2) {
            PG8_LDB(B0, 0, 0); PG8_LDB(B1, 0, 1); PG8_SCHED; PG8_LDA(At, 0, 0); PG8_STAGE(PG8_SA(1, 1), a1 + hstep, voffA);
            PG8_WAIT_V(8); PG8_WAIT_L(0); PG8_BAR; PG8_MMA(0, 0, At, B0); PG8_MMA(0, 1, At, B1); PG8_BAR; PG8_SCHED;
            PG8_LDA(At, 0, 1); PG8_STAGE(PG8_SB(0, 0), b2, voffB); PG8_STAGE(PG8_SB(0, 1), b2 + hstep, voffB); PG8_STAGE(PG8_SA(0, 0), a2, voffA);
            PG8_WAIT_V(8); PG8_WAIT_L(0); PG8_BAR; PG8_MMA(1, 0, At, B0); PG8_MMA(1, 1, At, B1); PG8_BAR; PG8_SCHED;
            PG8_LDB(B0, 1, 0); PG8_LDB(B1, 1, 1); PG8_SCHED; PG8_LDA(At, 1, 0); PG8_STAGE(PG8_SA(0, 1), a2 + hstep, voffA);
            PG8_WAIT_V(8); PG8_WAIT_L(0); PG8_BAR; PG8_MMA(0, 0, At, B0); PG8_MMA(0, 1, At, B1); PG8_BAR; PG8_SCHED;
            PG8_LDA(At, 1, 1); PG8_STAGE(PG8_SB(1, 0), b3, voffB); PG8_STAGE(PG8_SB(1, 1), b3 + hstep, voffB); PG8_STAGE(PG8_SA(1, 0), a3, voffA);
            PG8_WAIT_V(8); PG8_WAIT_L(0); PG8_BAR; PG8_MMA(1, 0, At, B0); PG8_MMA(1, 1, At, B1); PG8_BAR; PG8_SCHED;
            } else {
            PG8_LDB(B0, 0, 0); PG8_SCHED; PG8_LDA(At, 0, 0); PG8_STAGE(PG8_SA(1, 1), a1 + hstep, voffA);
            PG8_WAIT_L(8); PG8_BAR; PG8_WAIT_L(0); PG8_MMA(0, 0, At, B0); PG8_BAR; PG8_SCHED;
            PG8_LDB(B1, 0, 1); PG8_STAGE(PG8_SB(0, 0), b2, voffB);
            PG8_BAR; PG8_WAIT_L(0); PG8_MMA(0, 1, At, B1); PG8_BAR;
            PG8_LDA(At, 0, 1); PG8_STAGE(PG8_SA(0, 0), a2, voffA);
            PG8_BAR; PG8_WAIT_L(0); PG8_MMA(1, 0, At, B0); PG8_BAR; PG8_SCHED;
            PG8_STAGE(PG8_SB(0, 1), b2 + hstep, voffB);
            PG8_WAIT_V(6); PG8_BAR; PG8_MMA(1, 1, At, B1); PG8_BAR;
            PG8_LDB(B0, 1, 0); PG8_SCHED; PG8_LDA(At, 1, 0); PG8_STAGE(PG8_SA(0, 1), a2 + hstep, voffA);
            PG8_WAIT_L(8); PG8_BAR; PG8_WAIT_L(0); PG8_MMA(0, 0, At, B0); PG8_BAR; PG8_SCHED;
            PG8_LDB(B1, 1, 1); PG8_STAGE(PG8_SB(1, 0), b3, voffB);
            PG8_BAR; PG8_WAIT_L(0); PG8_MMA(0, 1, At, B1); PG8_BAR;
            PG8_LDA(At, 1, 1); PG8_STAGE(PG8_SA(1, 0), a3, voffA);
            PG8_BAR; PG8_WAIT_L(0); PG8_MMA(1, 0, At, B0); PG8_BAR; PG8_SCHED;
            PG8_STAGE(PG8_SB(1, 1), b3 + hstep, voffB);
            PG8_WAIT_V(6); PG8_BAR; PG8_MMA(1, 1, At, B1); PG8_BAR;
            }
        }
        if constexpr (ALIGN_EPI) { if (wr == 0) PG8_BAR; }
        if constexpr (!Epi::AFTER_DRAIN) { E(acc, cur, wr, wc, fr, fq); S.done(cur); }
        if (!has_next) break;
#pragma unroll
        for (int a = 0; a < 2; ++a)
#pragma unroll
            for (int b = 0; b < 2; ++b)
#pragma unroll
                for (int m = 0; m < 4; ++m)
#pragma unroll
                    for (int n = 0; n < 2; ++n) acc[a][b][m][n] = (f32x4){0.f, 0.f, 0.f, 0.f};
        cur = nxt; cA = nA; cB = nB; ++ui;
        if constexpr (ALIGN_EPI) { if (wr == 1) PG8_BAR; }
    }
    PG8_WAIT_V(0);
    if constexpr (!ALIGN_EPI) { if (wr == 0) PG8_BAR; }
    PG8_BAR;
    if constexpr (Epi::AFTER_DRAIN) { E.fused(acc, cur, wr, wc, fr, fq, lds, wid, lane); S.done(cur); }
#undef PG8_SA
#undef PG8_SB
#undef PG8_STAGE
#undef PG8_LDA
#undef PG8_LDB
#undef PG8_MMA
#undef PG8_WAIT_V
#undef PG8_WAIT_L
#undef PG8_BAR
#undef PG8_SCHED
}
}

#define LAS __attribute__((address_space(3)))
typedef unsigned short bf16;
typedef float f32x4 __attribute__((ext_vector_type(4)));
typedef float f32x2 __attribute__((ext_vector_type(2)));
typedef unsigned u32x4 __attribute__((ext_vector_type(4)));
typedef unsigned u32x2 __attribute__((ext_vector_type(2)));
typedef short bf16x8 __attribute__((ext_vector_type(8)));
typedef short s16x4 __attribute__((ext_vector_type(4)));

constexpr int SEQ = 8192, DM = 1024, MTOK = 16384;
constexpr int LDS_BYTES = 147456;
constexpr float EPS = 1e-6f;
constexpr float LOG2E = 1.4426950408889634f;
constexpr float QSCALE = 0.125f * LOG2E;

constexpr size_t MiB = 1u << 20;
constexpr size_t WS_W0T  = 0;
constexpr size_t WS_WO0T = 10 * MiB;
constexpr size_t WS_W1T  = 14 * MiB;
constexpr size_t WS_WO1T = 19 * MiB;
constexpr size_t WS_WGT  = 21 * MiB;
constexpr size_t WS_ROPE = 21 * MiB + 512 * 1024;
constexpr size_t WS_R0   = 22 * MiB;
constexpr size_t WS_VSS  = 23 * MiB;
constexpr size_t WS_SS1  = 24 * MiB;
constexpr size_t WS_SS2  = 25 * MiB;
constexpr size_t WS_XB   = 26 * MiB;
constexpr size_t WS_Z    = 58 * MiB;
constexpr size_t WS_UG = WS_Z, WS_GV = WS_Z + 32 * MiB, WS_BX = WS_Z + 64 * MiB, WS_BG = WS_Z + 96 * MiB;
constexpr size_t WS_Q  = WS_Z;
constexpr size_t WS_G  = WS_Z + 32 * MiB;
constexpr size_t WS_Y1 = WS_Z + 64 * MiB;
constexpr size_t WS_K  = WS_Z + 128 * MiB;
constexpr size_t WS_VT = WS_Z + 136 * MiB;
constexpr size_t WS_END = WS_Z + 144 * MiB;

__device__ __forceinline__ unsigned cvtpk(float lo, float hi) { return pg8::cvt_pk_bf16(lo, hi); }
__device__ __forceinline__ float bflo(unsigned u) { return __builtin_bit_cast(float, u << 16); }
__device__ __forceinline__ float bfhi(unsigned u) { return __builtin_bit_cast(float, u & 0xffff0000u); }
__device__ __forceinline__ float fast_exp2(float x) { return __builtin_amdgcn_exp2f(x); }
__device__ __forceinline__ float fast_rcp(float x) { return __builtin_amdgcn_rcpf(x); }
__device__ __forceinline__ float silu_f(float x) { return x * fast_rcp(1.f + fast_exp2(-x * LOG2E)); }
__device__ __forceinline__ float gelu_f(float x) { const float t = x * (1.f + 0.044715f * x * x) * (-1.5957691216057308f * LOG2E); return x * fast_rcp(1.f + fast_exp2(t)); }
__device__ __forceinline__ f32x2 exp2_2(f32x2 v) { return (f32x2){fast_exp2(v.x), fast_exp2(v.y)}; }
__device__ __forceinline__ f32x2 rcp_2(f32x2 v) { return (f32x2){fast_rcp(v.x), fast_rcp(v.y)}; }
__device__ __forceinline__ f32x2 min_2(f32x2 v, float m) { return (f32x2){fminf(v.x, m), fminf(v.y, m)}; }
constexpr float GC1 = -1.5957691216057308f * LOG2E, GC2 = 0.044715f;
__device__ __forceinline__ f32x2 gelu_arg(f32x2 u) { return min_2((u * u * (GC1 * GC2) + GC1) * u, 126.f); }
__device__ __forceinline__ f32x2 gelu_2(f32x2 u) { return u * rcp_2(exp2_2(gelu_arg(u)) + 1.f); }
__device__ __forceinline__ f32x2 silu_2(f32x2 g) { return g * rcp_2(exp2_2(min_2(g * (-LOG2E), 126.f)) + 1.f); }
__device__ __forceinline__ f32x2 gelu_silu_2(f32x2 u, f32x2 g) {
    const f32x2 e1 = exp2_2(gelu_arg(u)), e2 = exp2_2(min_2(g * (-LOG2E), 126.f));
    const f32x2 d = e1 + 1.f, d2 = e2 * d + d;
    return (u * g) * rcp_2(d2);
}
__device__ __forceinline__ void swap16(float v, float& a, float& b) { const auto r = __builtin_amdgcn_permlane16_swap(__builtin_bit_cast(unsigned, v), __builtin_bit_cast(unsigned, v), false, false); a = __builtin_bit_cast(float, (unsigned)r[0]); b = __builtin_bit_cast(float, (unsigned)r[1]); }
__device__ __forceinline__ void swap32(float v, float& a, float& b) { const auto r = __builtin_amdgcn_permlane32_swap(__builtin_bit_cast(unsigned, v), __builtin_bit_cast(unsigned, v), false, false); a = __builtin_bit_cast(float, (unsigned)r[0]); b = __builtin_bit_cast(float, (unsigned)r[1]); }
__device__ __forceinline__ float max2f(float a, float b) { float r; asm("v_max_f32_e32 %0, %1, %2" : "=v"(r) : "v"(a), "v"(b)); return r; }
__device__ __forceinline__ float fq_sum(float v) { float a, b; swap16(v, a, b); v = a + b; swap32(v, a, b); return a + b; }
__device__ __forceinline__ float fq_max(float v) { float a, b; swap16(v, a, b); v = max2f(a, b); swap32(v, a, b); return max2f(a, b); }
__device__ __forceinline__ float wave_sum(float v) {
#pragma unroll
    for (int o = 1; o < 64; o <<= 1) v += __shfl_xor(v, o);
    return v;
}
__device__ __forceinline__ float sum16(const float* p) {
    const f32x4 a = *(const f32x4*)p, b = *(const f32x4*)(p + 4), c = *(const f32x4*)(p + 8), d = *(const f32x4*)(p + 12);
    return ((a.x + a.y) + (a.z + a.w)) + ((b.x + b.y) + (b.z + b.w)) + (((c.x + c.y) + (c.z + c.w)) + ((d.x + d.y) + (d.z + d.w)));
}
#define LDS_WAIT() asm volatile("s_waitcnt lgkmcnt(0)" ::: "memory")

struct Args {
    const float* in[14];
    float* out; unsigned char* ws;
    int use_cg_sync, pad;
};

__device__ __forceinline__ void transpose_item(const float* __restrict__ W, int K, int N, bf16* __restrict__ WT, const float* __restrict__ g, int k0, int dst_n0, int src_n0, bool permqk, LAS float* scr, int lane) {
    float wv[32];
#pragma unroll
    for (int i = 0; i < 32; ++i) { const int kk = 2 * i + (lane >> 5); wv[i] = __builtin_nontemporal_load(W + (size_t)(k0 + kk) * N + src_n0 + (lane & 31)); }
    if (g) {
#pragma unroll
        for (int i = 0; i < 32; ++i) wv[i] *= g[k0 + 2 * i + (lane >> 5)];
    }
#pragma unroll
    for (int i = 0; i < 32; ++i) scr[(2 * i + (lane >> 5)) * 33 + (lane & 31)] = wv[i];
    LDS_WAIT(); asm volatile("" ::: "memory");
    const int c = lane & 7;
#pragma unroll
    for (int j = 0; j < 4; ++j) { const int n = (lane >> 3) + 8 * j; int ns = n;
        if (permqk && n < 16) ns = (n & 3) | ((n & 4) << 1) | ((n & 8) >> 1);
        const LAS float* s = scr + (8 * c) * 33 + ns;
        u32x4 o; o.x = cvtpk(s[0 * 33], s[1 * 33]); o.y = cvtpk(s[2 * 33], s[3 * 33]); o.z = cvtpk(s[4 * 33], s[5 * 33]); o.w = cvtpk(s[6 * 33], s[7 * 33]);
        *(u32x4*)(WT + (size_t)(dst_n0 + n) * K + k0 + 8 * c) = o; }
    LDS_WAIT(); asm volatile("" ::: "memory");
}

__device__ __forceinline__ void p0_prep(const Args& a, LAS unsigned char* lds) {
    int tid_ = threadIdx.x; asm volatile("" : "+v"(tid_));
    const int tid = tid_, lane = tid & 63, wave = __builtin_amdgcn_readfirstlane(tid >> 6);
    const int G = gridDim.x, gw = blockIdx.x * 8 + wave, NGW = G * 8;
    LAS float* scr = (LAS float*)(lds + wave * 16384);
    unsigned char* ws = a.ws;
    const float* x = a.in[0];
    constexpr int I_W0 = 16 * 160, I_WO0 = 32 * 32, I_W1 = 16 * 80, I_WO1 = 16 * 32, I_WG = 4 * 4 * 8;
    constexpr int NITEMS = I_W0 + I_WO0 + I_W1 + I_WO1 + I_WG;
    for (int it = gw; it < NITEMS; it += NGW) {
        int r = it;
        if (r < I_W0) {
            const int kb = r / 160, nb = r % 160, n0 = nb * 32; int src;
            if (n0 < 2048) { const int pn = n0 >> 8, within = n0 & 255, bj = within >> 7, ch = 128 * pn + (within & 127); src = bj ? 2048 + ch : ch; }
            else if (n0 < 3072) src = 1024 + (n0 - 2048);
            else src = n0;
            transpose_item(a.in[2], 1024, 5120, (bf16*)(ws + WS_W0T), a.in[1], kb * 64, n0, src, false, scr, lane); continue; }
        r -= I_W0;
        if (r < I_WO0) { const int kb = r / 32, nb = r % 32; transpose_item(a.in[8], 2048, 1024, (bf16*)(ws + WS_WO0T), nullptr, kb * 64, nb * 32, nb * 32, false, scr, lane); continue; }
        r -= I_WO0;
        if (r < I_W1) { const int kb = r / 80, nb = r % 80, n0 = nb * 32; const bool pq = (n0 < 1280) && ((n0 & 63) == 0);
            transpose_item(a.in[10], 1024, 2560, (bf16*)(ws + WS_W1T), a.in[9], kb * 64, n0, n0, pq, scr, lane); continue; }
        r -= I_W1;
        if (r < I_WO1) { const int kb = r / 32, nb = r % 32; transpose_item(a.in[12], 1024, 1024, (bf16*)(ws + WS_WO1T), nullptr, kb * 64, nb * 32, nb * 32, false, scr, lane); continue; }
        r -= I_WO1;
        { const int gi = r / 32, rr = r % 32, kb = rr / 8, nb = rr % 8;
          transpose_item(a.in[6] + (size_t)gi * 65536, 256, 256, (bf16*)(ws + WS_WGT) + (size_t)gi * 65536, nullptr, kb * 64, nb * 32, nb * 32, false, scr, lane); }
    }
    {
        bf16* XB = (bf16*)(ws + WS_XB); float* R0 = (float*)(ws + WS_R0);
        for (int m0 = gw; m0 < MTOK; m0 += 4 * NGW) {
            f32x4 v[4][4];
#pragma unroll
            for (int r = 0; r < 4; ++r) { const int m = min(m0 + r * NGW, MTOK - 1); const f32x4* xr = (const f32x4*)(x + (size_t)m * DM) + lane;
#pragma unroll
                for (int j = 0; j < 4; ++j) v[r][j] = __builtin_nontemporal_load(xr + 64 * j); }
#pragma unroll
            for (int r = 0; r < 4; ++r) { const int m = m0 + r * NGW; float s = 0.f;
#pragma unroll
                for (int j = 0; j < 4; ++j) s += (v[r][j].x * v[r][j].x + v[r][j].y * v[r][j].y) + (v[r][j].z * v[r][j].z + v[r][j].w * v[r][j].w);
                s = wave_sum(s);
                if (m < MTOK) {
                    u32x2* o = (u32x2*)(XB + (size_t)m * DM) + lane;
#pragma unroll
                    for (int j = 0; j < 4; ++j) { u32x2 w; w.x = cvtpk(v[r][j].x, v[r][j].y); w.y = cvtpk(v[r][j].z, v[r][j].w); o[64 * j] = w; }
                    if (lane == 0) R0[m] = 1.f / sqrtf(s * (1.f / DM) + EPS);
                } }
        }
    }
    {
        unsigned* T = (unsigned*)(ws + WS_ROPE);
        for (int e = blockIdx.x * 512 + tid; e < SEQ * 8; e += G * 512) {
            const int pos = e >> 3, i = e & 7;
            const float inv = (float)exp2(-(double)i * (18.931568569324174 / 8.0));
            const float ang = (float)pos * inv;
            const double rev = (double)ang * 0.15915494309189535; const double fr = rev - rint(rev);
            const float rf = (float)fr;
            T[e] = (unsigned)__builtin_bit_cast(unsigned short, (_Float16)__builtin_amdgcn_cosf(rf)) | ((unsigned)__builtin_bit_cast(unsigned short, (_Float16)__builtin_amdgcn_sinf(rf)) << 16);
        }
    }
}

#define EPI_ARGS const f32x4 (&acc)[2][2][4][2], const pg8::Unit& u, int wr, int wc, int fr, int fq


struct EpiIn0 {
    static constexpr bool PERM = true, AFTER_DRAIN = false;
    const float* r0; bf16 *UG, *GV, *BX, *BG; float* vss;
    __device__ __forceinline__ void operator()(EPI_ARGS) const {
        const int row0 = u.pm * 256 + wr * 64 + fr, pn = u.pn;
        float rs8[2][4];
#pragma unroll
        for (int ai = 0; ai < 2; ++ai)
#pragma unroll
            for (int m = 0; m < 4; ++m) rs8[ai][m] = r0[row0 + ai * 128 + m * 16];
        if (pn < 8) {
            const int col = 128 * pn + 32 * wc + 8 * fq;
#pragma unroll
            for (int ai = 0; ai < 2; ++ai)
#pragma unroll
                for (int m = 0; m < 4; ++m) { const int row = row0 + ai * 128 + m * 16; const float rs = rs8[ai][m];
                    u32x4 w;
#pragma unroll
                    for (int n = 0; n < 2; ++n) { const f32x4 au = acc[ai][0][m][n] * rs, ag = acc[ai][1][m][n] * rs;
                        const f32x2 o0 = gelu_silu_2((f32x2){au.x, au.y}, (f32x2){ag.x, ag.y}), o1 = gelu_silu_2((f32x2){au.z, au.w}, (f32x2){ag.z, ag.w});
                        w[2 * n] = cvtpk(o0.x, o0.y); w[2 * n + 1] = cvtpk(o1.x, o1.y); }
                    *(u32x4*)(UG + (size_t)row * 1024 + col) = w; }
        } else if (pn < 12) {
            const int col = 256 * (pn - 8) + 32 * wc + 8 * fq;
#pragma unroll
            for (int ai = 0; ai < 2; ++ai)
#pragma unroll
                for (int m = 0; m < 4; ++m) { const int row = row0 + ai * 128 + m * 16; const float rs = rs8[ai][m]; float ss = 0.f;
#pragma unroll
                    for (int bj = 0; bj < 2; ++bj) { u32x4 w;
#pragma unroll
                        for (int n = 0; n < 2; ++n) { const f32x4 av = acc[ai][bj][m][n] * rs;
                            const f32x2 o0 = gelu_2((f32x2){av.x, av.y}), o1 = gelu_2((f32x2){av.z, av.w});
                            const f32x2 q = o0 * o0 + o1 * o1; ss += q.x + q.y;
                            w[2 * n] = cvtpk(o0.x, o0.y); w[2 * n + 1] = cvtpk(o1.x, o1.y); }
                        *(u32x4*)(GV + (size_t)row * 1024 + col + bj * 128) = w; }
                    ss = fq_sum(ss);
                    if (fq == 0) vss[(size_t)row * 16 + (pn - 8) * 4 + wc] = ss; }
        } else {
            const bool isg = pn >= 16; bf16* O = isg ? BG : BX;
            const int col = 256 * (pn - (isg ? 16 : 12)) + 32 * wc + 8 * fq;
#pragma unroll
            for (int ai = 0; ai < 2; ++ai)
#pragma unroll
                for (int m = 0; m < 4; ++m) { const int row = row0 + ai * 128 + m * 16; const float rs = rs8[ai][m];
#pragma unroll
                    for (int bj = 0; bj < 2; ++bj) { u32x4 w;
#pragma unroll
                        for (int n = 0; n < 2; ++n) { const f32x4 av = acc[ai][bj][m][n] * rs;
                            f32x2 o0 = (f32x2){av.x, av.y}, o1 = (f32x2){av.z, av.w};
                            if (isg) { o0 = silu_2(o0); o1 = silu_2(o1); }
                            w[2 * n] = cvtpk(o0.x, o0.y); w[2 * n + 1] = cvtpk(o1.x, o1.y); }
                        *(u32x4*)(O + (size_t)row * 1024 + col + bj * 128) = w; } }
        }
    }
};

template <bool XIN_BF16, bool OUT_F32, bool OUT_BF16>
struct EpiRes {
    static constexpr bool PERM = true, AFTER_DRAIN = false;
    const void* xin; float* xo; bf16* xb; float* ss;
    __device__ __forceinline__ void load_batch(f32x4 (&x)[2][2][2], int row0, int col0, int b) const {
#pragma unroll
        for (int mm = 0; mm < 2; ++mm)
#pragma unroll
            for (int bj = 0; bj < 2; ++bj) { const size_t off = (size_t)(row0 + (b >> 1) * 128 + (2 * (b & 1) + mm) * 16) * 1024 + col0 + bj * 128;
                if (XIN_BF16) { const u32x4 r = *(const u32x4*)((const bf16*)xin + off); x[mm][bj][0] = (f32x4){bflo(r.x), bfhi(r.x), bflo(r.y), bfhi(r.y)}; x[mm][bj][1] = (f32x4){bflo(r.z), bfhi(r.z), bflo(r.w), bfhi(r.w)}; }
                else { x[mm][bj][0] = *(const f32x4*)((const float*)xin + off); x[mm][bj][1] = *(const f32x4*)((const float*)xin + off + 4); } }
    }
    __device__ __forceinline__ void operator()(EPI_ARGS) const {
        const int row0 = u.pm * 256 + wr * 64 + fr, col0 = u.pn * 256 + 32 * wc + 8 * fq;
        f32x4 xa[2][2][2], xb2[2][2][2];
        load_batch(xa, row0, col0, 0);
#pragma unroll
        for (int b = 0; b < 4; ++b) {
            if (b + 1 < 4) { if (b & 1) load_batch(xa, row0, col0, b + 1); else load_batch(xb2, row0, col0, b + 1); }
            const int ai = b >> 1;
#pragma unroll
            for (int mm = 0; mm < 2; ++mm) { const int m = 2 * (b & 1) + mm, row = row0 + ai * 128 + m * 16; float s = 0.f;
#pragma unroll
                for (int bj = 0; bj < 2; ++bj) { const size_t off = (size_t)row * 1024 + col0 + bj * 128;
                    const f32x4 v0 = ((b & 1) ? xb2[mm][bj][0] : xa[mm][bj][0]) + acc[ai][bj][m][0], v1 = ((b & 1) ? xb2[mm][bj][1] : xa[mm][bj][1]) + acc[ai][bj][m][1];
                    if (OUT_F32) { *(f32x4*)(xo + off) = v0; *(f32x4*)(xo + off + 4) = v1; }
                    s += (v0.x * v0.x + v0.y * v0.y) + (v0.z * v0.z + v0.w * v0.w) + (v1.x * v1.x + v1.y * v1.y) + (v1.z * v1.z + v1.w * v1.w);
                    if (OUT_BF16) { u32x4 w; w.x = cvtpk(v0.x, v0.y); w.y = cvtpk(v0.z, v0.w); w.z = cvtpk(v1.x, v1.y); w.w = cvtpk(v1.z, v1.w); *(u32x4*)(xb + off) = w; } }
                s = fq_sum(s);
                if (fq == 0) ss[(size_t)row * 16 + u.pn * 4 + wc] = s; }
        }
    }
};

struct EpiIn1 {
    static constexpr bool PERM = true, AFTER_DRAIN = false;
    const float* ss1; const unsigned* rope; bf16 *Q, *K, *VT, *G;
    __device__ __forceinline__ void operator()(EPI_ARGS) const {
        const int row0 = u.pm * 256 + wr * 64 + fr, pn = u.pn;
        const bool dorope = (pn < 5) && ((wc & 1) == 0) && (fq < 2);
        float rs8[2][4];
        {
            f32x4 part[2][4];
#pragma unroll
            for (int ai = 0; ai < 2; ++ai)
#pragma unroll
                for (int m = 0; m < 4; ++m) part[ai][m] = *(const f32x4*)(ss1 + (size_t)(row0 + ai * 128 + m * 16) * 16 + 4 * fq);
#pragma unroll
            for (int ai = 0; ai < 2; ++ai)
#pragma unroll
                for (int m = 0; m < 4; ++m) { const f32x4 pq = part[ai][m]; rs8[ai][m] = 1.f / sqrtf(fq_sum((pq.x + pq.y) + (pq.z + pq.w)) * (1.f / DM) + EPS); }
        }
        u32x4 cst[2][4];
#pragma unroll
        for (int ai = 0; ai < 2; ++ai)
#pragma unroll
            for (int m = 0; m < 4; ++m) { cst[ai][m] = (u32x4){0x3c00u, 0x3c00u, 0x3c00u, 0x3c00u};
                if (dorope) cst[ai][m] = *(const u32x4*)(rope + (size_t)((row0 + ai * 128 + m * 16) & (SEQ - 1)) * 8 + 4 * fq); }
#pragma unroll
        for (int ai = 0; ai < 2; ++ai)
#pragma unroll
            for (int m = 0; m < 4; ++m) { const int row = row0 + ai * 128 + m * 16;
                const float rs = rs8[ai][m];
                const u32x4 ct = cst[ai][m];
#pragma unroll
                for (int bj = 0; bj < 2; ++bj) {
                    f32x4 z0 = acc[ai][bj][m][0] * rs, z1 = acc[ai][bj][m][1] * rs;
                    const int colt = 128 * bj + 32 * wc + 8 * fq;
                    if (pn < 5) {
                        if (dorope) {
                            float c[4], s[4];
#pragma unroll
                            for (int j = 0; j < 4; ++j) { c[j] = (float)__builtin_bit_cast(_Float16, (unsigned short)(ct[j] & 0xffffu)); s[j] = (float)__builtin_bit_cast(_Float16, (unsigned short)(ct[j] >> 16)); }
#pragma unroll
                            for (int j = 0; j < 4; ++j) { const float a1 = z0[j], a2 = z1[j]; z0[j] = a1 * c[j] - a2 * s[j]; z1[j] = a2 * c[j] + a1 * s[j]; }
                        }
                        if (pn < 4) { z0 = z0 * QSCALE; z1 = z1 * QSCALE; }
                        u32x4 w; w.x = cvtpk(z0.x, z0.y); w.y = cvtpk(z0.z, z0.w); w.z = cvtpk(z1.x, z1.y); w.w = cvtpk(z1.z, z1.w);
                        if (pn < 4) *(u32x4*)(Q + (size_t)row * 1024 + 256 * pn + colt) = w;
                        else        *(u32x4*)(K + (size_t)row * 256 + colt) = w;
                    } else if (pn == 5) {
                        u32x4 w; w.x = cvtpk(z0.x, z0.y); w.y = cvtpk(z0.z, z0.w); w.z = cvtpk(z1.x, z1.y); w.w = cvtpk(z1.z, z1.w);
                        *(u32x4*)(VT + (size_t)row * 256 + colt) = w;
                    } else {
                        const f32x2 s0 = silu_2((f32x2){z0.x, z0.y}), s1 = silu_2((f32x2){z0.z, z0.w}), s2 = silu_2((f32x2){z1.x, z1.y}), s3 = silu_2((f32x2){z1.z, z1.w});
                        u32x4 w; w.x = cvtpk(s0.x, s0.y); w.y = cvtpk(s1.x, s1.y); w.z = cvtpk(s2.x, s2.y); w.w = cvtpk(s3.x, s3.y);
                        *(u32x4*)(G + (size_t)row * 1024 + 256 * (pn - 6) + colt) = w;
                    }
                } }
    }
};

#define MFMA16(a, b, c) __builtin_amdgcn_mfma_f32_16x16x32_bf16((a), (b), (c), 0, 0, 0)

typedef short v4i16_t __attribute__((ext_vector_type(4)));
__device__ __forceinline__ float max3f(float a, float b, float c) { float r; asm("v_max3_f32 %0, %1, %2, %3" : "=v"(r) : "v"(a), "v"(b), "v"(c)); return r; }
__device__ __forceinline__ s16x4 trread(const LAS bf16* p) { return __builtin_bit_cast(s16x4, __builtin_amdgcn_ds_read_tr16_b64_v4i16((LAS v4i16_t*)p)); }
__device__ __forceinline__ bf16x8 cat8(s16x4 a, s16x4 b) { return __builtin_shufflevector(a, b, 0, 1, 2, 3, 4, 5, 6, 7); }

__device__ __forceinline__ int unit_tile(int u) { return 16 * (u & 7) + (u >> 5); }
__device__ __forceinline__ int unit_grp(int u) { return (u >> 3) & 3; }

__device__ __forceinline__ void issue_a(const Args& a, int c, int h, int tid, u32x4 (&pf)[9]) {
    const bf16* GV = (const bf16*)(a.ws + WS_GV);
#pragma unroll
    for (int it = 0; it < 8; ++it) { const int item = it * 512 + tid, cl = item & 31, j = item >> 5; pf[it] = *(const u32x4*)(GV + (size_t)(128 * c + j) * 1024 + 256 * h + 8 * cl); }
}
__device__ __forceinline__ void issue_b(const Args& a, int tt, int g, int tid, u32x4 (&pf)[9]) {
    const int b = tt >> 6, t0 = (tt & 63) * 128;
    const bf16* base = (const bf16*)(a.ws + WS_BX) + (size_t)b * SEQ * 1024 + 256 * g;
#pragma unroll
    for (int it = 0; it < 9; ++it) { const int item = it * 512 + tid, cl = item & 31, rr = item >> 5, pos = t0 - 8 + rr;
        pf[it] = (u32x4){0u, 0u, 0u, 0u};
        if (pos >= 0 && pos < SEQ) pf[it] = *(const u32x4*)(base + (size_t)pos * 1024 + 8 * cl); }
}
__device__ __forceinline__ void issue_next(const Args& a, int nkind, int nidx, int tid, u32x4 (&pf)[9]) {
    if (nkind == 0) issue_a(a, unit_tile(nidx), unit_grp(nidx), tid, pf); else if (nkind == 1) issue_b(a, unit_tile(nidx), unit_grp(nidx), tid, pf);
}

__device__ __forceinline__ void mixer_a_unit(const Args& a, LAS unsigned char* lds, int c, int h, u32x4 (&pf)[9], int nkind, int nidx) {
    int tid_ = threadIdx.x; asm volatile("" : "+v"(tid_));
    const int tid = tid_, lane = tid & 63, w = __builtin_amdgcn_readfirstlane(tid >> 6), fr = lane & 15, fq = lane >> 4;
    constexpr int VS2 = 264, WS_ = 136;
    LAS bf16* V = (LAS bf16*)lds;
    LAS bf16* Ws = (LAS bf16*)(lds + 67584);
    LAS float* rvs = (LAS float*)(lds + 67584 + 34816);
    const unsigned char* ws = a.ws;
    const bf16* UG = (const bf16*)(ws + WS_UG); const float* vss = (const float*)(ws + WS_VSS);
    bf16* Y0 = (bf16*)a.out;
    const float* wsp = a.in[4] + (size_t)h * 16384; const float* bsp = a.in[5] + h * 128; const float* gv = a.in[3];
    f32x4 wsr[8];
#pragma unroll
    for (int it = 0; it < 8; ++it) { const int item = it * 512 + tid, j4 = item & 31, i = item >> 5; wsr[it] = *(const f32x4*)(wsp + i * 128 + 4 * j4); }
    if (tid < 128) rvs[tid] = 1.f / sqrtf(sum16(vss + (size_t)(128 * c + tid) * 16) * (1.f / 1024.f) + EPS);
#pragma unroll
    for (int it = 0; it < 8; ++it) { const int item = it * 512 + tid, cl = item & 31, j = item >> 5; *(LAS u32x4*)(V + j * VS2 + 8 * cl) = pf[it]; }
    issue_next(a, nkind, nidx, tid, pf);
    __syncthreads();
#pragma unroll
    for (int it = 0; it < 8; ++it) { const int item = it * 512 + tid, j4 = item & 31, i = item >> 5;
        const f32x4 r = *(const LAS f32x4*)(rvs + 4 * j4); const f32x4 v = wsr[it];
        u32x2 o; o.x = cvtpk(v.x * r.x, v.y * r.y); o.y = cvtpk(v.z * r.z, v.w * r.w);
        *(LAS u32x2*)(Ws + i * WS_ + 4 * j4) = o; }
    u32x4 ugr[8];
#pragma unroll
    for (int it = 0; it < 8; ++it) ugr[it] = *(const u32x4*)(UG + (size_t)(128 * c + 16 * it + fr) * 1024 + 256 * h + 32 * w + 8 * fq);
    __syncthreads();
    f32x4 acc[2][8];
#pragma unroll
    for (int dt = 0; dt < 2; ++dt)
#pragma unroll
        for (int it = 0; it < 8; ++it) acc[dt][it] = (f32x4){0.f, 0.f, 0.f, 0.f};
    const LAS bf16* vb = V + (8 * fq + ((lane >> 2) & 3)) * VS2 + 32 * w + 8 * (lane & 3);
#pragma unroll
    for (int ks = 0; ks < 4; ++ks) {
        bf16x8 af[2], bfr[8];
#pragma unroll
        for (int dt = 0; dt < 2; ++dt) { const LAS bf16* p = vb + (32 * ks) * VS2 + 4 * dt; af[dt] = cat8(trread(p), trread(p + 4 * VS2)); }
#pragma unroll
        for (int it = 0; it < 8; ++it) bfr[it] = *(const LAS bf16x8*)(Ws + (16 * it + fr) * WS_ + 32 * ks + 8 * fq);
#pragma unroll
        for (int dt = 0; dt < 2; ++dt)
#pragma unroll
            for (int it = 0; it < 8; ++it) acc[dt][it] = MFMA16(af[dt], bfr[it], acc[dt][it]);
    }
    {   const int col = 256 * h + 32 * w + 8 * fq; const f32x4 g0 = *(const f32x4*)(gv + col), g1 = *(const f32x4*)(gv + col + 4);
#pragma unroll
        for (int it = 0; it < 8; ++it) { const int i = 16 * it + fr, row = 128 * c + i; const float bs = bsp[i];
            const u32x4 ug = ugr[it];
            const f32x4 m0 = acc[0][it] * g0 + bs, m1 = acc[1][it] * g1 + bs;
            u32x4 o; o.x = cvtpk(bflo(ug.x) * m0.x, bfhi(ug.x) * m0.y); o.y = cvtpk(bflo(ug.y) * m0.z, bfhi(ug.y) * m0.w); o.z = cvtpk(bflo(ug.z) * m1.x, bfhi(ug.z) * m1.y); o.w = cvtpk(bflo(ug.w) * m1.z, bfhi(ug.w) * m1.w);
            *(u32x4*)(Y0 + (size_t)row * 2048 + col) = o; } }
    __syncthreads();
}

__device__ __forceinline__ void mixer_b_unit(const Args& a, LAS unsigned char* lds, int tt, int g, u32x4 (&pf)[9], int nkind, int nidx) {
    int tid_ = threadIdx.x; asm volatile("" : "+v"(tid_));
    const int tid = tid_, lane = tid & 63, w = __builtin_amdgcn_readfirstlane(tid >> 6), fr = lane & 15, fq = lane >> 4;
    constexpr int PS = 264;
    LAS bf16* Bs = (LAS bf16*)lds;
    LAS bf16* P = (LAS bf16*)(lds + 76032);
    const unsigned char* ws = a.ws;
    const bf16* BG = (const bf16*)(ws + WS_BG); const bf16* WGT = (const bf16*)(ws + WS_WGT) + (size_t)g * 65536;
    bf16* Y0 = (bf16*)a.out; const float* bscale = a.in[7];
    const int b = tt >> 6, t0 = (tt & 63) * 128;
#pragma unroll
    for (int it = 0; it < 9; ++it) { const int item = it * 512 + tid, cl = item & 31, rr = item >> 5; *(LAS u32x4*)(Bs + rr * PS + 8 * cl) = pf[it]; }
    bf16x8 wf[8][2];
#pragma unroll
    for (int ks = 0; ks < 8; ++ks)
#pragma unroll
        for (int et = 0; et < 2; ++et) wf[ks][et] = *(const bf16x8*)(WGT + (size_t)(32 * w + 8 * (fr >> 2) + 4 * et + (fr & 3)) * 256 + 32 * ks + 8 * fq);
    u32x4 bgr[8];
#pragma unroll
    for (int it = 0; it < 8; ++it) bgr[it] = *(const u32x4*)(BG + (size_t)(128 * tt + 16 * it + fr) * 1024 + 256 * g + 32 * w + 8 * fq);
    __syncthreads();
    {
        const int cl = tid & 31, tr = tid >> 5, half = 1 << g;
        const LAS bf16* col = Bs + 8 * cl;
        float s[8];
#pragma unroll
        for (int e = 0; e < 8; ++e) s[e] = 0.f;
        for (int rr = 8 * tr + 8 - half; rr < 8 * tr + 8 + half; ++rr) { const u32x4 r = *(const LAS u32x4*)(col + rr * PS);
#pragma unroll
            for (int e = 0; e < 4; ++e) { s[2 * e] += bflo(r[e]); s[2 * e + 1] += bfhi(r[e]); } }
        for (int k = 0; k < 8; ++k) { const int tl = 8 * tr + k, t = t0 + tl; const int lo = max(t - half, 0), hi = min(t + half, SEQ); const float inv = 1.f / (float)(hi - lo);
            const u32x4 r = *(const LAS u32x4*)(col + (tl + 8) * PS);
            u32x4 o;
#pragma unroll
            for (int e = 0; e < 4; ++e) o[e] = cvtpk(s[2 * e] * inv - bflo(r[e]), s[2 * e + 1] * inv - bfhi(r[e]));
            *(LAS u32x4*)(P + tl * PS + 8 * cl) = o;
            const u32x4 qa = *(const LAS u32x4*)(col + (tl + 8 + half) * PS), qs = *(const LAS u32x4*)(col + (tl + 8 - half) * PS);
#pragma unroll
            for (int e = 0; e < 4; ++e) { s[2 * e] += bflo(qa[e]) - bflo(qs[e]); s[2 * e + 1] += bfhi(qa[e]) - bfhi(qs[e]); } }
    }
    __syncthreads();
    f32x4 acc[2][8];
#pragma unroll
    for (int et = 0; et < 2; ++et)
#pragma unroll
        for (int it = 0; it < 8; ++it) acc[et][it] = (f32x4){0.f, 0.f, 0.f, 0.f};
#pragma unroll
    for (int ks = 0; ks < 8; ++ks) {
        bf16x8 bfr[8];
#pragma unroll
        for (int it = 0; it < 8; ++it) bfr[it] = *(const LAS bf16x8*)(P + (16 * it + fr) * PS + 32 * ks + 8 * fq);
#pragma unroll
        for (int et = 0; et < 2; ++et)
#pragma unroll
            for (int it = 0; it < 8; ++it) acc[et][it] = MFMA16(wf[ks][et], bfr[it], acc[et][it]);
    }
    issue_next(a, nkind, nidx, tid, pf);
    {   const int col = 256 * g + 32 * w + 8 * fq; const f32x4 s0 = *(const f32x4*)(bscale + col), s1 = *(const f32x4*)(bscale + col + 4);
#pragma unroll
        for (int it = 0; it < 8; ++it) { const int row = 128 * tt + 16 * it + fr;
            const u32x4 bg = bgr[it];
            const f32x4 y0 = acc[0][it] * s0, y1 = acc[1][it] * s1;
            u32x4 o; o.x = cvtpk(bflo(bg.x) * y0.x, bfhi(bg.x) * y0.y); o.y = cvtpk(bflo(bg.y) * y0.z, bfhi(bg.y) * y0.w); o.z = cvtpk(bflo(bg.z) * y1.x, bfhi(bg.z) * y1.y); o.w = cvtpk(bflo(bg.w) * y1.z, bfhi(bg.w) * y1.w);
            *(u32x4*)(Y0 + (size_t)row * 2048 + 1024 + col) = o; } }
    __syncthreads();
}

__device__ __forceinline__ void attn_issue(const Args& a, int u, int tid, u32x4 (&kr)[6], u32x4 (&vr)[6]) {
    if (u >= 512) return;
    const int gq = unit_tile(u), b = gq >> 6, qb = gq & 63, kvh = unit_grp(u), kb0 = (qb - 1) * 128;
    const bf16* Kg = (const bf16*)(a.ws + WS_K); const bf16* Vg = (const bf16*)(a.ws + WS_VT);
#pragma unroll
    for (int it = 0; it < 6; ++it) { const int item = it * 512 + tid, ch = item & 7, key = item >> 3; const int pos = kb0 + key;
        kr[it] = (u32x4){0u, 0u, 0u, 0u}; vr[it] = (u32x4){0u, 0u, 0u, 0u};
        if (pos >= 0 && pos < SEQ) { const size_t off = (size_t)(b * SEQ + pos) * 256 + kvh * 64 + 8 * ch; kr[it] = *(const u32x4*)(Kg + off); vr[it] = *(const u32x4*)(Vg + off); } }
}
__device__ __forceinline__ void attn_unit(const Args& a, LAS unsigned char* lds, int b, int qb, int kvh, u32x4 (&kr)[6], u32x4 (&vr)[6], int unext) {
    int tid_ = threadIdx.x; asm volatile("" : "+v"(tid_));
    const int tid = tid_, lane = tid & 63, w = __builtin_amdgcn_readfirstlane(tid >> 6), fr = lane & 15, fq = lane >> 4;
    constexpr int KS = 72, VS = 80;
    LAS bf16* Ks = (LAS bf16*)lds;
    LAS bf16* Vs = (LAS bf16*)(lds + 55296);
    const unsigned char* ws = a.ws;
    const bf16* Qg = (const bf16*)(ws + WS_Q); const bf16* Gg = (const bf16*)(ws + WS_G);
    bf16* Y1 = (bf16*)(a.ws + WS_Y1);
    const int kb0 = (qb - 1) * 128;
    const int head = kvh * 4 + (w >> 1);
    const size_t qbase = (size_t)(b * SEQ + qb * 128 + (w & 1) * 64 + fr) * 1024 + head * 64;
#pragma unroll
    for (int it = 0; it < 6; ++it) { const int item = it * 512 + tid, ch = item & 7, key = item >> 3; *(LAS u32x4*)(Ks + key * KS + 8 * ch) = kr[it];
        const u32x4 v = vr[it]; *(LAS u32x4*)(Vs + key * VS + 8 * ch) = (key & 1) ? (u32x4){v.z, v.w, v.x, v.y} : v; }
    attn_issue(a, unext, tid, kr, vr);
    bf16x8 q0 = *(const bf16x8*)(Qg + qbase + 8 * fq), q1 = *(const bf16x8*)(Qg + qbase + 32 + 8 * fq);
    __syncthreads();
    const float sink2 = a.in[11][head] * LOG2E;
    const bool edge = (qb == 0) || (qb == SEQ / 128 - 1);
    const LAS bf16* vtb = Vs + (4 * fq + ((lane >> 2) & 3)) * VS + 8 * (lane & 3);
    const int vsw = 4 * ((lane >> 2) & 1);
    for (int it = 0; it < 4; ++it) {
        const int rowoff = (w & 1) * 64 + 16 * it;
        const size_t qoff = qbase + (size_t)(16 * it) * 1024;
        const u32x4 g0 = *(const u32x4*)(Gg + qoff + 8 * fq), g1 = *(const u32x4*)(Gg + qoff + 32 + 8 * fq);
        const bf16x8 qa = q0, qb2 = q1;
        if (it < 3) { q0 = *(const bf16x8*)(Qg + qoff + 16 * 1024 + 8 * fq); q1 = *(const bf16x8*)(Qg + qoff + 16 * 1024 + 32 + 8 * fq); }
        const int kt0 = (rowoff >> 4) & ~1;
        f32x4 S[18];
        const LAS bf16* kpb = Ks + (16 * kt0 + fr) * KS + 8 * fq;
#pragma unroll
        for (int j = 0; j < 18; ++j) { const LAS bf16* kp = kpb + j * (16 * KS);
            f32x4 s = {0.f, 0.f, 0.f, 0.f};
            s = MFMA16(*(const LAS bf16x8*)kp, qa, s); s = MFMA16(*(const LAS bf16x8*)(kp + 32), qb2, s); S[j] = s;
            }
        const int qpos = qb * 128 + rowoff + fr, kbase = kb0 + 16 * kt0 + 4 * fq;
        const int klo = max(qpos - 128, 0), khi = min(qpos + 128, SEQ - 1);
        int mbase = kbase - klo; const unsigned mspan = (unsigned)(khi - klo);
        asm volatile("" : "+v"(mbase));
#define ATT_MASK_TILE(j) do { _Pragma("unroll") for (int r = 0; r < 4; ++r) { const bool ok = (unsigned)(mbase + (16 * (j) + r)) <= mspan; S[j][r] = ok ? S[j][r] : -1e30f; } } while (0)
        if (edge) {
#pragma unroll
            for (int j = 0; j < 18; ++j) ATT_MASK_TILE(j);
        } else {
            ATT_MASK_TILE(0); ATT_MASK_TILE(1); ATT_MASK_TILE(16); ATT_MASK_TILE(17);
        }
#undef ATT_MASK_TILE
        float mx = sink2;
#pragma unroll
        for (int j = 0; j < 18; ++j) { mx = max3f(mx, S[j][0], S[j][1]); mx = max3f(mx, S[j][2], S[j][3]); }
        mx = fq_max(mx);
        f32x2 l2 = {0.f, 0.f};
#pragma unroll
        for (int j = 0; j < 18; ++j) { const f32x2 p0 = exp2_2((f32x2){S[j][0], S[j][1]} - mx), p1 = exp2_2((f32x2){S[j][2], S[j][3]} - mx);
            S[j] = (f32x4){p0.x, p0.y, p1.x, p1.y}; l2 += p0 + p1; }
        float l = l2.x + l2.y;
        l = fq_sum(l);
        l += fast_exp2(sink2 - mx);
        const float rl = 1.f / l;
        const LAS bf16* vpb = vtb + (16 * kt0) * VS;
        f32x4 O[4];
#pragma unroll
        for (int dt = 0; dt < 4; ++dt) O[dt] = (f32x4){0.f, 0.f, 0.f, 0.f};
#pragma unroll
        for (int jp = 0; jp < 9; ++jp) {
            u32x4 pw; pw.x = cvtpk(S[2 * jp][0], S[2 * jp][1]); pw.y = cvtpk(S[2 * jp][2], S[2 * jp][3]); pw.z = cvtpk(S[2 * jp + 1][0], S[2 * jp + 1][1]); pw.w = cvtpk(S[2 * jp + 1][2], S[2 * jp + 1][3]);
            const bf16x8 pf = __builtin_bit_cast(bf16x8, pw);
            const LAS bf16* vp = vpb + jp * (32 * VS);
#pragma unroll
            for (int dt = 0; dt < 4; ++dt) { const LAS bf16* p = vp + 32 * (dt >> 1) + ((dt & 1) ? 4 - vsw : vsw);
                O[dt] = MFMA16(cat8(trread(p), trread(p + 16 * VS)), pf, O[dt]); }
        }
        {
            const f32x4 a0 = O[0] * rl, a1 = O[1] * rl, a2 = O[2] * rl, a3 = O[3] * rl;
            u32x4 o0, o1;
            o0.x = cvtpk(a0.x * bflo(g0.x), a0.y * bfhi(g0.x)); o0.y = cvtpk(a0.z * bflo(g0.y), a0.w * bfhi(g0.y)); o0.z = cvtpk(a1.x * bflo(g0.z), a1.y * bfhi(g0.z)); o0.w = cvtpk(a1.z * bflo(g0.w), a1.w * bfhi(g0.w));
            o1.x = cvtpk(a2.x * bflo(g1.x), a2.y * bfhi(g1.x)); o1.y = cvtpk(a2.z * bflo(g1.y), a2.w * bfhi(g1.y)); o1.z = cvtpk(a3.x * bflo(g1.z), a3.y * bfhi(g1.z)); o1.w = cvtpk(a3.z * bflo(g1.w), a3.w * bfhi(g1.w));
            *(u32x4*)(Y1 + qoff + 8 * fq) = o0; *(u32x4*)(Y1 + qoff + 32 + 8 * fq) = o1;
        }
    }
    __syncthreads();
}

#define RLX_AGENT __ATOMIC_RELAXED, __HIP_MEMORY_SCOPE_AGENT
#define XB_TMO      128
#define XB_XCNT(j)  (256  + 64 * (j))
#define XB_XSUB(j)  (1280 + 64 * (j))
#define XB_XGEN(j)  (2304 + 64 * (j))
#define XB_TOP      3328
#define XB_TOPGEN   3392
#define XCD_BAR_WORDS 3456
#define XB_SPIN_CAP (1u << 18)

__device__ __forceinline__ unsigned xb_ld(unsigned* p)              { return __hip_atomic_load(p, __ATOMIC_RELAXED, __HIP_MEMORY_SCOPE_AGENT); }
__device__ __forceinline__ unsigned xb_add(unsigned* p, unsigned v) { return __hip_atomic_fetch_add(p, v, __ATOMIC_RELAXED, __HIP_MEMORY_SCOPE_AGENT); }
__device__ __forceinline__ unsigned xb_xcc_id() { return (unsigned)__builtin_amdgcn_s_getreg((3 << 11) | 20) & 0xFu; }
#define XB_SPIN(cond, bar) do { unsigned _sp = 0; while (cond) { __builtin_amdgcn_s_sleep(1); \
    if ((++_sp & 255u) == 0u) { if (xb_ld(&(bar)[XB_TMO])) break; if (_sp > XB_SPIN_CAP) { atomicAdd(&(bar)[XB_TMO], 1u); break; } } } } while (0)

struct XcdBarrier {
    unsigned* bar; unsigned x;
    volatile LAS unsigned* st;
};

__device__ __forceinline__ XcdBarrier xcd_barrier_post(unsigned* bar, volatile LAS unsigned* st) {
    XcdBarrier b; b.bar = bar; b.x = xb_xcc_id(); b.st = st;
    if (threadIdx.x == 0) (void)xb_add(&bar[XB_XCNT(b.x)], 1u);
    return b;
}
__device__ __forceinline__ void xcd_barrier_complete(unsigned* bar, unsigned x, unsigned& nloc, unsigned& nx) {
    const unsigned G = gridDim.x * gridDim.y * gridDim.z;
    unsigned sum, cnt, mine, sp = 0u;
    for (;;) {
        sum = 0u; cnt = 0u; mine = 0u;
#pragma unroll
        for (unsigned j = 0; j < 16; ++j) { const unsigned c = xb_ld(&bar[XB_XCNT(j)]); sum += c; cnt += (c > 0u) ? 1u : 0u; mine = (j == x) ? c : mine; }
        if (sum == G) break;
        __builtin_amdgcn_s_sleep(1);
        if ((++sp & 255u) == 0u) { if (xb_ld(&bar[XB_TMO])) break; if (sp > XB_SPIN_CAP) { atomicAdd(&bar[XB_TMO], 1u); break; } }
    }
    nloc = mine > 0u ? mine : 1u; nx = cnt > 0u ? cnt : 1u;
}

__device__ __forceinline__ void xcd_barrier(const XcdBarrier& b) {
    asm volatile("s_waitcnt vmcnt(0)" ::: "memory");
    __syncthreads();
    if (threadIdx.x == 0) {
        unsigned* bar = b.bar;
        __builtin_amdgcn_s_waitcnt(0);
        unsigned nloc = b.st[0], nx = b.st[1];
        if (nloc == 0u) { xcd_barrier_complete(bar, b.x, nloc, nx); b.st[0] = nloc; b.st[1] = nx; }
        const unsigned old = xb_add(&bar[XB_XSUB(b.x)], 1u);
        const unsigned gen = old / nloc;
        if (old + 1u == (gen + 1u) * nloc) {
            __builtin_amdgcn_fence(__ATOMIC_RELEASE, "agent");
            asm volatile("s_waitcnt vmcnt(0)" ::: "memory");
            const unsigned og = xb_add(&bar[XB_TOP], 1u);
            const unsigned tg = og / nx;
            if (og + 1u == (tg + 1u) * nx) xb_add(&bar[XB_TOPGEN], 1u);
            else XB_SPIN(xb_ld(&bar[XB_TOPGEN]) == tg, bar);
            __builtin_amdgcn_fence(__ATOMIC_ACQUIRE, "agent");
            xb_add(&bar[XB_XGEN(b.x)], 1u);
            asm volatile("s_waitcnt vmcnt(0)" ::: "memory");
        } else {
            XB_SPIN(xb_ld(&bar[XB_XGEN(b.x)]) == gen, bar);
            __builtin_amdgcn_fence(__ATOMIC_ACQUIRE, "agent");
            asm volatile("s_waitcnt vmcnt(0)" ::: "memory");
        }
    }
    __syncthreads();
}

#define XB_MISMATCH 192
__device__ __forceinline__ void xcd_local_barrier(const XcdBarrier& b) {
    asm volatile("s_waitcnt vmcnt(0)" ::: "memory");
    __syncthreads();
    if (threadIdx.x == 0) {
        unsigned* bar = b.bar;
        __builtin_amdgcn_s_waitcnt(0);
        const unsigned nloc = b.st[0];
        const unsigned old = xb_add(&bar[XB_XSUB(b.x)], 1u);
        const unsigned gen = old / nloc;
        if (old + 1u == (gen + 1u) * nloc) xb_add(&bar[XB_XGEN(b.x)], 1u);
        else XB_SPIN(xb_ld(&bar[XB_XGEN(b.x)]) == gen, bar);
        __builtin_amdgcn_fence(__ATOMIC_ACQUIRE, "agent");
        asm volatile("s_waitcnt vmcnt(0)" ::: "memory");
    }
    __syncthreads();
}

__device__ __forceinline__ void xcd_barrier_arrive(const XcdBarrier& b) {
    asm volatile("s_waitcnt vmcnt(0)" ::: "memory");
    __syncthreads();
    if (threadIdx.x == 0) {
        unsigned* bar = b.bar;
        __builtin_amdgcn_s_waitcnt(0);
        const unsigned nloc = b.st[0], nx = b.st[1];
        const unsigned old = xb_add(&bar[XB_XSUB(b.x)], 1u);
        const unsigned gen = old / nloc;
        if (old + 1u == (gen + 1u) * nloc) {
            __builtin_amdgcn_fence(__ATOMIC_RELEASE, "agent");
            asm volatile("s_waitcnt vmcnt(0)" ::: "memory");
            const unsigned og = xb_add(&bar[XB_TOP], 1u);
            const unsigned tg = og / nx;
            if (og + 1u == (tg + 1u) * nx) xb_add(&bar[XB_TOPGEN], 1u);
            xb_add(&bar[XB_XGEN(b.x)], 1u);
        } else {
            XB_SPIN(xb_ld(&bar[XB_XGEN(b.x)]) == gen, bar);
        }
        __builtin_amdgcn_fence(__ATOMIC_ACQUIRE, "agent");
        asm volatile("s_waitcnt vmcnt(0)" ::: "memory");
    }
    __syncthreads();
}
__device__ __forceinline__ void xcd_barrier_wait_top(const XcdBarrier& b, unsigned target) {
    if (threadIdx.x == 0) {
        unsigned* bar = b.bar;
        XB_SPIN(xb_ld(&bar[XB_TOPGEN]) < target, bar);
        __builtin_amdgcn_fence(__ATOMIC_ACQUIRE, "agent");
        asm volatile("s_waitcnt vmcnt(0)" ::: "memory");
    }
    __syncthreads();
}

constexpr size_t WS_BAR = 22 * MiB + 256 * 1024;
constexpr int LDS_ST_OFF = 147392;

__device__ __forceinline__ XcdBarrier mkbar(const Args& a, LAS unsigned char* lds) { XcdBarrier b; b.bar = (unsigned*)(a.ws + WS_BAR); b.x = xb_xcc_id(); b.st = (volatile LAS unsigned*)(lds + LDS_ST_OFF); return b; }

struct EpiFinal {
    static constexpr bool PERM = true, AFTER_DRAIN = true;
    const bf16* x1b; float* out; float* ss; const float* gfin; unsigned char* wsb; int fast;
    __device__ __forceinline__ void fused(const f32x4 (&acc)[2][2][4][2], const pg8::Unit& u, int wr, int wc, int fr, int fq, LAS unsigned char* lds, int wid, int lane) const {
        const int row0 = u.pm * 256 + wr * 64 + fr, col0 = u.pn * 256 + 32 * wc + 8 * fq;
        f32x4 v[2][4][2][2];
#pragma unroll
        for (int ai = 0; ai < 2; ++ai)
#pragma unroll
            for (int m = 0; m < 4; ++m) { const int row = row0 + ai * 128 + m * 16; float s = 0.f;
#pragma unroll
                for (int bj = 0; bj < 2; ++bj) { const size_t off = (size_t)row * 1024 + col0 + bj * 128;
                    const u32x4 r = *(const u32x4*)(x1b + off);
                    const f32x4 v0 = (f32x4){bflo(r.x), bfhi(r.x), bflo(r.y), bfhi(r.y)} + acc[ai][bj][m][0], v1 = (f32x4){bflo(r.z), bfhi(r.z), bflo(r.w), bfhi(r.w)} + acc[ai][bj][m][1];
                    v[ai][m][bj][0] = v0; v[ai][m][bj][1] = v1;
                    s += (v0.x * v0.x + v0.y * v0.y) + (v0.z * v0.z + v0.w * v0.w) + (v1.x * v1.x + v1.y * v1.y) + (v1.z * v1.z + v1.w * v1.w); }
                s = fq_sum(s);
                if (fq == 0) ss[(size_t)row * 16 + u.pn * 4 + wc] = s; }
        { XcdBarrier b; b.bar = (unsigned*)(wsb + WS_BAR); b.x = xb_xcc_id(); b.st = (volatile LAS unsigned*)(lds + LDS_ST_OFF); if (fast) xcd_local_barrier(b); else xcd_barrier(b); }
        f32x4 g[2][2];
#pragma unroll
        for (int bj = 0; bj < 2; ++bj) { g[bj][0] = *(const f32x4*)(gfin + col0 + bj * 128); g[bj][1] = *(const f32x4*)(gfin + col0 + bj * 128 + 4); }
#pragma unroll
        for (int ai = 0; ai < 2; ++ai)
#pragma unroll
            for (int m = 0; m < 4; ++m) { const int row = row0 + ai * 128 + m * 16;
                const float rs = 1.f / sqrtf(sum16(ss + (size_t)row * 16) * (1.f / DM) + EPS);
#pragma unroll
                for (int bj = 0; bj < 2; ++bj) { const size_t off = (size_t)row * 1024 + col0 + bj * 128;
                    *(f32x4*)(out + off) = v[ai][m][bj][0] * rs * g[bj][0]; *(f32x4*)(out + off + 4) = v[ai][m][bj][1] * rs * g[bj][1]; } }
    }
};

#ifndef PH
#define PH 0xFF
#endif
__global__ void __launch_bounds__(512, 2) fwd_megakernel(Args a) {
    extern __shared__ __attribute__((aligned(16))) unsigned char lds_raw[];
    LAS unsigned char* lds = (LAS unsigned char*)lds_raw;
    cg::grid_group grid = cg::this_grid();
    unsigned char* ws = a.ws;
    const int G = gridDim.x, bid = blockIdx.x;

    volatile LAS unsigned* st = (volatile LAS unsigned*)(lds + LDS_ST_OFF);
    unsigned* barw = (unsigned*)(ws + WS_BAR);
    if (threadIdx.x < 4) st[threadIdx.x] = 0u;
    __syncthreads();
    (void)xcd_barrier_post(barw, st);
    if (threadIdx.x == 0) atomicOr(barw + 64 + (bid & 7), 1u << xb_xcc_id());
    if (a.use_cg_sync) grid.sync();
#if (PH >> 0) & 1
    p0_prep(a, lds);
#ifdef DUP_P0
    p0_prep(a, lds);
#endif
#endif
    xcd_barrier(mkbar(a, lds));
    bool fast = (G == 256);
#pragma unroll
    for (int g8 = 0; g8 < 8; ++g8) { const unsigned m = (unsigned)__builtin_amdgcn_readfirstlane((int)xb_ld(barw + 64 + g8)); fast = fast && (m != 0u) && ((m & (m - 1u)) == 0u); }
#ifdef PROBE_FAST
    if (!fast) return;
#endif
#define LOCAL_BAR() do { if (fast) xcd_local_barrier(mkbar(a, lds)); else xcd_barrier(mkbar(a, lds)); } while (0)
#ifdef DUP_BAR
#define GRID_BAR() do { xcd_barrier(mkbar(a, lds)); xcd_barrier(mkbar(a, lds)); } while (0)
#else
#define GRID_BAR() xcd_barrier(mkbar(a, lds))
#endif
#if (PH >> 1) & 1
    {
        pg8::Gemm g{(const bf16*)(ws + WS_XB), (const bf16*)(ws + WS_W0T), MTOK, 5120, 1024}; pg8::StaticOrder S; S.init(MTOK, 5120, G, bid);
        EpiIn0 E{(const float*)(ws + WS_R0), (bf16*)(ws + WS_UG), (bf16*)(ws + WS_GV), (bf16*)(ws + WS_BX), (bf16*)(ws + WS_BG), (float*)(ws + WS_VSS)};
        pg8::gemm_phase<EpiIn0, pg8::StaticOrder, true, true>(lds, g, S, E);
    }
#endif
    if (fast) xcd_barrier_arrive(mkbar(a, lds)); else xcd_barrier(mkbar(a, lds));
#if (PH >> 2) & 1
    {
        u32x4 pf[9];
        int tid_ = threadIdx.x; asm volatile("" : "+v"(tid_));
        int kind = 0, idx = bid;
        if (idx >= 512) kind = 2;
        issue_next(a, kind, idx, tid_, pf);
        while (kind < 2) {
            int nkind = kind, nidx = idx + G;
            if (nidx >= 512) { nkind = kind + 1; nidx = bid; }
            if (fast && kind == 0 && nkind == 1) xcd_barrier_wait_top(mkbar(a, lds), 2u);
            if (kind == 0) mixer_a_unit(a, lds, unit_tile(idx), unit_grp(idx), pf, nkind, nidx);
            else           mixer_b_unit(a, lds, unit_tile(idx), unit_grp(idx), pf, nkind, nidx);
            kind = nkind; idx = nidx;
        }
    }
#endif
    LOCAL_BAR();
#if (PH >> 3) & 1
    {
        pg8::Gemm g{(const bf16*)a.out, (const bf16*)(ws + WS_WO0T), MTOK, 1024, 2048}; pg8::StaticOrder S; S.init(MTOK, 1024, G, bid);
        typedef EpiRes<true, false, true> Epi3;
        Epi3 E{(const void*)(ws + WS_XB), nullptr, (bf16*)(ws + WS_XB), (float*)(ws + WS_SS1)};
        pg8::gemm_phase<Epi3, pg8::StaticOrder, true, true>(lds, g, S, E);
#ifdef DUP_G2
        pg8::gemm_phase<Epi3, pg8::StaticOrder, true, true>(lds, g, S, E);
#endif
    }
#endif
    LOCAL_BAR();
#if (PH >> 4) & 1
    {
        pg8::Gemm g{(const bf16*)(ws + WS_XB), (const bf16*)(ws + WS_W1T), MTOK, 2560, 1024}; pg8::StaticOrder S; S.init(MTOK, 2560, G, bid);
        EpiIn1 E{(const float*)(ws + WS_SS1), (const unsigned*)(ws + WS_ROPE), (bf16*)(ws + WS_Q), (bf16*)(ws + WS_K), (bf16*)(ws + WS_VT), (bf16*)(ws + WS_G)};
        pg8::gemm_phase<EpiIn1, pg8::StaticOrder, true, true>(lds, g, S, E);
#ifdef DUP_G3
        pg8::gemm_phase<EpiIn1, pg8::StaticOrder, true, true>(lds, g, S, E);
#endif
    }
#endif
    GRID_BAR();
#if (PH >> 5) & 1
#ifndef DUP_ATT
#define DUP_ATT 1
#endif
    {
        u32x4 kr[6], vr[6];
        int tid_ = threadIdx.x; asm volatile("" : "+v"(tid_));
        attn_issue(a, bid, tid_, kr, vr);
        for (int u = bid; u < 512; u += G) attn_unit(a, lds, unit_tile(u) >> 6, unit_tile(u) & 63, unit_grp(u), kr, vr, u + G);
    }
#endif
    LOCAL_BAR();
#if (PH >> 6) & 1
    if (G == 256) {
        pg8::Gemm g{(const bf16*)(ws + WS_Y1), (const bf16*)(ws + WS_WO1T), MTOK, 1024, 1024}; pg8::StaticOrder S; S.init(MTOK, 1024, G, bid);
        EpiFinal E{(const bf16*)(ws + WS_XB), a.out, (float*)(ws + WS_SS2), a.in[13], a.ws, fast ? 1 : 0};
        pg8::gemm_phase<EpiFinal, pg8::StaticOrder, false, true>(lds, g, S, E);
#ifdef DUP_G4
        pg8::gemm_phase<EpiFinal, pg8::StaticOrder, false, true>(lds, g, S, E);
#endif
    } else {
        {
            pg8::Gemm g{(const bf16*)(ws + WS_Y1), (const bf16*)(ws + WS_WO1T), MTOK, 1024, 1024}; pg8::StaticOrder S; S.init(MTOK, 1024, G, bid);
            typedef EpiRes<true, true, false> Epi6;
            Epi6 E{(const void*)(ws + WS_XB), a.out, nullptr, (float*)(ws + WS_SS2)};
            pg8::gemm_phase<Epi6, pg8::StaticOrder, true, true>(lds, g, S, E);
        }
        GRID_BAR();
        int tid_ = threadIdx.x; asm volatile("" : "+v"(tid_));
        const int tid = tid_, lane = tid & 63, wave = __builtin_amdgcn_readfirstlane(tid >> 6), gw = bid * 8 + wave, NGW = G * 8;
        const float* ss2 = (const float*)(ws + WS_SS2); const f32x4* fn = (const f32x4*)a.in[13] + lane;
        f32x4 gn[4];
#pragma unroll
        for (int j = 0; j < 4; ++j) gn[j] = fn[64 * j];
        for (int m = gw; m < MTOK; m += NGW) {
            const float rs = 1.f / sqrtf(sum16(ss2 + (size_t)m * 16) * (1.f / DM) + EPS);
            f32x4* xr = (f32x4*)(a.out + (size_t)m * DM) + lane;
#pragma unroll
            for (int j = 0; j < 4; ++j) xr[64 * j] = xr[64 * j] * rs * gn[j];
        }
    }
#endif
}

extern "C" void kernel_launch(void* const* d_in, const int* in_sizes, int n_in, void* d_out, int out_size, void* d_ws, size_t ws_size, hipStream_t stream) {
    static int grid = 0;
    if (grid == 0) {
        if (n_in != 14 || out_size != MTOK * DM || ws_size < WS_END) { fprintf(stderr, "kernel_launch: unexpected problem shape (n_in %d out %d ws %zu)\n", n_in, out_size, ws_size); grid = -1; return; }
        int dev = 0, cus = 0, per_cu = 0;
        hipGetDevice(&dev);
        hipDeviceGetAttribute(&cus, hipDeviceAttributeMultiprocessorCount, dev);
        if (hipFuncSetAttribute((const void*)fwd_megakernel, hipFuncAttributeMaxDynamicSharedMemorySize, LDS_BYTES) != hipSuccess) { fprintf(stderr, "kernel_launch: hipFuncSetAttribute failed\n"); grid = -1; return; }
        if (hipOccupancyMaxActiveBlocksPerMultiprocessor(&per_cu, (const void*)fwd_megakernel, 512, LDS_BYTES) != hipSuccess || per_cu < 1) { fprintf(stderr, "kernel_launch: occupancy query failed (%d)\n", per_cu); (void)hipGetLastError(); grid = -1; return; }
        grid = cus * per_cu;
    }
    if (grid < 0) return;
    if (hipMemsetAsync((char*)d_ws + WS_BAR, 0, XCD_BAR_WORDS * 4, stream) != hipSuccess) { fprintf(stderr, "kernel_launch: hipMemsetAsync failed\n"); return; }
    Args a{};
    for (int i = 0; i < 14; ++i) a.in[i] = (const float*)d_in[i];
    a.out = (float*)d_out; a.ws = (unsigned char*)d_ws;
    void* args[] = {&a};
    hipError_t e = hipLaunchCooperativeKernel((const void*)fwd_megakernel, dim3(grid), dim3(512), args, LDS_BYTES, stream);
    if (e != hipSuccess) fprintf(stderr, "kernel_launch: cooperative launch failed: %s (grid %d)\n", hipGetErrorString(e), grid);
}
```

```cpp
#include <hip/hip_runtime.h>
#include <hip/hip_cooperative_groups.h>
#include <cstdio>
#include <cstdint>
namespace cg = cooperative_groups;
namespace pg8 {
#define PG8_LAS __attribute__((address_space(3)))
typedef unsigned short bf16_t;
typedef short bf16x8 __attribute__((ext_vector_type(8)));
typedef float f32x4 __attribute__((ext_vector_type(4)));
typedef unsigned u32x4 __attribute__((ext_vector_type(4)));
constexpr int BM = 256, BK = 64, HALF = 128, HTB = HALF * BK * 2  , STAGE_BYTES = 8 * HTB, NXCD = 8, WGM = 4;

__host__ __device__ __forceinline__ int lds_byte(int r, int c) { const int st = (r >> 4) * 2 + (c >> 5), rr = r & 15, cc = c & 31, ob = rr * 64 + cc * 2; return st * 1024 + (ob ^ (((ob >> 9) & 1) << 5)); }
__host__ __device__ __forceinline__ void stage_rc(int b, int& R, int& C) { const int st = b / 1024, sb = b % 1024, swz = sb ^ (((sb >> 9) & 1) << 5); R = (st >> 1) * 16 + swz / 64; C = (st & 1) * 32 + (swz % 64) / 2; }
__host__ __device__ __forceinline__ int perm32(int rho) { const int n = rho >> 4, i = rho & 15; return 8 * (i >> 2) + 4 * n + (i & 3); }

struct Unit { int pm, pn; };
struct Gemm { const bf16_t* A; const bf16_t* Bt; int M, N, K; };

struct StaticOrder {
    int nM, nN, nwg, G, c;
    __host__ __device__ void init(int M, int N, int G_, int c_) { nM = M / BM; nN = N / BM; nwg = nM * nN; G = G_; c = c_; }
    __host__ __device__ bool next(int i, Unit& u) const {
        const long L = (long)i * G + c; if (L >= nwg) return false;
        int wgid = (int)L; { const int q = nwg / NXCD, r = nwg % NXCD, xcd = wgid % NXCD, off = wgid / NXCD; wgid = (xcd < r ? xcd * (q + 1) : r * (q + 1) + (xcd - r) * q) + off; }
        const int nig = WGM * nN, gid = wgid / nig, fm = gid * WGM, gsz = (nM - fm) < WGM ? (nM - fm) : WGM;
        u.pm = fm + ((wgid % nig) % gsz); u.pn = (wgid % nig) / gsz; return true;
    }
    __device__ __forceinline__ void a_ready(const Unit&) const {}
    __device__ __forceinline__ void done(const Unit&) const {}
};

__device__ __forceinline__ unsigned cvt_pk_bf16(float lo, float hi) { unsigned r; asm volatile("v_cvt_pk_bf16_f32 %0, %1, %2" : "=v"(r) : "v"(lo), "v"(hi)); return r; }
template <class Epi, class Sched, bool ALIGN_EPI = false, bool SP2 = false>
__device__ __forceinline__ void gemm_phase(PG8_LAS unsigned char* lds, const Gemm g, const Sched& S, const Epi& E) {
    int tid_ = threadIdx.x; asm volatile("" : "+v"(tid_));
    const int tid = tid_, wid = __builtin_amdgcn_readfirstlane(tid >> 6), lane = tid & 63, wr = wid >> 2, wc = wid & 3, fr = lane & 15, fq = lane >> 4;
    const int K = g.K, nt = K / BK;
    unsigned voffA[2], voffB[2];
#pragma unroll
    for (int i = 0; i < 2; ++i) { int R, C; stage_rc(tid * 16 + i * 8192, R, C); const int Rb = Epi::PERM ? ((R & ~31) + perm32(R & 31)) : R;
        voffA[i] = (unsigned)(R * K + C) * 2u; voffB[i] = (unsigned)(Rb * K + C) * 2u; }
    const size_t kstep = (size_t)(BK * 2);
    const size_t hstep = (size_t)HALF * K * 2;
    const size_t tstep = 2 * hstep;
    const unsigned ldsw = (unsigned)wid * 1024u;
    const int aoff = lds_byte(wr * 64 + fr, fq * 8), boff = lds_byte(wc * 32 + fr, fq * 8);
#define PG8_SA(b, h) (((b) * 2 + (h)) * HTB)
#define PG8_SB(b, h) ((4 + (b) * 2 + (h)) * HTB)
#define PG8_STAGE(bufoff, gbase, voff) do { _Pragma("unroll") for (int _i = 0; _i < 2; ++_i) \
        __builtin_amdgcn_global_load_lds((const unsigned*)((const char*)(gbase) + (voff)[_i]), (PG8_LAS unsigned*)(lds + (bufoff) + ldsw + _i * 8192), 16, 0, 0); } while (0)
#define PG8_LDA(dst, b, h) do { _Pragma("unroll") for (int m = 0; m < 4; ++m) _Pragma("unroll") for (int k = 0; k < 2; ++k) dst[m][k] = *(const PG8_LAS bf16x8*)(lds + PG8_SA(b, h) + aoff + m * 2048 + k * 1024); } while (0)
#define PG8_LDB(dst, b, h) do { _Pragma("unroll") for (int n = 0; n < 2; ++n) _Pragma("unroll") for (int k = 0; k < 2; ++k) dst[n][k] = *(const PG8_LAS bf16x8*)(lds + PG8_SB(b, h) + boff + n * 2048 + k * 1024); } while (0)
#define PG8_MMA(ai, bj, At, Bt) do { __builtin_amdgcn_s_setprio(1); _Pragma("unroll") for (int m = 0; m < 4; ++m) _Pragma("unroll") for (int n = 0; n < 2; ++n) _Pragma("unroll") for (int k = 0; k < 2; ++k) \
        acc[ai][bj][m][n] = __builtin_amdgcn_mfma_f32_16x16x32_bf16(Bt[n][k], At[m][k], acc[ai][bj][m][n], 0, 0, 0); __builtin_amdgcn_s_setprio(0); } while (0)
#define PG8_WAIT_V(n) asm volatile("s_waitcnt vmcnt(" #n ")" ::: "memory")
#define PG8_WAIT_L(n) asm volatile("s_waitcnt lgkmcnt(" #n ")" ::: "memory")
#define PG8_BAR __builtin_amdgcn_s_barrier()
#define PG8_SCHED __builtin_amdgcn_sched_barrier(0)
    Unit cur, nxt; int ui = 0;
    if (!S.next(0, cur)) return;
    f32x4 acc[2][2][4][2];
#pragma unroll
    for (int a = 0; a < 2; ++a)
#pragma unroll
        for (int b = 0; b < 2; ++b)
#pragma unroll
            for (int m = 0; m < 4; ++m)
#pragma unroll
                for (int n = 0; n < 2; ++n) acc[a][b][m][n] = (f32x4){0.f, 0.f, 0.f, 0.f};
    bf16x8 At[4][2], B0[2][2], B1[2][2];
    const char* cA = (const char*)g.A + (size_t)cur.pm * tstep; const char* cB = (const char*)g.Bt + (size_t)cur.pn * tstep;
    S.a_ready(cur);
    if constexpr (SP2) {
        PG8_STAGE(PG8_SB(0, 0), cB, voffB); PG8_STAGE(PG8_SB(0, 1), cB + hstep, voffB); PG8_STAGE(PG8_SA(0, 0), cA, voffA); PG8_STAGE(PG8_SA(0, 1), cA + hstep, voffA);
        if (wr == 1) PG8_BAR;
        PG8_WAIT_V(2); PG8_BAR;
        PG8_STAGE(PG8_SB(1, 0), cB + kstep, voffB); PG8_STAGE(PG8_SA(1, 0), cA + kstep, voffA); PG8_STAGE(PG8_SB(1, 1), cB + hstep + kstep, voffB);
        PG8_WAIT_V(6); PG8_BAR;
    } else {
        PG8_STAGE(PG8_SB(0, 0), cB, voffB); PG8_STAGE(PG8_SA(0, 0), cA, voffA); PG8_STAGE(PG8_SB(0, 1), cB + hstep, voffB); PG8_STAGE(PG8_SA(0, 1), cA + hstep, voffA);
        if (wr == 1) PG8_BAR;
        PG8_WAIT_V(4); PG8_BAR;
        PG8_STAGE(PG8_SB(1, 0), cB + kstep, voffB); PG8_STAGE(PG8_SA(1, 0), cA + kstep, voffA); PG8_STAGE(PG8_SB(1, 1), cB + hstep + kstep, voffB);
        PG8_WAIT_V(6); PG8_BAR;
    }
    for (;;) {
        const bool has_next = S.next(ui + 1, nxt);
        const char* nA = has_next ? (const char*)g.A + (size_t)nxt.pm * tstep : cA; const char* nB = has_next ? (const char*)g.Bt + (size_t)nxt.pn * tstep : cB;
        for (int t = 0; t < nt; t += 2) {
            const bool last = (t == nt - 2);
            const char* a1 = cA + (size_t)(t + 1) * kstep;
            const char* a2 = last ? nA : cA + (size_t)(t + 2) * kstep; const char* b2 = last ? nB : cB + (size_t)(t + 2) * kstep;
            const char* a3 = a2 + kstep; const char* b3 = b2 + kstep;
            if (last && has_next) S.a_ready(nxt);
            if constexpr (SP2) {
            PG8_LDB(B0, 0, 0); PG8_LDB(B1, 0, 1); PG8_SCHED; PG8_LDA(At, 0, 0); PG8_STAGE(PG8_SA(1, 1), a1 + hstep, voffA);
            PG8_WAIT_V(8); PG8_WAIT_L(0); PG8_BAR; PG8_MMA(0, 0, At, B0); PG8_MMA(0, 1, At, B1); PG8_BAR; PG8_SCHED;
            PG8_LDA(At, 0, 1); PG8_STAGE(PG8_SB(0, 0), b2, voffB); PG8_STAGE(PG8_SB(0, 1), b2 + hstep, voffB); PG8_STAGE(PG8_SA(0, 0), a2, voffA);
            PG8_WAIT_V(8); PG8_WAIT_L(0); PG8_BAR; PG8_MMA(1, 0, At, B0); PG8_MMA(1, 1, At, B1); PG8_BAR; PG8_SCHED;
            PG8_LDB(B0, 1, 0); PG8_LDB(B1, 1, 1); PG8_SCHED; PG8_LDA(At, 1, 0); PG8_STAGE(PG8_SA(0, 1), a2 + hstep, voffA);
            PG8_WAIT_V(8); PG8_WAIT_L(0); PG8_BAR; PG8_MMA(0, 0, At, B0); PG8_MMA(0, 1, At, B1); PG8_BAR; PG8_SCHED;
            PG8_LDA(At, 1, 1); PG8_STAGE(PG8_SB(1, 0), b3, voffB); PG8_STAGE(PG8_SB(1, 1), b3 + hstep, voffB); PG8_STAGE(PG8_SA(1, 0), a3, voffA);
            PG8_WAIT_V(8); PG8_WAIT_L(0); PG8_BAR; PG8_MMA(1, 0, At, B0); PG8_MMA(1, 1, At, B1); PG8_BAR; PG8_SCHED;
            } else {
            PG8_LDB(B0, 0, 0); PG8_SCHED; PG8_LDA(At, 0, 0); PG8_STAGE(PG8_SA(1, 1), a1 + hstep, voffA);
            PG8_WAIT_L(8); PG8_BAR; PG8_WAIT_L(0); PG8_MMA(0, 0, At, B0); PG8_BAR; PG8_SCHED;
            PG8_LDB(B1, 0, 1); PG8_STAGE(PG8_SB(0, 0), b2, voffB);
            PG8_BAR; PG8_WAIT_L(0); PG8_MMA(0, 1, At, B1); PG8_BAR;
            PG8_LDA(At, 0, 1); PG8_STAGE(PG8_SA(0, 0), a2, voffA);
            PG8_BAR; PG8_WAIT_L(0); PG8_MMA(1, 0, At, B0); PG8_BAR; PG8_SCHED;
            PG8_STAGE(PG8_SB(0, 1), b2 + hstep, voffB);
            PG8_WAIT_V(6); PG8_BAR; PG8_MMA(1, 1, At, B1); PG8_BAR;
            PG8_LDB(B0, 1, 0); PG8_SCHED; PG8_LDA(At, 1, 0); PG8_STAGE(PG8_SA(0, 1), a2 + hstep, voffA);
            PG8_WAIT_L(8); PG8_BAR; PG8_WAIT_L(0); PG8_MMA(0, 0, At, B0); PG8_BAR; PG8_SCHED;
            PG8_LDB(B1, 1, 1); PG8_STAGE(PG8_SB(1, 0), b3, voffB);
            PG8_BAR; PG8_WAIT_L(0); PG8_MMA(0, 1, At, B1); PG8_BAR;
            PG8_LDA(At, 1, 1); PG8_STAGE(PG8_SA(1, 0), a3, voffA);
            PG8_BAR; PG8_WAIT_L(0); PG8_MMA(1, 0, At, B0); PG8_BAR; PG8_SCHED;
            PG8_STAGE(PG8_SB(1, 1), b3 + hstep, voffB);
            PG8_WAIT_V(6); PG8_BAR; PG8_MMA(1, 1, At, B1); PG8_BAR;
            }
        }
        if constexpr (ALIGN_EPI) { if (wr == 0) PG8_BAR; }
        if constexpr (!Epi::AFTER_DRAIN) { E(acc, cur, wr, wc, fr, fq); S.done(cur); }
        if (!has_next) break;
#pragma unroll
        for (int a = 0; a < 2; ++a)
#pragma unroll
            for (int b = 0; b < 2; ++b)
#pragma unroll
                for (int m = 0; m < 4; ++m)
#pragma unroll
                    for (int n = 0; n < 2; ++n) acc[a][b][m][n] = (f32x4){0.f, 0.f, 0.f, 0.f};
        cur = nxt; cA = nA; cB = nB; ++ui;
        if constexpr (ALIGN_EPI) { if (wr == 1) PG8_BAR; }
    }
    PG8_WAIT_V(0);
    if constexpr (!ALIGN_EPI) { if (wr == 0) PG8_BAR; }
    PG8_BAR;
    if constexpr (Epi::AFTER_DRAIN) { E.fused(acc, cur, wr, wc, fr, fq, lds, wid, lane); S.done(cur); }
#undef PG8_SA
#undef PG8_SB
#undef PG8_STAGE
#undef PG8_LDA
#undef PG8_LDB
#undef PG8_MMA
#undef PG8_WAIT_V
#undef PG8_WAIT_L
#undef PG8_BAR
#undef PG8_SCHED
}
}

#define LAS __attribute__((address_space(3)))
typedef unsigned short bf16;
typedef float f32x4 __attribute__((ext_vector_type(4)));
typedef float f32x2 __attribute__((ext_vector_type(2)));
typedef unsigned u32x4 __attribute__((ext_vector_type(4)));
typedef unsigned u32x2 __attribute__((ext_vector_type(2)));
typedef short bf16x8 __attribute__((ext_vector_type(8)));
typedef short s16x4 __attribute__((ext_vector_type(4)));

constexpr int SEQ = 8192, DM = 1024, MTOK = 16384;
constexpr int LDS_BYTES = 147456;
constexpr float EPS = 1e-6f;
constexpr float LOG2E = 1.4426950408889634f;
constexpr float QSCALE = 0.125f * LOG2E;

constexpr size_t MiB = 1u << 20;
constexpr size_t WS_W0T  = 0;
constexpr size_t WS_WO0T = 10 * MiB;
constexpr size_t WS_W1T  = 14 * MiB;
constexpr size_t WS_WO1T = 19 * MiB;
constexpr size_t WS_WGT  = 21 * MiB;
constexpr size_t WS_ROPE = 21 * MiB + 512 * 1024;
constexpr size_t WS_R0   = 22 * MiB;
constexpr size_t WS_VSS  = 23 * MiB;
constexpr size_t WS_SS1  = 24 * MiB;
constexpr size_t WS_SS2  = 25 * MiB;
constexpr size_t WS_XB   = 26 * MiB;
constexpr size_t WS_Z    = 58 * MiB;
constexpr size_t WS_UG = WS_Z, WS_GV = WS_Z + 32 * MiB, WS_BX = WS_Z + 64 * MiB, WS_BG = WS_Z + 96 * MiB;
constexpr size_t WS_Q  = WS_Z;
constexpr size_t WS_G  = WS_Z + 32 * MiB;
constexpr size_t WS_Y1 = WS_Z + 64 * MiB;
constexpr size_t WS_K  = WS_Z + 128 * MiB;
constexpr size_t WS_VT = WS_Z + 136 * MiB;
constexpr size_t WS_END = WS_Z + 144 * MiB;

__device__ __forceinline__ unsigned cvtpk(float lo, float hi) { return pg8::cvt_pk_bf16(lo, hi); }
__device__ __forceinline__ float bflo(unsigned u) { return __builtin_bit_cast(float, u << 16); }
__device__ __forceinline__ float bfhi(unsigned u) { return __builtin_bit_cast(float, u & 0xffff0000u); }
__device__ __forceinline__ float fast_exp2(float x) { return __builtin_amdgcn_exp2f(x); }
__device__ __forceinline__ float fast_rcp(float x) { return __builtin_amdgcn_rcpf(x); }
__device__ __forceinline__ float silu_f(float x) { return x * fast_rcp(1.f + fast_exp2(-x * LOG2E)); }
__device__ __forceinline__ float gelu_f(float x) { const float t = x * (1.f + 0.044715f * x * x) * (-1.5957691216057308f * LOG2E); return x * fast_rcp(1.f + fast_exp2(t)); }
__device__ __forceinline__ f32x2 exp2_2(f32x2 v) { return (f32x2){fast_exp2(v.x), fast_exp2(v.y)}; }
__device__ __forceinline__ f32x2 rcp_2(f32x2 v) { return (f32x2){fast_rcp(v.x), fast_rcp(v.y)}; }
__device__ __forceinline__ f32x2 min_2(f32x2 v, float m) { return (f32x2){fminf(v.x, m), fminf(v.y, m)}; }
constexpr float GC1 = -1.5957691216057308f * LOG2E, GC2 = 0.044715f;
__device__ __forceinline__ f32x2 gelu_arg(f32x2 u) { return min_2((u * u * (GC1 * GC2) + GC1) * u, 126.f); }
__device__ __forceinline__ f32x2 gelu_2(f32x2 u) { return u * rcp_2(exp2_2(gelu_arg(u)) + 1.f); }
__device__ __forceinline__ f32x2 silu_2(f32x2 g) { return g * rcp_2(exp2_2(min_2(g * (-LOG2E), 126.f)) + 1.f); }
__device__ __forceinline__ f32x2 gelu_silu_2(f32x2 u, f32x2 g) {
    const f32x2 e1 = exp2_2(gelu_arg(u)), e2 = exp2_2(min_2(g * (-LOG2E), 126.f));
    const f32x2 d = e1 + 1.f, d2 = e2 * d + d;
    return (u * g) * rcp_2(d2);
}
__device__ __forceinline__ void swap16(float v, float& a, float& b) { const auto r = __builtin_amdgcn_permlane16_swap(__builtin_bit_cast(unsigned, v), __builtin_bit_cast(unsigned, v), false, false); a = __builtin_bit_cast(float, (unsigned)r[0]); b = __builtin_bit_cast(float, (unsigned)r[1]); }
__device__ __forceinline__ void swap32(float v, float& a, float& b) { const auto r = __builtin_amdgcn_permlane32_swap(__builtin_bit_cast(unsigned, v), __builtin_bit_cast(unsigned, v), false, false); a = __builtin_bit_cast(float, (unsigned)r[0]); b = __builtin_bit_cast(float, (unsigned)r[1]); }
__device__ __forceinline__ float max2f(float a, float b) { float r; asm("v_max_f32_e32 %0, %1, %2" : "=v"(r) : "v"(a), "v"(b)); return r; }
__device__ __forceinline__ float fq_sum(float v) { float a, b; swap16(v, a, b); v = a + b; swap32(v, a, b); return a + b; }
__device__ __forceinline__ float fq_max(float v) { float a, b; swap16(v, a, b); v = max2f(a, b); swap32(v, a, b); return max2f(a, b); }
__device__ __forceinline__ float wave_sum(float v) {
#pragma unroll
    for (int o = 1; o < 64; o <<= 1) v += __shfl_xor(v, o);
    return v;
}
__device__ __forceinline__ float sum16(const float* p) {
    const f32x4 a = *(const f32x4*)p, b = *(const f32x4*)(p + 4), c = *(const f32x4*)(p + 8), d = *(const f32x4*)(p + 12);
    return ((a.x + a.y) + (a.z + a.w)) + ((b.x + b.y) + (b.z + b.w)) + (((c.x + c.y) + (c.z + c.w)) + ((d.x + d.y) + (d.z + d.w)));
}
#define LDS_WAIT() asm volatile("s_waitcnt lgkmcnt(0)" ::: "memory")

struct Args {
    const float* in[14];
    float* out; unsigned char* ws;
    int use_cg_sync, pad;
};

__device__ __forceinline__ void transpose_item(const float* __restrict__ W, int K, int N, bf16* __restrict__ WT, const float* __restrict__ g, int k0, int dst_n0, int src_n0, bool permqk, LAS float* scr, int lane) {
    float wv[32];
#pragma unroll
    for (int i = 0; i < 32; ++i) { const int kk = 2 * i + (lane >> 5); wv[i] = __builtin_nontemporal_load(W + (size_t)(k0 + kk) * N + src_n0 + (lane & 31)); }
    if (g) {
#pragma unroll
        for (int i = 0; i < 32; ++i) wv[i] *= g[k0 + 2 * i + (lane >> 5)];
    }
#pragma unroll
    for (int i = 0; i < 32; ++i) scr[(2 * i + (lane >> 5)) * 33 + (lane & 31)] = wv[i];
    LDS_WAIT(); asm volatile("" ::: "memory");
    const int c = lane & 7;
#pragma unroll
    for (int j = 0; j < 4; ++j) { const int n = (lane >> 3) + 8 * j; int ns = n;
        if (permqk && n < 16) ns = (n & 3) | ((n & 4) << 1) | ((n & 8) >> 1);
        const LAS float* s = scr + (8 * c) * 33 + ns;
        u32x4 o; o.x = cvtpk(s[0 * 33], s[1 * 33]); o.y = cvtpk(s[2 * 33], s[3 * 33]); o.z = cvtpk(s[4 * 33], s[5 * 33]); o.w = cvtpk(s[6 * 33], s[7 * 33]);
        *(u32x4*)(WT + (size_t)(dst_n0 + n) * K + k0 + 8 * c) = o; }
    LDS_WAIT(); asm volatile("" ::: "memory");
}

__device__ __forceinline__ void p0_prep(const Args& a, LAS unsigned char* lds) {
    int tid_ = threadIdx.x; asm volatile("" : "+v"(tid_));
    const int tid = tid_, lane = tid & 63, wave = __builtin_amdgcn_readfirstlane(tid >> 6);
    const int G = gridDim.x, gw = blockIdx.x * 8 + wave, NGW = G * 8;
    LAS float* scr = (LAS float*)(lds + wave * 16384);
    unsigned char* ws = a.ws;
    const float* x = a.in[0];
    constexpr int I_W0 = 16 * 160, I_WO0 = 32 * 32, I_W1 = 16 * 80, I_WO1 = 16 * 32, I_WG = 4 * 4 * 8;
    constexpr int NITEMS = I_W0 + I_WO0 + I_W1 + I_WO1 + I_WG;
    for (int it = gw; it < NITEMS; it += NGW) {
        int r = it;
        if (r < I_W0) {
            const int kb = r / 160, nb = r % 160, n0 = nb * 32; int src;
            if (n0 < 2048) { const int pn = n0 >> 8, within = n0 & 255, bj = within >> 7, ch = 128 * pn + (within & 127); src = bj ? 2048 + ch : ch; }
            else if (n0 < 3072) src = 1024 + (n0 - 2048);
            else src = n0;
            transpose_item(a.in[2], 1024, 5120, (bf16*)(ws + WS_W0T), a.in[1], kb * 64, n0, src, false, scr, lane); continue; }
        r -= I_W0;
        if (r < I_WO0) { const int kb = r / 32, nb = r % 32; transpose_item(a.in[8], 2048, 1024, (bf16*)(ws + WS_WO0T), nullptr, kb * 64, nb * 32, nb * 32, false, scr, lane); continue; }
        r -= I_WO0;
        if (r < I_W1) { const int kb = r / 80, nb = r % 80, n0 = nb * 32; const bool pq = (n0 < 1280) && ((n0 & 63) == 0);
            transpose_item(a.in[10], 1024, 2560, (bf16*)(ws + WS_W1T), a.in[9], kb * 64, n0, n0, pq, scr, lane); continue; }
        r -= I_W1;
        if (r < I_WO1) { const int kb = r / 32, nb = r % 32; transpose_item(a.in[12], 1024, 1024, (bf16*)(ws + WS_WO1T), nullptr, kb * 64, nb * 32, nb * 32, false, scr, lane); continue; }
        r -= I_WO1;
        { const int gi = r / 32, rr = r % 32, kb = rr / 8, nb = rr % 8;
          transpose_item(a.in[6] + (size_t)gi * 65536, 256, 256, (bf16*)(ws + WS_WGT) + (size_t)gi * 65536, nullptr, kb * 64, nb * 32, nb * 32, false, scr, lane); }
    }
    {
        bf16* XB = (bf16*)(ws + WS_XB); float* R0 = (float*)(ws + WS_R0);
        for (int m0 = gw; m0 < MTOK; m0 += 4 * NGW) {
            f32x4 v[4][4];
#pragma unroll
            for (int r = 0; r < 4; ++r) { const int m = min(m0 + r * NGW, MTOK - 1); const f32x4* xr = (const f32x4*)(x + (size_t)m * DM) + lane;
#pragma unroll
                for (int j = 0; j < 4; ++j) v[r][j] = __builtin_nontemporal_load(xr + 64 * j); }
#pragma unroll
            for (int r = 0; r < 4; ++r) { const int m = m0 + r * NGW; float s = 0.f;
#pragma unroll
                for (int j = 0; j < 4; ++j) s += (v[r][j].x * v[r][j].x + v[r][j].y * v[r][j].y) + (v[r][j].z * v[r][j].z + v[r][j].w * v[r][j].w);
                s = wave_sum(s);
                if (m < MTOK) {
                    u32x2* o = (u32x2*)(XB + (size_t)m * DM) + lane;
#pragma unroll
                    for (int j = 0; j < 4; ++j) { u32x2 w; w.x = cvtpk(v[r][j].x, v[r][j].y); w.y = cvtpk(v[r][j].z, v[r][j].w); o[64 * j] = w; }
                    if (lane == 0) R0[m] = 1.f / sqrtf(s * (1.f / DM) + EPS);
                } }
        }
    }
    {
        unsigned* T = (unsigned*)(ws + WS_ROPE);
        for (int e = blockIdx.x * 512 + tid; e < SEQ * 8; e += G * 512) {
            const int pos = e >> 3, i = e & 7;
            const float inv = (float)exp2(-(double)i * (18.931568569324174 / 8.0));
            const float ang = (float)pos * inv;
            const double rev = (double)ang * 0.15915494309189535; const double fr = rev - rint(rev);
            const float rf = (float)fr;
            T[e] = (unsigned)__builtin_bit_cast(unsigned short, (_Float16)__builtin_amdgcn_cosf(rf)) | ((unsigned)__builtin_bit_cast(unsigned short, (_Float16)__builtin_amdgcn_sinf(rf)) << 16);
        }
    }
}

#define EPI_ARGS const f32x4 (&acc)[2][2][4][2], const pg8::Unit& u, int wr, int wc, int fr, int fq


struct EpiIn0 {
    static constexpr bool PERM = true, AFTER_DRAIN = false;
    const float* r0; bf16 *UG, *GV, *BX, *BG; float* vss;
    __device__ __forceinline__ void operator()(EPI_ARGS) const {
        const int row0 = u.pm * 256 + wr * 64 + fr, pn = u.pn;
        float rs8[2][4];
#pragma unroll
        for (int ai = 0; ai < 2; ++ai)
#pragma unroll
            for (int m = 0; m < 4; ++m) rs8[ai][m] = r0[row0 + ai * 128 + m * 16];
        if (pn < 8) {
            const int col = 128 * pn + 32 * wc + 8 * fq;
#pragma unroll
            for (int ai = 0; ai < 2; ++ai)
#pragma unroll
                for (int m = 0; m < 4; ++m) { const int row = row0 + ai * 128 + m * 16; const float rs = rs8[ai][m];
                    u32x4 w;
#pragma unroll
                    for (int n = 0; n < 2; ++n) { const f32x4 au = acc[ai][0][m][n] * rs, ag = acc[ai][1][m][n] * rs;
                        const f32x2 o0 = gelu_silu_2((f32x2){au.x, au.y}, (f32x2){ag.x, ag.y}), o1 = gelu_silu_2((f32x2){au.z, au.w}, (f32x2){ag.z, ag.w});
                        w[2 * n] = cvtpk(o0.x, o0.y); w[2 * n + 1] = cvtpk(o1.x, o1.y); }
                    *(u32x4*)(UG + (size_t)row * 1024 + col) = w; }
        } else if (pn < 12) {
            const int col = 256 * (pn - 8) + 32 * wc + 8 * fq;
#pragma unroll
            for (int ai = 0; ai < 2; ++ai)
#pragma unroll
                for (int m = 0; m < 4; ++m) { const int row = row0 + ai * 128 + m * 16; const float rs = rs8[ai][m]; float ss = 0.f;
#pragma unroll
                    for (int bj = 0; bj < 2; ++bj) { u32x4 w;
#pragma unroll
                        for (int n = 0; n < 2; ++n) { const f32x4 av = acc[ai][bj][m][n] * rs;
                            const f32x2 o0 = gelu_2((f32x2){av.x, av.y}), o1 = gelu_2((f32x2){av.z, av.w});
                            const f32x2 q = o0 * o0 + o1 * o1; ss += q.x + q.y;
                            w[2 * n] = cvtpk(o0.x, o0.y); w[2 * n + 1] = cvtpk(o1.x, o1.y); }
                        *(u32x4*)(GV + (size_t)row * 1024 + col + bj * 128) = w; }
                    ss = fq_sum(ss);
                    if (fq == 0) vss[(size_t)row * 16 + (pn - 8) * 4 + wc] = ss; }
        } else {
            const bool isg = pn >= 16; bf16* O = isg ? BG : BX;
            const int col = 256 * (pn - (isg ? 16 : 12)) + 32 * wc + 8 * fq;
#pragma unroll
            for (int ai = 0; ai < 2; ++ai)
#pragma unroll
                for (int m = 0; m < 4; ++m) { const int row = row0 + ai * 128 + m * 16; const float rs = rs8[ai][m];
#pragma unroll
                    for (int bj = 0; bj < 2; ++bj) { u32x4 w;
#pragma unroll
                        for (int n = 0; n < 2; ++n) { const f32x4 av = acc[ai][bj][m][n] * rs;
                            f32x2 o0 = (f32x2){av.x, av.y}, o1 = (f32x2){av.z, av.w};
                            if (isg) { o0 = silu_2(o0); o1 = silu_2(o1); }
                            w[2 * n] = cvtpk(o0.x, o0.y); w[2 * n + 1] = cvtpk(o1.x, o1.y); }
                        *(u32x4*)(O + (size_t)row * 1024 + col + bj * 128) = w; } }
        }
    }
};

template <bool XIN_BF16, bool OUT_F32, bool OUT_BF16>
struct EpiRes {
    static constexpr bool PERM = true, AFTER_DRAIN = false;
    const void* xin; float* xo; bf16* xb; float* ss;
    __device__ __forceinline__ void load_batch(f32x4 (&x)[2][2][2], int row0, int col0, int b) const {
#pragma unroll
        for (int mm = 0; mm < 2; ++mm)
#pragma unroll
            for (int bj = 0; bj < 2; ++bj) { const size_t off = (size_t)(row0 + (b >> 1) * 128 + (2 * (b & 1) + mm) * 16) * 1024 + col0 + bj * 128;
                if (XIN_BF16) { const u32x4 r = *(const u32x4*)((const bf16*)xin + off); x[mm][bj][0] = (f32x4){bflo(r.x), bfhi(r.x), bflo(r.y), bfhi(r.y)}; x[mm][bj][1] = (f32x4){bflo(r.z), bfhi(r.z), bflo(r.w), bfhi(r.w)}; }
                else { x[mm][bj][0] = *(const f32x4*)((const float*)xin + off); x[mm][bj][1] = *(const f32x4*)((const float*)xin + off + 4); } }
    }
    __device__ __forceinline__ void operator()(EPI_ARGS) const {
        const int row0 = u.pm * 256 + wr * 64 + fr, col0 = u.pn * 256 + 32 * wc + 8 * fq;
        f32x4 xa[2][2][2], xb2[2][2][2];
        load_batch(xa, row0, col0, 0);
#pragma unroll
        for (int b = 0; b < 4; ++b) {
            if (b + 1 < 4) { if (b & 1) load_batch(xa, row0, col0, b + 1); else load_batch(xb2, row0, col0, b + 1); }
            const int ai = b >> 1;
#pragma unroll
            for (int mm = 0; mm < 2; ++mm) { const int m = 2 * (b & 1) + mm, row = row0 + ai * 128 + m * 16; float s = 0.f;
#pragma unroll
                for (int bj = 0; bj < 2; ++bj) { const size_t off = (size_t)row * 1024 + col0 + bj * 128;
                    const f32x4 v0 = ((b & 1) ? xb2[mm][bj][0] : xa[mm][bj][0]) + acc[ai][bj][m][0], v1 = ((b & 1) ? xb2[mm][bj][1] : xa[mm][bj][1]) + acc[ai][bj][m][1];
                    if (OUT_F32) { *(f32x4*)(xo + off) = v0; *(f32x4*)(xo + off + 4) = v1; }
                    s += (v0.x * v0.x + v0.y * v0.y) + (v0.z * v0.z + v0.w * v0.w) + (v1.x * v1.x + v1.y * v1.y) + (v1.z * v1.z + v1.w * v1.w);
                    if (OUT_BF16) { u32x4 w; w.x = cvtpk(v0.x, v0.y); w.y = cvtpk(v0.z, v0.w); w.z = cvtpk(v1.x, v1.y); w.w = cvtpk(v1.z, v1.w); *(u32x4*)(xb + off) = w; } }
                s = fq_sum(s);
                if (fq == 0) ss[(size_t)row * 16 + u.pn * 4 + wc] = s; }
        }
    }
};

struct EpiIn1 {
    static constexpr bool PERM = true, AFTER_DRAIN = false;
    const float* ss1; const unsigned* rope; bf16 *Q, *K, *VT, *G;
    __device__ __forceinline__ void operator()(EPI_ARGS) const {
        const int row0 = u.pm * 256 + wr * 64 + fr, pn = u.pn;
        const bool dorope = (pn < 5) && ((wc & 1) == 0) && (fq < 2);
        float rs8[2][4];
        {
            f32x4 part[2][4];
#pragma unroll
            for (int ai = 0; ai < 2; ++ai)
#pragma unroll
                for (int m = 0; m < 4; ++m) part[ai][m] = *(const f32x4*)(ss1 + (size_t)(row0 + ai * 128 + m * 16) * 16 + 4 * fq);
#pragma unroll
            for (int ai = 0; ai < 2; ++ai)
#pragma unroll
                for (int m = 0; m < 4; ++m) { const f32x4 pq = part[ai][m]; rs8[ai][m] = 1.f / sqrtf(fq_sum((pq.x + pq.y) + (pq.z + pq.w)) * (1.f / DM) + EPS); }
        }
        u32x4 cst[2][4];
#pragma unroll
        for (int ai = 0; ai < 2; ++ai)
#pragma unroll
            for (int m = 0; m < 4; ++m) { cst[ai][m] = (u32x4){0x3c00u, 0x3c00u, 0x3c00u, 0x3c00u};
                if (dorope) cst[ai][m] = *(const u32x4*)(rope + (size_t)((row0 + ai * 128 + m * 16) & (SEQ - 1)) * 8 + 4 * fq); }
#pragma unroll
        for (int ai = 0; ai < 2; ++ai)
#pragma unroll
            for (int m = 0; m < 4; ++m) { const int row = row0 + ai * 128 + m * 16;
                const float rs = rs8[ai][m];
                const u32x4 ct = cst[ai][m];
#pragma unroll
                for (int bj = 0; bj < 2; ++bj) {
                    f32x4 z0 = acc[ai][bj][m][0] * rs, z1 = acc[ai][bj][m][1] * rs;
                    const int colt = 128 * bj + 32 * wc + 8 * fq;
                    if (pn < 5) {
                        if (dorope) {
                            float c[4], s[4];
#pragma unroll
                            for (int j = 0; j < 4; ++j) { c[j] = (float)__builtin_bit_cast(_Float16, (unsigned short)(ct[j] & 0xffffu)); s[j] = (float)__builtin_bit_cast(_Float16, (unsigned short)(ct[j] >> 16)); }
#pragma unroll
                            for (int j = 0; j < 4; ++j) { const float a1 = z0[j], a2 = z1[j]; z0[j] = a1 * c[j] - a2 * s[j]; z1[j] = a2 * c[j] + a1 * s[j]; }
                        }
                        if (pn < 4) { z0 = z0 * QSCALE; z1 = z1 * QSCALE; }
                        u32x4 w; w.x = cvtpk(z0.x, z0.y); w.y = cvtpk(z0.z, z0.w); w.z = cvtpk(z1.x, z1.y); w.w = cvtpk(z1.z, z1.w);
                        if (pn < 4) *(u32x4*)(Q + (size_t)row * 1024 + 256 * pn + colt) = w;
                        else        *(u32x4*)(K + (size_t)row * 256 + colt) = w;
                    } else if (pn == 5) {
                        u32x4 w; w.x = cvtpk(z0.x, z0.y); w.y = cvtpk(z0.z, z0.w); w.z = cvtpk(z1.x, z1.y); w.w = cvtpk(z1.z, z1.w);
                        *(u32x4*)(VT + (size_t)row * 256 + colt) = w;
                    } else {
                        const f32x2 s0 = silu_2((f32x2){z0.x, z0.y}), s1 = silu_2((f32x2){z0.z, z0.w}), s2 = silu_2((f32x2){z1.x, z1.y}), s3 = silu_2((f32x2){z1.z, z1.w});
                        u32x4 w; w.x = cvtpk(s0.x, s0.y); w.y = cvtpk(s1.x, s1.y); w.z = cvtpk(s2.x, s2.y); w.w = cvtpk(s3.x, s3.y);
                        *(u32x4*)(G + (size_t)row * 1024 + 256 * (pn - 6) + colt) = w;
                    }
                } }
    }
};

#define MFMA16(a, b, c) __builtin_amdgcn_mfma_f32_16x16x32_bf16((a), (b), (c), 0, 0, 0)

typedef short v4i16_t __attribute__((ext_vector_type(4)));
__device__ __forceinline__ float max3f(float a, float b, float c) { float r; asm("v_max3_f32 %0, %1, %2, %3" : "=v"(r) : "v"(a), "v"(b), "v"(c)); return r; }
__device__ __forceinline__ s16x4 trread(const LAS bf16* p) { return __builtin_bit_cast(s16x4, __builtin_amdgcn_ds_read_tr16_b64_v4i16((LAS v4i16_t*)p)); }
__device__ __forceinline__ bf16x8 cat8(s16x4 a, s16x4 b) { return __builtin_shufflevector(a, b, 0, 1, 2, 3, 4, 5, 6, 7); }

__device__ __forceinline__ int unit_tile(int u) { return 16 * (u & 7) + (u >> 5); }
__device__ __forceinline__ int unit_grp(int u) { return (u >> 3) & 3; }

__device__ __forceinline__ void issue_a(const Args& a, int c, int h, int tid, u32x4 (&pf)[9]) {
    const bf16* GV = (const bf16*)(a.ws + WS_GV);
#pragma unroll
    for (int it = 0; it < 8; ++it) { const int item = it * 512 + tid, cl = item & 31, j = item >> 5; pf[it] = *(const u32x4*)(GV + (size_t)(128 * c + j) * 1024 + 256 * h + 8 * cl); }
}
__device__ __forceinline__ void issue_b(const Args& a, int tt, int g, int tid, u32x4 (&pf)[9]) {
    const int b = tt >> 6, t0 = (tt & 63) * 128;
    const bf16* base = (const bf16*)(a.ws + WS_BX) + (size_t)b * SEQ * 1024 + 256 * g;
#pragma unroll
    for (int it = 0; it < 9; ++it) { const int item = it * 512 + tid, cl = item & 31, rr = item >> 5, pos = t0 - 8 + rr;
        pf[it] = (u32x4){0u, 0u, 0u, 0u};
        if (pos >= 0 && pos < SEQ) pf[it] = *(const u32x4*)(base + (size_t)pos * 1024 + 8 * cl); }
}
__device__ __forceinline__ void issue_next(const Args& a, int nkind, int nidx, int tid, u32x4 (&pf)[9]) {
    if (nkind == 0) issue_a(a, unit_tile(nidx), unit_grp(nidx), tid, pf); else if (nkind == 1) issue_b(a, unit_tile(nidx), unit_grp(nidx), tid, pf);
}

__device__ __forceinline__ void mixer_a_unit(const Args& a, LAS unsigned char* lds, int c, int h, u32x4 (&pf)[9], int nkind, int nidx) {
    int tid_ = threadIdx.x; asm volatile("" : "+v"(tid_));
    const int tid = tid_, lane = tid & 63, w = __builtin_amdgcn_readfirstlane(tid >> 6), fr = lane & 15, fq = lane >> 4;
    constexpr int VS2 = 264, WS_ = 136;
    LAS bf16* V = (LAS bf16*)lds;
    LAS bf16* Ws = (LAS bf16*)(lds + 67584);
    LAS float* rvs = (LAS float*)(lds + 67584 + 34816);
    const unsigned char* ws = a.ws;
    const bf16* UG = (const bf16*)(ws + WS_UG); const float* vss = (const float*)(ws + WS_VSS);
    bf16* Y0 = (bf16*)a.out;
    const float* wsp = a.in[4] + (size_t)h * 16384; const float* bsp = a.in[5] + h * 128; const float* gv = a.in[3];
    f32x4 wsr[8];
#pragma unroll
    for (int it = 0; it < 8; ++it) { const int item = it * 512 + tid, j4 = item & 31, i = item >> 5; wsr[it] = *(const f32x4*)(wsp + i * 128 + 4 * j4); }
    if (tid < 128) rvs[tid] = 1.f / sqrtf(sum16(vss + (size_t)(128 * c + tid) * 16) * (1.f / 1024.f) + EPS);
#pragma unroll
    for (int it = 0; it < 8; ++it) { const int item = it * 512 + tid, cl = item & 31, j = item >> 5; *(LAS u32x4*)(V + j * VS2 + 8 * cl) = pf[it]; }
    issue_next(a, nkind, nidx, tid, pf);
    __syncthreads();
#pragma unroll
    for (int it = 0; it < 8; ++it) { const int item = it * 512 + tid, j4 = item & 31, i = item >> 5;
        const f32x4 r = *(const LAS f32x4*)(rvs + 4 * j4); const f32x4 v = wsr[it];
        u32x2 o; o.x = cvtpk(v.x * r.x, v.y * r.y); o.y = cvtpk(v.z * r.z, v.w * r.w);
        *(LAS u32x2*)(Ws + i * WS_ + 4 * j4) = o; }
    u32x4 ugr[8];
#pragma unroll
    for (int it = 0; it < 8; ++it) ugr[it] = *(const u32x4*)(UG + (size_t)(128 * c + 16 * it + fr) * 1024 + 256 * h + 32 * w + 8 * fq);
    __syncthreads();
    f32x4 acc[2][8];
#pragma unroll
    for (int dt = 0; dt < 2; ++dt)
#pragma unroll
        for (int it = 0; it < 8; ++it) acc[dt][it] = (f32x4){0.f, 0.f, 0.f, 0.f};
    const LAS bf16* vb = V + (8 * fq + ((lane >> 2) & 3)) * VS2 + 32 * w + 8 * (lane & 3);
#pragma unroll
    for (int ks = 0; ks < 4; ++ks) {
        bf16x8 af[2], bfr[8];
#pragma unroll
        for (int dt = 0; dt < 2; ++dt) { const LAS bf16* p = vb + (32 * ks) * VS2 + 4 * dt; af[dt] = cat8(trread(p), trread(p + 4 * VS2)); }
#pragma unroll
        for (int it = 0; it < 8; ++it) bfr[it] = *(const LAS bf16x8*)(Ws + (16 * it + fr) * WS_ + 32 * ks + 8 * fq);
#pragma unroll
        for (int dt = 0; dt < 2; ++dt)
#pragma unroll
            for (int it = 0; it < 8; ++it) acc[dt][it] = MFMA16(af[dt], bfr[it], acc[dt][it]);
    }
    {   const int col = 256 * h + 32 * w + 8 * fq; const f32x4 g0 = *(const f32x4*)(gv + col), g1 = *(const f32x4*)(gv + col + 4);
#pragma unroll
        for (int it = 0; it < 8; ++it) { const int i = 16 * it + fr, row = 128 * c + i; const float bs = bsp[i];
            const u32x4 ug = ugr[it];
            const f32x4 m0 = acc[0][it] * g0 + bs, m1 = acc[1][it] * g1 + bs;
            u32x4 o; o.x = cvtpk(bflo(ug.x) * m0.x, bfhi(ug.x) * m0.y); o.y = cvtpk(bflo(ug.y) * m0.z, bfhi(ug.y) * m0.w); o.z = cvtpk(bflo(ug.z) * m1.x, bfhi(ug.z) * m1.y); o.w = cvtpk(bflo(ug.w) * m1.z, bfhi(ug.w) * m1.w);
            *(u32x4*)(Y0 + (size_t)row * 2048 + col) = o; } }
    __syncthreads();
}

__device__ __forceinline__ void mixer_b_unit(const Args& a, LAS unsigned char* lds, int tt, int g, u32x4 (&pf)[9], int nkind, int nidx) {
    int tid_ = threadIdx.x; asm volatile("" : "+v"(tid_));
    const int tid = tid_, lane = tid & 63, w = __builtin_amdgcn_readfirstlane(tid >> 6), fr = lane & 15, fq = lane >> 4;
    constexpr int PS = 264;
    LAS bf16* Bs = (LAS bf16*)lds;
    LAS bf16* P = (LAS bf16*)(lds + 76032);
    const unsigned char* ws = a.ws;
    const bf16* BG = (const bf16*)(ws + WS_BG); const bf16* WGT = (const bf16*)(ws + WS_WGT) + (size_t)g * 65536;
    bf16* Y0 = (bf16*)a.out; const float* bscale = a.in[7];
    const int b = tt >> 6, t0 = (tt & 63) * 128;
#pragma unroll
    for (int it = 0; it < 9; ++it) { const int item = it * 512 + tid, cl = item & 31, rr = item >> 5; *(LAS u32x4*)(Bs + rr * PS + 8 * cl) = pf[it]; }
    bf16x8 wf[8][2];
#pragma unroll
    for (int ks = 0; ks < 8; ++ks)
#pragma unroll
        for (int et = 0; et < 2; ++et) wf[ks][et] = *(const bf16x8*)(WGT + (size_t)(32 * w + 8 * (fr >> 2) + 4 * et + (fr & 3)) * 256 + 32 * ks + 8 * fq);
    u32x4 bgr[8];
#pragma unroll
    for (int it = 0; it < 8; ++it) bgr[it] = *(const u32x4*)(BG + (size_t)(128 * tt + 16 * it + fr) * 1024 + 256 * g + 32 * w + 8 * fq);
    __syncthreads();
    {
        const int cl = tid & 31, tr = tid >> 5, half = 1 << g;
        const LAS bf16* col = Bs + 8 * cl;
        float s[8];
#pragma unroll
        for (int e = 0; e < 8; ++e) s[e] = 0.f;
        for (int rr = 8 * tr + 8 - half; rr < 8 * tr + 8 + half; ++rr) { const u32x4 r = *(const LAS u32x4*)(col + rr * PS);
#pragma unroll
            for (int e = 0; e < 4; ++e) { s[2 * e] += bflo(r[e]); s[2 * e + 1] += bfhi(r[e]); } }
        for (int k = 0; k < 8; ++k) { const int tl = 8 * tr + k, t = t0 + tl; const int lo = max(t - half, 0), hi = min(t + half, SEQ); const float inv = 1.f / (float)(hi - lo);
            const u32x4 r = *(const LAS u32x4*)(col + (tl + 8) * PS);
            u32x4 o;
#pragma unroll
            for (int e = 0; e < 4; ++e) o[e] = cvtpk(s[2 * e] * inv - bflo(r[e]), s[2 * e + 1] * inv - bfhi(r[e]));
            *(LAS u32x4*)(P + tl * PS + 8 * cl) = o;
            const u32x4 qa = *(const LAS u32x4*)(col + (tl + 8 + half) * PS), qs = *(const LAS u32x4*)(col + (tl + 8 - half) * PS);
#pragma unroll
            for (int e = 0; e < 4; ++e) { s[2 * e] += bflo(qa[e]) - bflo(qs[e]); s[2 * e + 1] += bfhi(qa[e]) - bfhi(qs[e]); } }
    }
    __syncthreads();
    f32x4 acc[2][8];
#pragma unroll
    for (int et = 0; et < 2; ++et)
#pragma unroll
        for (int it = 0; it < 8; ++it) acc[et][it] = (f32x4){0.f, 0.f, 0.f, 0.f};
#pragma unroll
    for (int ks = 0; ks < 8; ++ks) {
        bf16x8 bfr[8];
#pragma unroll
        for (int it = 0; it < 8; ++it) bfr[it] = *(const LAS bf16x8*)(P + (16 * it + fr) * PS + 32 * ks + 8 * fq);
#pragma unroll
        for (int et = 0; et < 2; ++et)
#pragma unroll
            for (int it = 0; it < 8; ++it) acc[et][it] = MFMA16(wf[ks][et], bfr[it], acc[et][it]);
    }
    issue_next(a, nkind, nidx, tid, pf);
    {   const int col = 256 * g + 32 * w + 8 * fq; const f32x4 s0 = *(const f32x4*)(bscale + col), s1 = *(const f32x4*)(bscale + col + 4);
#pragma unroll
        for (int it = 0; it < 8; ++it) { const int row = 128 * tt + 16 * it + fr;
            const u32x4 bg = bgr[it];
            const f32x4 y0 = acc[0][it] * s0, y1 = acc[1][it] * s1;
            u32x4 o; o.x = cvtpk(bflo(bg.x) * y0.x, bfhi(bg.x) * y0.y); o.y = cvtpk(bflo(bg.y) * y0.z, bfhi(bg.y) * y0.w); o.z = cvtpk(bflo(bg.z) * y1.x, bfhi(bg.z) * y1.y); o.w = cvtpk(bflo(bg.w) * y1.z, bfhi(bg.w) * y1.w);
            *(u32x4*)(Y0 + (size_t)row * 2048 + 1024 + col) = o; } }
    __syncthreads();
}

__device__ __forceinline__ void attn_issue(const Args& a, int u, int tid, u32x4 (&kr)[6], u32x4 (&vr)[6]) {
    if (u >= 512) return;
    const int gq = unit_tile(u), b = gq >> 6, qb = gq & 63, kvh = unit_grp(u), kb0 = (qb - 1) * 128;
    const bf16* Kg = (const bf16*)(a.ws + WS_K); const bf16* Vg = (const bf16*)(a.ws + WS_VT);
#pragma unroll
    for (int it = 0; it < 6; ++it) { const int item = it * 512 + tid, ch = item & 7, key = item >> 3; const int pos = kb0 + key;
        kr[it] = (u32x4){0u, 0u, 0u, 0u}; vr[it] = (u32x4){0u, 0u, 0u, 0u};
        if (pos >= 0 && pos < SEQ) { const size_t off = (size_t)(b * SEQ + pos) * 256 + kvh * 64 + 8 * ch; kr[it] = *(const u32x4*)(Kg + off); vr[it] = *(const u32x4*)(Vg + off); } }
}
__device__ __forceinline__ void attn_unit(const Args& a, LAS unsigned char* lds, int b, int qb, int kvh, u32x4 (&kr)[6], u32x4 (&vr)[6], int unext) {
    int tid_ = threadIdx.x; asm volatile("" : "+v"(tid_));
    const int tid = tid_, lane = tid & 63, w = __builtin_amdgcn_readfirstlane(tid >> 6), fr = lane & 15, fq = lane >> 4;
    constexpr int KS = 72, VS = 80;
    LAS bf16* Ks = (LAS bf16*)lds;
    LAS bf16* Vs = (LAS bf16*)(lds + 55296);
    const unsigned char* ws = a.ws;
    const bf16* Qg = (const bf16*)(ws + WS_Q); const bf16* Gg = (const bf16*)(ws + WS_G);
    bf16* Y1 = (bf16*)(a.ws + WS_Y1);
    const int kb0 = (qb - 1) * 128;
    const int head = kvh * 4 + (w >> 1);
    const size_t qbase = (size_t)(b * SEQ + qb * 128 + (w & 1) * 64 + fr) * 1024 + head * 64;
#pragma unroll
    for (int it = 0; it < 6; ++it) { const int item = it * 512 + tid, ch = item & 7, key = item >> 3; *(LAS u32x4*)(Ks + key * KS + 8 * ch) = kr[it];
        const u32x4 v = vr[it]; *(LAS u32x4*)(Vs + key * VS + 8 * ch) = (key & 1) ? (u32x4){v.z, v.w, v.x, v.y} : v; }
    attn_issue(a, unext, tid, kr, vr);
    bf16x8 q0 = *(const bf16x8*)(Qg + qbase + 8 * fq), q1 = *(const bf16x8*)(Qg + qbase + 32 + 8 * fq);
    __syncthreads();
    const float sink2 = a.in[11][head] * LOG2E;
    const bool edge = (qb == 0) || (qb == SEQ / 128 - 1);
    const LAS bf16* vtb = Vs + (4 * fq + ((lane >> 2) & 3)) * VS + 8 * (lane & 3);
    const int vsw = 4 * ((lane >> 2) & 1);
    for (int it = 0; it < 4; ++it) {
        const int rowoff = (w & 1) * 64 + 16 * it;
        const size_t qoff = qbase + (size_t)(16 * it) * 1024;
        const u32x4 g0 = *(const u32x4*)(Gg + qoff + 8 * fq), g1 = *(const u32x4*)(Gg + qoff + 32 + 8 * fq);
        const bf16x8 qa = q0, qb2 = q1;
        if (it < 3) { q0 = *(const bf16x8*)(Qg + qoff + 16 * 1024 + 8 * fq); q1 = *(const bf16x8*)(Qg + qoff + 16 * 1024 + 32 + 8 * fq); }
        const int kt0 = (rowoff >> 4) & ~1;
        f32x4 S[18];
        const LAS bf16* kpb = Ks + (16 * kt0 + fr) * KS + 8 * fq;
#pragma unroll
        for (int j = 0; j < 18; ++j) { const LAS bf16* kp = kpb + j * (16 * KS);
            f32x4 s = {0.f, 0.f, 0.f, 0.f};
            s = MFMA16(*(const LAS bf16x8*)kp, qa, s); s = MFMA16(*(const LAS bf16x8*)(kp + 32), qb2, s); S[j] = s;
            }
        const int qpos = qb * 128 + rowoff + fr, kbase = kb0 + 16 * kt0 + 4 * fq;
        const int klo = max(qpos - 128, 0), khi = min(qpos + 128, SEQ - 1);
        int mbase = kbase - klo; const unsigned mspan = (unsigned)(khi - klo);
        asm volatile("" : "+v"(mbase));
#define ATT_MASK_TILE(j) do { _Pragma("unroll") for (int r = 0; r < 4; ++r) { const bool ok = (unsigned)(mbase + (16 * (j) + r)) <= mspan; S[j][r] = ok ? S[j][r] : -1e30f; } } while (0)
        if (edge) {
#pragma unroll
            for (int j = 0; j < 18; ++j) ATT_MASK_TILE(j);
        } else {
            ATT_MASK_TILE(0); ATT_MASK_TILE(1); ATT_MASK_TILE(16); ATT_MASK_TILE(17);
        }
#undef ATT_MASK_TILE
        float mx = sink2;
#pragma unroll
        for (int j = 0; j < 18; ++j) { mx = max3f(mx, S[j][0], S[j][1]); mx = max3f(mx, S[j][2], S[j][3]); }
        mx = fq_max(mx);
        f32x2 l2 = {0.f, 0.f};
#pragma unroll
        for (int j = 0; j < 18; ++j) { const f32x2 p0 = exp2_2((f32x2){S[j][0], S[j][1]} - mx), p1 = exp2_2((f32x2){S[j][2], S[j][3]} - mx);
            S[j] = (f32x4){p0.x, p0.y, p1.x, p1.y}; l2 += p0 + p1; }
        float l = l2.x + l2.y;
        l = fq_sum(l);
        l += fast_exp2(sink2 - mx);
        const float rl = 1.f / l;
        const LAS bf16* vpb = vtb + (16 * kt0) * VS;
        f32x4 O[4];
#pragma unroll
        for (int dt = 0; dt < 4; ++dt) O[dt] = (f32x4){0.f, 0.f, 0.f, 0.f};
#pragma unroll
        for (int jp = 0; jp < 9; ++jp) {
            u32x4 pw; pw.x = cvtpk(S[2 * jp][0], S[2 * jp][1]); pw.y = cvtpk(S[2 * jp][2], S[2 * jp][3]); pw.z = cvtpk(S[2 * jp + 1][0], S[2 * jp + 1][1]); pw.w = cvtpk(S[2 * jp + 1][2], S[2 * jp + 1][3]);
            const bf16x8 pf = __builtin_bit_cast(bf16x8, pw);
            const LAS bf16* vp = vpb + jp * (32 * VS);
#pragma unroll
            for (int dt = 0; dt < 4; ++dt) { const LAS bf16* p = vp + 32 * (dt >> 1) + ((dt & 1) ? 4 - vsw : vsw);
                O[dt] = MFMA16(cat8(trread(p), trread(p + 16 * VS)), pf, O[dt]); }
        }
        {
            const f32x4 a0 = O[0] * rl, a1 = O[1] * rl, a2 = O[2] * rl, a3 = O[3] * rl;
            u32x4 o0, o1;
            o0.x = cvtpk(a0.x * bflo(g0.x), a0.y * bfhi(g0.x)); o0.y = cvtpk(a0.z * bflo(g0.y), a0.w * bfhi(g0.y)); o0.z = cvtpk(a1.x * bflo(g0.z), a1.y * bfhi(g0.z)); o0.w = cvtpk(a1.z * bflo(g0.w), a1.w * bfhi(g0.w));
            o1.x = cvtpk(a2.x * bflo(g1.x), a2.y * bfhi(g1.x)); o1.y = cvtpk(a2.z * bflo(g1.y), a2.w * bfhi(g1.y)); o1.z = cvtpk(a3.x * bflo(g1.z), a3.y * bfhi(g1.z)); o1.w = cvtpk(a3.z * bflo(g1.w), a3.w * bfhi(g1.w));
            *(u32x4*)(Y1 + qoff + 8 * fq) = o0; *(u32x4*)(Y1 + qoff + 32 + 8 * fq) = o1;
        }
    }
    __syncthreads();
}

#define RLX_AGENT __ATOMIC_RELAXED, __HIP_MEMORY_SCOPE_AGENT
#define XB_TMO      128
#define XB_XCNT(j)  (256  + 64 * (j))
#define XB_XSUB(j)  (1280 + 64 * (j))
#define XB_XGEN(j)  (2304 + 64 * (j))
#define XB_TOP      3328
#define XB_TOPGEN   3392
#define XCD_BAR_WORDS 3456
#define XB_SPIN_CAP (1u << 18)

__device__ __forceinline__ unsigned xb_ld(unsigned* p)              { return __hip_atomic_load(p, __ATOMIC_RELAXED, __HIP_MEMORY_SCOPE_AGENT); }
__device__ __forceinline__ unsigned xb_add(unsigned* p, unsigned v) { return __hip_atomic_fetch_add(p, v, __ATOMIC_RELAXED, __HIP_MEMORY_SCOPE_AGENT); }
__device__ __forceinline__ unsigned xb_xcc_id() { return (unsigned)__builtin_amdgcn_s_getreg((3 << 11) | 20) & 0xFu; }
#define XB_SPIN(cond, bar) do { unsigned _sp = 0; while (cond) { __builtin_amdgcn_s_sleep(1); \
    if ((++_sp & 255u) == 0u) { if (xb_ld(&(bar)[XB_TMO])) break; if (_sp > XB_SPIN_CAP) { atomicAdd(&(bar)[XB_TMO], 1u); break; } } } } while (0)

struct XcdBarrier {
    unsigned* bar; unsigned x;
    volatile LAS unsigned* st;
};

__device__ __forceinline__ XcdBarrier xcd_barrier_post(unsigned* bar, volatile LAS unsigned* st) {
    XcdBarrier b; b.bar = bar; b.x = xb_xcc_id(); b.st = st;
    if (threadIdx.x == 0) (void)xb_add(&bar[XB_XCNT(b.x)], 1u);
    return b;
}
__device__ __forceinline__ void xcd_barrier_complete(unsigned* bar, unsigned x, unsigned& nloc, unsigned& nx) {
    const unsigned G = gridDim.x * gridDim.y * gridDim.z;
    unsigned sum, cnt, mine, sp = 0u;
    for (;;) {
        sum = 0u; cnt = 0u; mine = 0u;
#pragma unroll
        for (unsigned j = 0; j < 16; ++j) { const unsigned c = xb_ld(&bar[XB_XCNT(j)]); sum += c; cnt += (c > 0u) ? 1u : 0u; mine = (j == x) ? c : mine; }
        if (sum == G) break;
        __builtin_amdgcn_s_sleep(1);
        if ((++sp & 255u) == 0u) { if (xb_ld(&bar[XB_TMO])) break; if (sp > XB_SPIN_CAP) { atomicAdd(&bar[XB_TMO], 1u); break; } }
    }
    nloc = mine > 0u ? mine : 1u; nx = cnt > 0u ? cnt : 1u;
}

__device__ __forceinline__ void xcd_barrier(const XcdBarrier& b) {
    asm volatile("s_waitcnt vmcnt(0)" ::: "memory");
    __syncthreads();
    if (threadIdx.x == 0) {
        unsigned* bar = b.bar;
        __builtin_amdgcn_s_waitcnt(0);
        unsigned nloc = b.st[0], nx = b.st[1];
        if (nloc == 0u) { xcd_barrier_complete(bar, b.x, nloc, nx); b.st[0] = nloc; b.st[1] = nx; }
        const unsigned old = xb_add(&bar[XB_XSUB(b.x)], 1u);
        const unsigned gen = old / nloc;
        if (old + 1u == (gen + 1u) * nloc) {
            __builtin_amdgcn_fence(__ATOMIC_RELEASE, "agent");
            asm volatile("s_waitcnt vmcnt(0)" ::: "memory");
            const unsigned og = xb_add(&bar[XB_TOP], 1u);
            const unsigned tg = og / nx;
            if (og + 1u == (tg + 1u) * nx) xb_add(&bar[XB_TOPGEN], 1u);
            else XB_SPIN(xb_ld(&bar[XB_TOPGEN]) == tg, bar);
            __builtin_amdgcn_fence(__ATOMIC_ACQUIRE, "agent");
            xb_add(&bar[XB_XGEN(b.x)], 1u);
            asm volatile("s_waitcnt vmcnt(0)" ::: "memory");
        } else {
            XB_SPIN(xb_ld(&bar[XB_XGEN(b.x)]) == gen, bar);
            __builtin_amdgcn_fence(__ATOMIC_ACQUIRE, "agent");
            asm volatile("s_waitcnt vmcnt(0)" ::: "memory");
        }
    }
    __syncthreads();
}

#define XB_MISMATCH 192
__device__ __forceinline__ void xcd_local_barrier(const XcdBarrier& b) {
    asm volatile("s_waitcnt vmcnt(0)" ::: "memory");
    __syncthreads();
    if (threadIdx.x == 0) {
        unsigned* bar = b.bar;
        __builtin_amdgcn_s_waitcnt(0);
        const unsigned nloc = b.st[0];
        const unsigned old = xb_add(&bar[XB_XSUB(b.x)], 1u);
        const unsigned gen = old / nloc;
        if (old + 1u == (gen + 1u) * nloc) xb_add(&bar[XB_XGEN(b.x)], 1u);
        else XB_SPIN(xb_ld(&bar[XB_XGEN(b.x)]) == gen, bar);
        __builtin_amdgcn_fence(__ATOMIC_ACQUIRE, "agent");
        asm volatile("s_waitcnt vmcnt(0)" ::: "memory");
    }
    __syncthreads();
}

__device__ __forceinline__ void xcd_barrier_arrive(const XcdBarrier& b) {
    asm volatile("s_waitcnt vmcnt(0)" ::: "memory");
    __syncthreads();
    if (threadIdx.x == 0) {
        unsigned* bar = b.bar;
        __builtin_amdgcn_s_waitcnt(0);
        const unsigned nloc = b.st[0], nx = b.st[1];
        const unsigned old = xb_add(&bar[XB_XSUB(b.x)], 1u);
        const unsigned gen = old / nloc;
        if (old + 1u == (gen + 1u) * nloc) {
            __builtin_amdgcn_fence(__ATOMIC_RELEASE, "agent");
            asm volatile("s_waitcnt vmcnt(0)" ::: "memory");
            const unsigned og = xb_add(&bar[XB_TOP], 1u);
            const unsigned tg = og / nx;
            if (og + 1u == (tg + 1u) * nx) xb_add(&bar[XB_TOPGEN], 1u);
            xb_add(&bar[XB_XGEN(b.x)], 1u);
        } else {
            XB_SPIN(xb_ld(&bar[XB_XGEN(b.x)]) == gen, bar);
        }
        __builtin_amdgcn_fence(__ATOMIC_ACQUIRE, "agent");
        asm volatile("s_waitcnt vmcnt(0)" ::: "memory");
    }
    __syncthreads();
}
__device__ __forceinline__ void xcd_barrier_wait_top(const XcdBarrier& b, unsigned target) {
    if (threadIdx.x == 0) {
        unsigned* bar = b.bar;
        XB_SPIN(xb_ld(&bar[XB_TOPGEN]) < target, bar);
        __builtin_amdgcn_fence(__ATOMIC_ACQUIRE, "agent");
        asm volatile("s_waitcnt vmcnt(0)" ::: "memory");
    }
    __syncthreads();
}

constexpr size_t WS_BAR = 22 * MiB + 256 * 1024;
constexpr int LDS_ST_OFF = 147392;

__device__ __forceinline__ XcdBarrier mkbar(const Args& a, LAS unsigned char* lds) { XcdBarrier b; b.bar = (unsigned*)(a.ws + WS_BAR); b.x = xb_xcc_id(); b.st = (volatile LAS unsigned*)(lds + LDS_ST_OFF); return b; }

struct EpiFinal {
    static constexpr bool PERM = true, AFTER_DRAIN = true;
    const bf16* x1b; float* out; float* ss; const float* gfin; unsigned char* wsb; int fast;
    __device__ __forceinline__ void fused(const f32x4 (&acc)[2][2][4][2], const pg8::Unit& u, int wr, int wc, int fr, int fq, LAS unsigned char* lds, int wid, int lane) const {
        const int row0 = u.pm * 256 + wr * 64 + fr, col0 = u.pn * 256 + 32 * wc + 8 * fq;
        f32x4 v[2][4][2][2];
#pragma unroll
        for (int ai = 0; ai < 2; ++ai)
#pragma unroll
            for (int m = 0; m < 4; ++m) { const int row = row0 + ai * 128 + m * 16; float s = 0.f;
#pragma unroll
                for (int bj = 0; bj < 2; ++bj) { const size_t off = (size_t)row * 1024 + col0 + bj * 128;
                    const u32x4 r = *(const u32x4*)(x1b + off);
                    const f32x4 v0 = (f32x4){bflo(r.x), bfhi(r.x), bflo(r.y), bfhi(r.y)} + acc[ai][bj][m][0], v1 = (f32x4){bflo(r.z), bfhi(r.z), bflo(r.w), bfhi(r.w)} + acc[ai][bj][m][1];
                    v[ai][m][bj][0] = v0; v[ai][m][bj][1] = v1;
                    s += (v0.x * v0.x + v0.y * v0.y) + (v0.z * v0.z + v0.w * v0.w) + (v1.x * v1.x + v1.y * v1.y) + (v1.z * v1.z + v1.w * v1.w); }
                s = fq_sum(s);
                if (fq == 0) ss[(size_t)row * 16 + u.pn * 4 + wc] = s; }
        { XcdBarrier b; b.bar = (unsigned*)(wsb + WS_BAR); b.x = xb_xcc_id(); b.st = (volatile LAS unsigned*)(lds + LDS_ST_OFF); if (fast) xcd_local_barrier(b); else xcd_barrier(b); }
        f32x4 g[2][2];
#pragma unroll
        for (int bj = 0; bj < 2; ++bj) { g[bj][0] = *(const f32x4*)(gfin + col0 + bj * 128); g[bj][1] = *(const f32x4*)(gfin + col0 + bj * 128 + 4); }
#pragma unroll
        for (int ai = 0; ai < 2; ++ai)
#pragma unroll
            for (int m = 0; m < 4; ++m) { const int row = row0 + ai * 128 + m * 16;
                const float rs = 1.f / sqrtf(sum16(ss + (size_t)row * 16) * (1.f / DM) + EPS);
#pragma unroll
                for (int bj = 0; bj < 2; ++bj) { const size_t off = (size_t)row * 1024 + col0 + bj * 128;
                    *(f32x4*)(out + off) = v[ai][m][bj][0] * rs * g[bj][0]; *(f32x4*)(out + off + 4) = v[ai][m][bj][1] * rs * g[bj][1]; } }
    }
};

#ifndef PH
#define PH 0xFF
#endif
__global__ void __launch_bounds__(512, 2) fwd_megakernel(Args a) {
    extern __shared__ __attribute__((aligned(16))) unsigned char lds_raw[];
    LAS unsigned char* lds = (LAS unsigned char*)lds_raw;
    cg::grid_group grid = cg::this_grid();
    unsigned char* ws = a.ws;
    const int G = gridDim.x, bid = blockIdx.x;

    volatile LAS unsigned* st = (volatile LAS unsigned*)(lds + LDS_ST_OFF);
    unsigned* barw = (unsigned*)(ws + WS_BAR);
    if (threadIdx.x < 4) st[threadIdx.x] = 0u;
    __syncthreads();
    (void)xcd_barrier_post(barw, st);
    if (threadIdx.x == 0) atomicOr(barw + 64 + (bid & 7), 1u << xb_xcc_id());
    if (a.use_cg_sync) grid.sync();
#if (PH >> 0) & 1
    p0_prep(a, lds);
#ifdef DUP_P0
    p0_prep(a, lds);
#endif
#endif
    xcd_barrier(mkbar(a, lds));
    bool fast = (G == 256);
#pragma unroll
    for (int g8 = 0; g8 < 8; ++g8) { const unsigned m = (unsigned)__builtin_amdgcn_readfirstlane((int)xb_ld(barw + 64 + g8)); fast = fast && (m != 0u) && ((m & (m - 1u)) == 0u); }
#ifdef PROBE_FAST
    if (!fast) return;
#endif
#define LOCAL_BAR() do { if (fast) xcd_local_barrier(mkbar(a, lds)); else xcd_barrier(mkbar(a, lds)); } while (0)
#ifdef DUP_BAR
#define GRID_BAR() do { xcd_barrier(mkbar(a, lds)); xcd_barrier(mkbar(a, lds)); } while (0)
#else
#define GRID_BAR() xcd_barrier(mkbar(a, lds))
#endif
#if (PH >> 1) & 1
    {
        pg8::Gemm g{(const bf16*)(ws + WS_XB), (const bf16*)(ws + WS_W0T), MTOK, 5120, 1024}; pg8::StaticOrder S; S.init(MTOK, 5120, G, bid);
        EpiIn0 E{(const float*)(ws + WS_R0), (bf16*)(ws + WS_UG), (bf16*)(ws + WS_GV), (bf16*)(ws + WS_BX), (bf16*)(ws + WS_BG), (float*)(ws + WS_VSS)};
        pg8::gemm_phase<EpiIn0, pg8::StaticOrder, true, true>(lds, g, S, E);
    }
#endif
    if (fast) xcd_barrier_arrive(mkbar(a, lds)); else xcd_barrier(mkbar(a, lds));
#if (PH >> 2) & 1
    {
        u32x4 pf[9];
        int tid_ = threadIdx.x; asm volatile("" : "+v"(tid_));
        int kind = 0, idx = bid;
        if (idx >= 512) kind = 2;
        issue_next(a, kind, idx, tid_, pf);
        while (kind < 2) {
            int nkind = kind, nidx = idx + G;
            if (nidx >= 512) { nkind = kind + 1; nidx = bid; }
            if (fast && kind == 0 && nkind == 1) xcd_barrier_wait_top(mkbar(a, lds), 2u);
            if (kind == 0) mixer_a_unit(a, lds, unit_tile(idx), unit_grp(idx), pf, nkind, nidx);
            else           mixer_b_unit(a, lds, unit_tile(idx), unit_grp(idx), pf, nkind, nidx);
            kind = nkind; idx = nidx;
        }
    }
#endif
    LOCAL_BAR();
#if (PH >> 3) & 1
    {
        pg8::Gemm g{(const bf16*)a.out, (const bf16*)(ws + WS_WO0T), MTOK, 1024, 2048}; pg8::StaticOrder S; S.init(MTOK, 1024, G, bid);
        typedef EpiRes<true, false, true> Epi3;
        Epi3 E{(const void*)(ws + WS_XB), nullptr, (bf16*)(ws + WS_XB), (float*)(ws + WS_SS1)};
        pg8::gemm_phase<Epi3, pg8::StaticOrder, true, true>(lds, g, S, E);
#ifdef DUP_G2
        pg8::gemm_phase<Epi3, pg8::StaticOrder, true, true>(lds, g, S, E);
#endif
    }
#endif
    LOCAL_BAR();
#if (PH >> 4) & 1
    {
        pg8::Gemm g{(const bf16*)(ws + WS_XB), (const bf16*)(ws + WS_W1T), MTOK, 2560, 1024}; pg8::StaticOrder S; S.init(MTOK, 2560, G, bid);
        EpiIn1 E{(const float*)(ws + WS_SS1), (const unsigned*)(ws + WS_ROPE), (bf16*)(ws + WS_Q), (bf16*)(ws + WS_K), (bf16*)(ws + WS_VT), (bf16*)(ws + WS_G)};
        pg8::gemm_phase<EpiIn1, pg8::StaticOrder, true, true>(lds, g, S, E);
#ifdef DUP_G3
        pg8::gemm_phase<EpiIn1, pg8::StaticOrder, true, true>(lds, g, S, E);
#endif
    }
#endif
    GRID_BAR();
#if (PH >> 5) & 1
#ifndef DUP_ATT
#define DUP_ATT 1
#endif
    {
        u32x4 kr[6], vr[6];
        int tid_ = threadIdx.x; asm volatile("" : "+v"(tid_));
        attn_issue(a, bid, tid_, kr, vr);
        for (int u = bid; u < 512; u += G) attn_unit(a, lds, unit_tile(u) >> 6, unit_tile(u) & 63, unit_grp(u), kr, vr, u + G);
    }
#endif
    LOCAL_BAR();
#if (PH >> 6) & 1
    if (G == 256) {
        pg8::Gemm g{(const bf16*)(ws + WS_Y1), (const bf16*)(ws + WS_WO1T), MTOK, 1024, 1024}; pg8::StaticOrder S; S.init(MTOK, 1024, G, bid);
        EpiFinal E{(const bf16*)(ws + WS_XB), a.out, (float*)(ws + WS_SS2), a.in[13], a.ws, fast ? 1 : 0};
        pg8::gemm_phase<EpiFinal, pg8::StaticOrder, false, true>(lds, g, S, E);
#ifdef DUP_G4
        pg8::gemm_phase<EpiFinal, pg8::StaticOrder, false, true>(lds, g, S, E);
#endif
    } else {
        {
            pg8::Gemm g{(const bf16*)(ws + WS_Y1), (const bf16*)(ws + WS_WO1T), MTOK, 1024, 1024}; pg8::StaticOrder S; S.init(MTOK, 1024, G, bid);
            typedef EpiRes<true, true, false> Epi6;
            Epi6 E{(const void*)(ws + WS_XB), a.out, nullptr, (float*)(ws + WS_SS2)};
            pg8::gemm_phase<Epi6, pg8::StaticOrder, true, true>(lds, g, S, E);
        }
        GRID_BAR();
        int tid_ = threadIdx.x; asm volatile("" : "+v"(tid_));
        const int tid = tid_, lane = tid & 63, wave = __builtin_amdgcn_readfirstlane(tid >> 6), gw = bid * 8 + wave, NGW = G * 8;
        const float* ss2 = (const float*)(ws + WS_SS2); const f32x4* fn = (const f32x4*)a.in[13] + lane;
        f32x4 gn[4];
#pragma unroll
        for (int j = 0; j < 4; ++j) gn[j] = fn[64 * j];
        for (int m = gw; m < MTOK; m += NGW) {
            const float rs = 1.f / sqrtf(sum16(ss2 + (size_t)m * 16) * (1.f / DM) + EPS);
            f32x4* xr = (f32x4*)(a.out + (size_t)m * DM) + lane;
#pragma unroll
            for (int j = 0; j < 4; ++j) xr[64 * j] = xr[64 * j] * rs * gn[j];
        }
    }
#endif
}

extern "C" void kernel_launch(void* const* d_in, const int* in_sizes, int n_in, void* d_out, int out_size, void* d_ws, size_t ws_size, hipStream_t stream) {
    static int grid = 0;
    if (grid == 0) {
        if (n_in != 14 || out_size != MTOK * DM || ws_size < WS_END) { fprintf(stderr, "kernel_launch: unexpected problem shape (n_in %d out %d ws %zu)\n", n_in, out_size, ws_size); grid = -1; return; }
        int dev = 0, cus = 0, per_cu = 0;
        hipGetDevice(&dev);
        hipDeviceGetAttribute(&cus, hipDeviceAttributeMultiprocessorCount, dev);
        if (hipFuncSetAttribute((const void*)fwd_megakernel, hipFuncAttributeMaxDynamicSharedMemorySize, LDS_BYTES) != hipSuccess) { fprintf(stderr, "kernel_launch: hipFuncSetAttribute failed\n"); grid = -1; return; }
        if (hipOccupancyMaxActiveBlocksPerMultiprocessor(&per_cu, (const void*)fwd_megakernel, 512, LDS_BYTES) != hipSuccess || per_cu < 1) { fprintf(stderr, "kernel_launch: occupancy query failed (%d)\n", per_cu); (void)hipGetLastError(); grid = -1; return; }
        grid = cus * per_cu;
    }
    if (grid < 0) return;
    if (hipMemsetAsync((char*)d_ws + WS_BAR, 0, XCD_BAR_WORDS * 4, stream) != hipSuccess) { fprintf(stderr, "kernel_launch: hipMemsetAsync failed\n"); return; }
    Args a{};
    for (int i = 0; i < 14; ++i) a.in[i] = (const float*)d_in[i];
    a.out = (float*)d_out; a.ws = (unsigned char*)d_ws;
    void* args[] = {&a};
    hipError_t e = hipLaunchCooperativeKernel((const void*)fwd_megakernel, dim3(grid), dim3(512), args, LDS_BYTES, stream);
    if (e != hipSuccess) fprintf(stderr, "kernel_launch: cooperative launch failed: %s (grid %d)\n", hipGetErrorString(e), grid);
}
```

```cpp
#include <hip/hip_runtime.h>
#include <hip/hip_cooperative_groups.h>
#include <cstdio>
#include <cstdint>
namespace cg = cooperative_groups;
namespace pg8 {
#define PG8_LAS __attribute__((address_space(3)))
typedef unsigned short bf16_t;
typedef short bf16x8 __attribute__((ext_vector_type(8)));
typedef float f32x4 __attribute__((ext_vector_type(4)));
typedef unsigned u32x4 __attribute__((ext_vector_type(4)));
constexpr int BM = 256, BK = 64, HALF = 128, HTB = HALF * BK * 2  , STAGE_BYTES = 8 * HTB, NXCD = 8, WGM = 8;

__host__ __device__ __forceinline__ int lds_byte(int r, int c) { const int st = (r >> 4) * 2 + (c >> 5), rr = r & 15, cc = c & 31, ob = rr * 64 + cc * 2; return st * 1024 + (ob ^ (((ob >> 9) & 1) << 5)); }
__host__ __device__ __forceinline__ void stage_rc(int b, int& R, int& C) { const int st = b / 1024, sb = b % 1024, swz = sb ^ (((sb >> 9) & 1) << 5); R = (st >> 1) * 16 + swz / 64; C = (st & 1) * 32 + (swz % 64) / 2; }
__host__ __device__ __forceinline__ int perm32(int rho) { const int n = rho >> 4, i = rho & 15; return 8 * (i >> 2) + 4 * n + (i & 3); }

struct Unit { int pm, pn; };
struct Gemm { const bf16_t* A; const bf16_t* Bt; int M, N, K; };

struct StaticOrder {
    int nM, nN, nwg, G, c;
    __host__ __device__ void init(int M, int N, int G_, int c_) { nM = M / BM; nN = N / BM; nwg = nM * nN; G = G_; c = c_; }
    __host__ __device__ bool next(int i, Unit& u) const {
        const long L = (long)i * G + c; if (L >= nwg) return false;
        int wgid = (int)L; { const int q = nwg / NXCD, r = nwg % NXCD, xcd = wgid % NXCD, off = wgid / NXCD; wgid = (xcd < r ? xcd * (q + 1) : r * (q + 1) + (xcd - r) * q) + off; }
        const int nig = WGM * nN, gid = wgid / nig, fm = gid * WGM, gsz = (nM - fm) < WGM ? (nM - fm) : WGM;
        u.pm = fm + ((wgid % nig) % gsz); u.pn = (wgid % nig) / gsz; return true;
    }
    __device__ __forceinline__ void a_ready(const Unit&) const {}
    __device__ __forceinline__ void done(const Unit&) const {}
};

__device__ __forceinline__ unsigned cvt_pk_bf16(float lo, float hi) { unsigned r; asm volatile("v_cvt_pk_bf16_f32 %0, %1, %2" : "=v"(r) : "v"(lo), "v"(hi)); return r; }
template <class Epi, class Sched, bool ALIGN_EPI = false, bool SP2 = false>
__device__ __forceinline__ void gemm_phase(PG8_LAS unsigned char* lds, const Gemm g, const Sched& S, const Epi& E) {
    int tid_ = threadIdx.x; asm volatile("" : "+v"(tid_));
    const int tid = tid_, wid = __builtin_amdgcn_readfirstlane(tid >> 6), lane = tid & 63, wr = wid >> 2, wc = wid & 3, fr = lane & 15, fq = lane >> 4;
    const int K = g.K, nt = K / BK;
    unsigned voffA[2], voffB[2];
#pragma unroll
    for (int i = 0; i < 2; ++i) { int R, C; stage_rc(tid * 16 + i * 8192, R, C); const int Rb = Epi::PERM ? ((R & ~31) + perm32(R & 31)) : R;
        voffA[i] = (unsigned)(R * K + C) * 2u; voffB[i] = (unsigned)(Rb * K + C) * 2u; }
    const size_t kstep = (size_t)(BK * 2);
    const size_t hstep = (size_t)HALF * K * 2;
    const size_t tstep = 2 * hstep;
    const unsigned ldsw = (unsigned)wid * 1024u;
    const int aoff = lds_byte(wr * 64 + fr, fq * 8), boff = lds_byte(wc * 32 + fr, fq * 8);
#define PG8_SA(b, h) (((b) * 2 + (h)) * HTB)
#define PG8_SB(b, h) ((4 + (b) * 2 + (h)) * HTB)
#define PG8_STAGE(bufoff, gbase, voff) do { _Pragma("unroll") for (int _i = 0; _i < 2; ++_i) \
        __builtin_amdgcn_global_load_lds((const unsigned*)((const char*)(gbase) + (voff)[_i]), (PG8_LAS unsigned*)(lds + (bufoff) + ldsw + _i * 8192), 16, 0, 0); } while (0)
#define PG8_LDA(dst, b, h) do { _Pragma("unroll") for (int m = 0; m < 4; ++m) _Pragma("unroll") for (int k = 0; k < 2; ++k) dst[m][k] = *(const PG8_LAS bf16x8*)(lds + PG8_SA(b, h) + aoff + m * 2048 + k * 1024); } while (0)
#define PG8_LDB(dst, b, h) do { _Pragma("unroll") for (int n = 0; n < 2; ++n) _Pragma("unroll") for (int k = 0; k < 2; ++k) dst[n][k] = *(const PG8_LAS bf16x8*)(lds + PG8_SB(b, h) + boff + n * 2048 + k * 1024); } while (0)
#define PG8_MMA(ai, bj, At, Bt) do { __builtin_amdgcn_s_setprio(1); _Pragma("unroll") for (int m = 0; m < 4; ++m) _Pragma("unroll") for (int n = 0; n < 2; ++n) _Pragma("unroll") for (int k = 0; k < 2; ++k) \
        acc[ai][bj][m][n] = __builtin_amdgcn_mfma_f32_16x16x32_bf16(Bt[n][k], At[m][k], acc[ai][bj][m][n], 0, 0, 0); __builtin_amdgcn_s_setprio(0); } while (0)
#define PG8_WAIT_V(n) asm volatile("s_waitcnt vmcnt(" #n ")" ::: "memory")
#define PG8_WAIT_L(n) asm volatile("s_waitcnt lgkmcnt(" #n ")" ::: "memory")
#define PG8_BAR __builtin_amdgcn_s_barrier()
#define PG8_SCHED __builtin_amdgcn_sched_barrier(0)
    Unit cur, nxt; int ui = 0;
    if (!S.next(0, cur)) return;
    f32x4 acc[2][2][4][2];
#pragma unroll
    for (int a = 0; a < 2; ++a)
#pragma unroll
        for (int b = 0; b < 2; ++b)
#pragma unroll
            for (int m = 0; m < 4; ++m)
#pragma unroll
                for (int n = 0; n < 2; ++n) acc[a][b][m][n] = (f32x4){0.f, 0.f, 0.f, 0.f};
    bf16x8 At[4][2], B0[2][2], B1[2][2];
    const char* cA = (const char*)g.A + (size_t)cur.pm * tstep; const char* cB = (const char*)g.Bt + (size_t)cur.pn * tstep;
    S.a_ready(cur);
    if constexpr (SP2) {
        PG8_STAGE(PG8_SB(0, 0), cB, voffB); PG8_STAGE(PG8_SB(0, 1), cB + hstep, voffB); PG8_STAGE(PG8_SA(0, 0), cA, voffA); PG8_STAGE(PG8_SA(0, 1), cA + hstep, voffA);
        if (wr == 1) PG8_BAR;
        PG8_WAIT_V(2); PG8_BAR;
        PG8_STAGE(PG8_SB(1, 0), cB + kstep, voffB); PG8_STAGE(PG8_SA(1, 0), cA + kstep, voffA); PG8_STAGE(PG8_SB(1, 1), cB + hstep + kstep, voffB);
        PG8_WAIT_V(6); PG8_BAR;
    } else {
        PG8_STAGE(PG8_SB(0, 0), cB, voffB); PG8_STAGE(PG8_SA(0, 0), cA, voffA); PG8_STAGE(PG8_SB(0, 1), cB + hstep, voffB); PG8_STAGE(PG8_SA(0, 1), cA + hstep, voffA);
        if (wr == 1) PG8_BAR;
        PG8_WAIT_V(4); PG8_BAR;
        PG8_STAGE(PG8_SB(1, 0), cB + kstep, voffB); PG8_STAGE(PG8_SA(1, 0), cA + kstep, voffA); PG8_STAGE(PG8_SB(1, 1), cB + hstep + kstep, voffB);
        PG8_WAIT_V(6); PG8_BAR;
    }
    for (;;) {
        const bool has_next = S.next(ui + 1, nxt);
        const char* nA = has_next ? (const char*)g.A + (size_t)nxt.pm * tstep : cA; const char* nB = has_next ? (const char*)g.Bt + (size_t)nxt.pn * tstep : cB;
        for (int t = 0; t < nt; t += 2) {
            const bool last = (t == nt - 2);
            const char* a1 = cA + (size_t)(t + 1) * kstep;
            const char* a2 = last ? nA : cA + (size_t)(t + 2) * kstep; const char* b2 = last ? nB : cB + (size_t)(t + 2) * kstep;
            const char* a3 = a2 + kstep; const char* b3 = b2 + kstep;
            if (last && has_next) S.a_ready(nxt);
            if constexpr (SP2) {
            PG8_LDB(B0, 0, 0); PG8_LDB(B1, 0, 1); PG8_SCHED; PG8_LDA(At, 0, 0); PG8_STAGE(PG8_SA(1, 1), a1 + hstep, voffA);
            PG8_WAIT_V(8); PG8_WAIT_L(0); PG8_BAR; PG8_MMA(0, 0, At, B0); PG8_MMA(0, 1, At, B1); PG8_BAR; PG8_SCHED;
            PG8_LDA(At, 0, 1); PG8_STAGE(PG8_SB(0, 0), b2, voffB); PG8_STAGE(PG8_SB(0, 1), b2 + hstep, voffB); PG8_STAGE(PG8_SA(0, 0), a2, voffA);
            PG8_WAIT_V(8); PG8_WAIT_L(0); PG8_BAR; PG8_MMA(1, 0, At, B0); PG8_MMA(1, 1, At, B1); PG8_BAR; PG8_SCHED;
            PG8_LDB(B0, 1, 0); PG8_LDB(B1, 1, 1); PG8_SCHED; PG8_LDA(At, 1, 0); PG8_STAGE(PG8_SA(0, 1), a2 + hstep, voffA);
            PG8_WAIT_V(8); PG8_WAIT_L(0); PG8_BAR; PG8_MMA(0, 0, At, B0); PG8_MMA(0, 1, At, B1); PG8_BAR; PG8_SCHED;
            PG8_LDA(At, 1, 1); PG8_STAGE(PG8_SB(1, 0), b3, voffB); PG8_STAGE(PG8_SB(1, 1), b3 + hstep, voffB); PG8_STAGE(PG8_SA(1, 0), a3, voffA);
            PG8_WAIT_V(8); PG8_WAIT_L(0); PG8_BAR; PG8_MMA(1, 0, At, B0); PG8_MMA(1, 1, At, B1); PG8_BAR; PG8_SCHED;
            } else {
            PG8_LDB(B0, 0, 0); PG8_SCHED; PG8_LDA(At, 0, 0); PG8_STAGE(PG8_SA(1, 1), a1 + hstep, voffA);
            PG8_WAIT_L(8); PG8_BAR; PG8_WAIT_L(0); PG8_MMA(0, 0, At, B0); PG8_BAR; PG8_SCHED;
            PG8_LDB(B1, 0, 1); PG8_STAGE(PG8_SB(0, 0), b2, voffB);
            PG8_BAR; PG8_WAIT_L(0); PG8_MMA(0, 1, At, B1); PG8_BAR;
            PG8_LDA(At, 0, 1); PG8_STAGE(PG8_SA(0, 0), a2, voffA);
            PG8_BAR; PG8_WAIT_L(0); PG8_MMA(1, 0, At, B0); PG8_BAR; PG8_SCHED;
            PG8_STAGE(PG8_SB(0, 1), b2 + hstep, voffB);
            PG8_WAIT_V(6); PG8_BAR; PG8_MMA(1, 1, At, B1); PG8_BAR;
            PG8_LDB(B0, 1, 0); PG8_SCHED; PG8_LDA(At, 1, 0); PG8_STAGE(PG8_SA(0, 1), a2 + hstep, voffA);
            PG8_WAIT_L(8); PG8_BAR; PG8_WAIT_L(0); PG8_MMA(0, 0, At, B0); PG8_BAR; PG8_SCHED;
            PG8_LDB(B1, 1, 1); PG8_STAGE(PG8_SB(1, 0), b3, voffB);
            PG8_BAR; PG8_WAIT_L(0); PG8_MMA(0, 1, At, B1); PG8_BAR;
            PG8_LDA(At, 1, 1); PG8_STAGE(PG8_SA(1, 0), a3, voffA);
            PG8_BAR; PG8_WAIT_L(0); PG8_MMA(1, 0, At, B0); PG8_BAR; PG8_SCHED;
            PG8_STAGE(PG8_SB(1, 1), b3 + hstep, voffB);
            PG8_WAIT_V(6); PG8_BAR; PG8_MMA(1, 1, At, B1); PG8_BAR;
            }
        }
        if constexpr (ALIGN_EPI) { if (wr == 0) PG8_BAR; }
        if constexpr (!Epi::AFTER_DRAIN) { E(acc, cur, wr, wc, fr, fq); S.done(cur); }
        if (!has_next) break;
#pragma unroll
        for (int a = 0; a < 2; ++a)
#pragma unroll
            for (int b = 0; b < 2; ++b)
#pragma unroll
                for (int m = 0; m < 4; ++m)
#pragma unroll
                    for (int n = 0; n < 2; ++n) acc[a][b][m][n] = (f32x4){0.f, 0.f, 0.f, 0.f};
        cur = nxt; cA = nA; cB = nB; ++ui;
        if constexpr (ALIGN_EPI) { if (wr == 1) PG8_BAR; }
    }
    PG8_WAIT_V(0);
    if constexpr (!ALIGN_EPI) { if (wr == 0) PG8_BAR; }
    PG8_BAR;
    if constexpr (Epi::AFTER_DRAIN) { E.fused(acc, cur, wr, wc, fr, fq, lds, wid, lane); S.done(cur); }
#undef PG8_SA
#undef PG8_SB
#undef PG8_STAGE
#undef PG8_LDA
#undef PG8_LDB
#undef PG8_MMA
#undef PG8_WAIT_V
#undef PG8_WAIT_L
#undef PG8_BAR
#undef PG8_SCHED
}
}

#define LAS __attribute__((address_space(3)))
typedef unsigned short bf16;
typedef float f32x4 __attribute__((ext_vector_type(4)));
typedef float f32x2 __attribute__((ext_vector_type(2)));
typedef unsigned u32x4 __attribute__((ext_vector_type(4)));
typedef unsigned u32x2 __attribute__((ext_vector_type(2)));
typedef short bf16x8 __attribute__((ext_vector_type(8)));
typedef short s16x4 __attribute__((ext_vector_type(4)));

constexpr int SEQ = 8192, DM = 1024, MTOK = 16384;
constexpr int LDS_BYTES = 147456;
constexpr float EPS = 1e-6f;
constexpr float LOG2E = 1.4426950408889634f;
constexpr float QSCALE = 0.125f * LOG2E;

constexpr size_t MiB = 1u << 20;
constexpr size_t WS_W0T  = 0;
constexpr size_t WS_WO0T = 10 * MiB;
constexpr size_t WS_W1T  = 14 * MiB;
constexpr size_t WS_WO1T = 19 * MiB;
constexpr size_t WS_WGT  = 21 * MiB;
constexpr size_t WS_ROPE = 21 * MiB + 512 * 1024;
constexpr size_t WS_R0   = 22 * MiB;
constexpr size_t WS_VSS  = 23 * MiB;
constexpr size_t WS_SS1  = 24 * MiB;
constexpr size_t WS_SS2  = 25 * MiB;
constexpr size_t WS_XB   = 26 * MiB;
constexpr size_t WS_Z    = 58 * MiB;
constexpr size_t WS_UG = WS_Z, WS_GV = WS_Z + 32 * MiB, WS_BX = WS_Z + 64 * MiB, WS_BG = WS_Z + 96 * MiB;
constexpr size_t WS_Q  = WS_Z;
constexpr size_t WS_G  = WS_Z + 32 * MiB;
constexpr size_t WS_Y1 = WS_Z + 64 * MiB;
constexpr size_t WS_K  = WS_Z + 128 * MiB;
constexpr size_t WS_VT = WS_Z + 136 * MiB;
constexpr size_t WS_END = WS_Z + 144 * MiB;

__device__ __forceinline__ unsigned cvtpk(float lo, float hi) { return pg8::cvt_pk_bf16(lo, hi); }
__device__ __forceinline__ float bflo(unsigned u) { return __builtin_bit_cast(float, u << 16); }
__device__ __forceinline__ float bfhi(unsigned u) { return __builtin_bit_cast(float, u & 0xffff0000u); }
__device__ __forceinline__ float fast_exp2(float x) { return __builtin_amdgcn_exp2f(x); }
__device__ __forceinline__ float fast_rcp(float x) { return __builtin_amdgcn_rcpf(x); }
__device__ __forceinline__ float silu_f(float x) { return x * fast_rcp(1.f + fast_exp2(-x * LOG2E)); }
__device__ __forceinline__ float gelu_f(float x) { const float t = x * (1.f + 0.044715f * x * x) * (-1.5957691216057308f * LOG2E); return x * fast_rcp(1.f + fast_exp2(t)); }
__device__ __forceinline__ f32x2 exp2_2(f32x2 v) { return (f32x2){fast_exp2(v.x), fast_exp2(v.y)}; }
__device__ __forceinline__ f32x2 rcp_2(f32x2 v) { return (f32x2){fast_rcp(v.x), fast_rcp(v.y)}; }
__device__ __forceinline__ f32x2 min_2(f32x2 v, float m) { return (f32x2){fminf(v.x, m), fminf(v.y, m)}; }
constexpr float GC1 = -1.5957691216057308f * LOG2E, GC2 = 0.044715f;
__device__ __forceinline__ f32x2 gelu_arg(f32x2 u) { return min_2((u * u * (GC1 * GC2) + GC1) * u, 126.f); }
__device__ __forceinline__ f32x2 gelu_2(f32x2 u) { return u * rcp_2(exp2_2(gelu_arg(u)) + 1.f); }
__device__ __forceinline__ f32x2 silu_2(f32x2 g) { return g * rcp_2(exp2_2(min_2(g * (-LOG2E), 126.f)) + 1.f); }
__device__ __forceinline__ f32x2 gelu_silu_2(f32x2 u, f32x2 g) {
    const f32x2 e1 = exp2_2(gelu_arg(u)), e2 = exp2_2(min_2(g * (-LOG2E), 126.f));
    const f32x2 d = e1 + 1.f, d2 = e2 * d + d;
    return (u * g) * rcp_2(d2);
}
__device__ __forceinline__ void swap16(float v, float& a, float& b) { const auto r = __builtin_amdgcn_permlane16_swap(__builtin_bit_cast(unsigned, v), __builtin_bit_cast(unsigned, v), false, false); a = __builtin_bit_cast(float, (unsigned)r[0]); b = __builtin_bit_cast(float, (unsigned)r[1]); }
__device__ __forceinline__ void swap32(float v, float& a, float& b) { const auto r = __builtin_amdgcn_permlane32_swap(__builtin_bit_cast(unsigned, v), __builtin_bit_cast(unsigned, v), false, false); a = __builtin_bit_cast(float, (unsigned)r[0]); b = __builtin_bit_cast(float, (unsigned)r[1]); }
__device__ __forceinline__ float max2f(float a, float b) { float r; asm("v_max_f32_e32 %0, %1, %2" : "=v"(r) : "v"(a), "v"(b)); return r; }
__device__ __forceinline__ float fq_sum(float v) { float a, b; swap16(v, a, b); v = a + b; swap32(v, a, b); return a + b; }
__device__ __forceinline__ float fq_max(float v) { float a, b; swap16(v, a, b); v = max2f(a, b); swap32(v, a, b); return max2f(a, b); }
__device__ __forceinline__ float wave_sum(float v) {
#pragma unroll
    for (int o = 1; o < 64; o <<= 1) v += __shfl_xor(v, o);
    return v;
}
__device__ __forceinline__ float sum16(const float* p) {
    const f32x4 a = *(const f32x4*)p, b = *(const f32x4*)(p + 4), c = *(const f32x4*)(p + 8), d = *(const f32x4*)(p + 12);
    return ((a.x + a.y) + (a.z + a.w)) + ((b.x + b.y) + (b.z + b.w)) + (((c.x + c.y) + (c.z + c.w)) + ((d.x + d.y) + (d.z + d.w)));
}
#define LDS_WAIT() asm volatile("s_waitcnt lgkmcnt(0)" ::: "memory")

struct Args {
    const float* in[14];
    float* out; unsigned char* ws;
    int use_cg_sync, pad;
};

__device__ __forceinline__ void transpose_item(const float* __restrict__ W, int K, int N, bf16* __restrict__ WT, const float* __restrict__ g, int k0, int dst_n0, int src_n0, bool permqk, LAS float* scr, int lane) {
    float wv[32];
#pragma unroll
    for (int i = 0; i < 32; ++i) { const int kk = 2 * i + (lane >> 5); wv[i] = __builtin_nontemporal_load(W + (size_t)(k0 + kk) * N + src_n0 + (lane & 31)); }
    if (g) {
#pragma unroll
        for (int i = 0; i < 32; ++i) wv[i] *= g[k0 + 2 * i + (lane >> 5)];
    }
#pragma unroll
    for (int i = 0; i < 32; ++i) scr[(2 * i + (lane >> 5)) * 33 + (lane & 31)] = wv[i];
    LDS_WAIT(); asm volatile("" ::: "memory");
    const int c = lane & 7;
#pragma unroll
    for (int j = 0; j < 4; ++j) { const int n = (lane >> 3) + 8 * j; int ns = n;
        if (permqk && n < 16) ns = (n & 3) | ((n & 4) << 1) | ((n & 8) >> 1);
        const LAS float* s = scr + (8 * c) * 33 + ns;
        u32x4 o; o.x = cvtpk(s[0 * 33], s[1 * 33]); o.y = cvtpk(s[2 * 33], s[3 * 33]); o.z = cvtpk(s[4 * 33], s[5 * 33]); o.w = cvtpk(s[6 * 33], s[7 * 33]);
        *(u32x4*)(WT + (size_t)(dst_n0 + n) * K + k0 + 8 * c) = o; }
    LDS_WAIT(); asm volatile("" ::: "memory");
}

__device__ __forceinline__ void p0_prep(const Args& a, LAS unsigned char* lds) {
    int tid_ = threadIdx.x; asm volatile("" : "+v"(tid_));
    const int tid = tid_, lane = tid & 63, wave = __builtin_amdgcn_readfirstlane(tid >> 6);
    const int G = gridDim.x, gw = blockIdx.x * 8 + wave, NGW = G * 8;
    LAS float* scr = (LAS float*)(lds + wave * 16384);
    unsigned char* ws = a.ws;
    const float* x = a.in[0];
    constexpr int I_W0 = 16 * 160, I_WO0 = 32 * 32, I_W1 = 16 * 80, I_WO1 = 16 * 32, I_WG = 4 * 4 * 8;
    constexpr int NITEMS = I_W0 + I_WO0 + I_W1 + I_WO1 + I_WG;
    for (int it = gw; it < NITEMS; it += NGW) {
        int r = it;
        if (r < I_W0) {
            const int kb = r / 160, nb = r % 160, n0 = nb * 32; int src;
            if (n0 < 2048) { const int pn = n0 >> 8, within = n0 & 255, bj = within >> 7, ch = 128 * pn + (within & 127); src = bj ? 2048 + ch : ch; }
            else if (n0 < 3072) src = 1024 + (n0 - 2048);
            else src = n0;
            transpose_item(a.in[2], 1024, 5120, (bf16*)(ws + WS_W0T), a.in[1], kb * 64, n0, src, false, scr, lane); continue; }
        r -= I_W0;
        if (r < I_WO0) { const int kb = r / 32, nb = r % 32; transpose_item(a.in[8], 2048, 1024, (bf16*)(ws + WS_WO0T), nullptr, kb * 64, nb * 32, nb * 32, false, scr, lane); continue; }
        r -= I_WO0;
        if (r < I_W1) { const int kb = r / 80, nb = r % 80, n0 = nb * 32; const bool pq = (n0 < 1280) && ((n0 & 63) == 0);
            transpose_item(a.in[10], 1024, 2560, (bf16*)(ws + WS_W1T), a.in[9], kb * 64, n0, n0, pq, scr, lane); continue; }
        r -= I_W1;
        if (r < I_WO1) { const int kb = r / 32, nb = r % 32; transpose_item(a.in[12], 1024, 1024, (bf16*)(ws + WS_WO1T), nullptr, kb * 64, nb * 32, nb * 32, false, scr, lane); continue; }
        r -= I_WO1;
        { const int gi = r / 32, rr = r % 32, kb = rr / 8, nb = rr % 8;
          transpose_item(a.in[6] + (size_t)gi * 65536, 256, 256, (bf16*)(ws + WS_WGT) + (size_t)gi * 65536, nullptr, kb * 64, nb * 32, nb * 32, false, scr, lane); }
    }
    {
        bf16* XB = (bf16*)(ws + WS_XB); float* R0 = (float*)(ws + WS_R0);
        for (int m0 = gw; m0 < MTOK; m0 += 4 * NGW) {
            f32x4 v[4][4];
#pragma unroll
            for (int r = 0; r < 4; ++r) { const int m = min(m0 + r * NGW, MTOK - 1); const f32x4* xr = (const f32x4*)(x + (size_t)m * DM) + lane;
#pragma unroll
                for (int j = 0; j < 4; ++j) v[r][j] = __builtin_nontemporal_load(xr + 64 * j); }
#pragma unroll
            for (int r = 0; r < 4; ++r) { const int m = m0 + r * NGW; float s = 0.f;
#pragma unroll
                for (int j = 0; j < 4; ++j) s += (v[r][j].x * v[r][j].x + v[r][j].y * v[r][j].y) + (v[r][j].z * v[r][j].z + v[r][j].w * v[r][j].w);
                s = wave_sum(s);
                if (m < MTOK) {
                    u32x2* o = (u32x2*)(XB + (size_t)m * DM) + lane;
#pragma unroll
                    for (int j = 0; j < 4; ++j) { u32x2 w; w.x = cvtpk(v[r][j].x, v[r][j].y); w.y = cvtpk(v[r][j].z, v[r][j].w); o[64 * j] = w; }
                    if (lane == 0) R0[m] = 1.f / sqrtf(s * (1.f / DM) + EPS);
                } }
        }
    }
    {
        unsigned* T = (unsigned*)(ws + WS_ROPE);
        for (int e = blockIdx.x * 512 + tid; e < SEQ * 8; e += G * 512) {
            const int pos = e >> 3, i = e & 7;
            const float inv = (float)exp2(-(double)i * (18.931568569324174 / 8.0));
            const float ang = (float)pos * inv;
            const double rev = (double)ang * 0.15915494309189535; const double fr = rev - rint(rev);
            const float rf = (float)fr;
            T[e] = (unsigned)__builtin_bit_cast(unsigned short, (_Float16)__builtin_amdgcn_cosf(rf)) | ((unsigned)__builtin_bit_cast(unsigned short, (_Float16)__builtin_amdgcn_sinf(rf)) << 16);
        }
    }
}

#define EPI_ARGS const f32x4 (&acc)[2][2][4][2], const pg8::Unit& u, int wr, int wc, int fr, int fq


struct EpiIn0 {
    static constexpr bool PERM = true, AFTER_DRAIN = false;
    const float* r0; bf16 *UG, *GV, *BX, *BG; float* vss;
    __device__ __forceinline__ void operator()(EPI_ARGS) const {
        const int row0 = u.pm * 256 + wr * 64 + fr, pn = u.pn;
        float rs8[2][4];
#pragma unroll
        for (int ai = 0; ai < 2; ++ai)
#pragma unroll
            for (int m = 0; m < 4; ++m) rs8[ai][m] = r0[row0 + ai * 128 + m * 16];
        if (pn < 8) {
            const int col = 128 * pn + 32 * wc + 8 * fq;
#pragma unroll
            for (int ai = 0; ai < 2; ++ai)
#pragma unroll
                for (int m = 0; m < 4; ++m) { const int row = row0 + ai * 128 + m * 16; const float rs = rs8[ai][m];
                    u32x4 w;
#pragma unroll
                    for (int n = 0; n < 2; ++n) { const f32x4 au = acc[ai][0][m][n] * rs, ag = acc[ai][1][m][n] * rs;
                        const f32x2 o0 = gelu_silu_2((f32x2){au.x, au.y}, (f32x2){ag.x, ag.y}), o1 = gelu_silu_2((f32x2){au.z, au.w}, (f32x2){ag.z, ag.w});
                        w[2 * n] = cvtpk(o0.x, o0.y); w[2 * n + 1] = cvtpk(o1.x, o1.y); }
                    *(u32x4*)(UG + (size_t)row * 1024 + col) = w; }
        } else if (pn < 12) {
            const int col = 256 * (pn - 8) + 32 * wc + 8 * fq;
#pragma unroll
            for (int ai = 0; ai < 2; ++ai)
#pragma unroll
                for (int m = 0; m < 4; ++m) { const int row = row0 + ai * 128 + m * 16; const float rs = rs8[ai][m]; float ss = 0.f;
#pragma unroll
                    for (int bj = 0; bj < 2; ++bj) { u32x4 w;
#pragma unroll
                        for (int n = 0; n < 2; ++n) { const f32x4 av = acc[ai][bj][m][n] * rs;
                            const f32x2 o0 = gelu_2((f32x2){av.x, av.y}), o1 = gelu_2((f32x2){av.z, av.w});
                            const f32x2 q = o0 * o0 + o1 * o1; ss += q.x + q.y;
                            w[2 * n] = cvtpk(o0.x, o0.y); w[2 * n + 1] = cvtpk(o1.x, o1.y); }
                        *(u32x4*)(GV + (size_t)row * 1024 + col + bj * 128) = w; }
                    ss = fq_sum(ss);
                    if (fq == 0) vss[(size_t)row * 16 + (pn - 8) * 4 + wc] = ss; }
        } else {
            const bool isg = pn >= 16; bf16* O = isg ? BG : BX;
            const int col = 256 * (pn - (isg ? 16 : 12)) + 32 * wc + 8 * fq;
#pragma unroll
            for (int ai = 0; ai < 2; ++ai)
#pragma unroll
                for (int m = 0; m < 4; ++m) { const int row = row0 + ai * 128 + m * 16; const float rs = rs8[ai][m];
#pragma unroll
                    for (int bj = 0; bj < 2; ++bj) { u32x4 w;
#pragma unroll
                        for (int n = 0; n < 2; ++n) { const f32x4 av = acc[ai][bj][m][n] * rs;
                            f32x2 o0 = (f32x2){av.x, av.y}, o1 = (f32x2){av.z, av.w};
                            if (isg) { o0 = silu_2(o0); o1 = silu_2(o1); }
                            w[2 * n] = cvtpk(o0.x, o0.y); w[2 * n + 1] = cvtpk(o1.x, o1.y); }
                        *(u32x4*)(O + (size_t)row * 1024 + col + bj * 128) = w; } }
        }
    }
};

template <bool XIN_BF16, bool OUT_F32, bool OUT_BF16>
struct EpiRes {
    static constexpr bool PERM = true, AFTER_DRAIN = false;
    const void* xin; float* xo; bf16* xb; float* ss;
    __device__ __forceinline__ void load_batch(f32x4 (&x)[2][2][2], int row0, int col0, int b) const {
#pragma unroll
        for (int mm = 0; mm < 2; ++mm)
#pragma unroll
            for (int bj = 0; bj < 2; ++bj) { const size_t off = (size_t)(row0 + (b >> 1) * 128 + (2 * (b & 1) + mm) * 16) * 1024 + col0 + bj * 128;
                if (XIN_BF16) { const u32x4 r = *(const u32x4*)((const bf16*)xin + off); x[mm][bj][0] = (f32x4){bflo(r.x), bfhi(r.x), bflo(r.y), bfhi(r.y)}; x[mm][bj][1] = (f32x4){bflo(r.z), bfhi(r.z), bflo(r.w), bfhi(r.w)}; }
                else { x[mm][bj][0] = *(const f32x4*)((const float*)xin + off); x[mm][bj][1] = *(const f32x4*)((const float*)xin + off + 4); } }
    }
    __device__ __forceinline__ void operator()(EPI_ARGS) const {
        const int row0 = u.pm * 256 + wr * 64 + fr, col0 = u.pn * 256 + 32 * wc + 8 * fq;
        f32x4 xa[2][2][2], xb2[2][2][2];
        load_batch(xa, row0, col0, 0);
#pragma unroll
        for (int b = 0; b < 4; ++b) {
            if (b + 1 < 4) { if (b & 1) load_batch(xa, row0, col0, b + 1); else load_batch(xb2, row0, col0, b + 1); }
            const int ai = b >> 1;
#pragma unroll
            for (int mm = 0; mm < 2; ++mm) { const int m = 2 * (b & 1) + mm, row = row0 + ai * 128 + m * 16; float s = 0.f;
#pragma unroll
                for (int bj = 0; bj < 2; ++bj) { const size_t off = (size_t)row * 1024 + col0 + bj * 128;
                    const f32x4 v0 = ((b & 1) ? xb2[mm][bj][0] : xa[mm][bj][0]) + acc[ai][bj][m][0], v1 = ((b & 1) ? xb2[mm][bj][1] : xa[mm][bj][1]) + acc[ai][bj][m][1];
                    if (OUT_F32) { *(f32x4*)(xo + off) = v0; *(f32x4*)(xo + off + 4) = v1; }
                    s += (v0.x * v0.x + v0.y * v0.y) + (v0.z * v0.z + v0.w * v0.w) + (v1.x * v1.x + v1.y * v1.y) + (v1.z * v1.z + v1.w * v1.w);
                    if (OUT_BF16) { u32x4 w; w.x = cvtpk(v0.x, v0.y); w.y = cvtpk(v0.z, v0.w); w.z = cvtpk(v1.x, v1.y); w.w = cvtpk(v1.z, v1.w); *(u32x4*)(xb + off) = w; } }
                s = fq_sum(s);
                if (fq == 0) ss[(size_t)row * 16 + u.pn * 4 + wc] = s; }
        }
    }
};

struct EpiIn1 {
    static constexpr bool PERM = true, AFTER_DRAIN = false;
    const float* ss1; const unsigned* rope; bf16 *Q, *K, *VT, *G;
    __device__ __forceinline__ void operator()(EPI_ARGS) const {
        const int row0 = u.pm * 256 + wr * 64 + fr, pn = u.pn;
        const bool dorope = (pn < 5) && ((wc & 1) == 0) && (fq < 2);
        float rs8[2][4];
        {
            f32x4 part[2][4];
#pragma unroll
            for (int ai = 0; ai < 2; ++ai)
#pragma unroll
                for (int m = 0; m < 4; ++m) part[ai][m] = *(const f32x4*)(ss1 + (size_t)(row0 + ai * 128 + m * 16) * 16 + 4 * fq);
#pragma unroll
            for (int ai = 0; ai < 2; ++ai)
#pragma unroll
                for (int m = 0; m < 4; ++m) { const f32x4 pq = part[ai][m]; rs8[ai][m] = 1.f / sqrtf(fq_sum((pq.x + pq.y) + (pq.z + pq.w)) * (1.f / DM) + EPS); }
        }
        u32x4 cst[2][4];
#pragma unroll
        for (int ai = 0; ai < 2; ++ai)
#pragma unroll
            for (int m = 0; m < 4; ++m) { cst[ai][m] = (u32x4){0x3c00u, 0x3c00u, 0x3c00u, 0x3c00u};
                if (dorope) cst[ai][m] = *(const u32x4*)(rope + (size_t)((row0 + ai * 128 + m * 16) & (SEQ - 1)) * 8 + 4 * fq); }
#pragma unroll
        for (int ai = 0; ai < 2; ++ai)
#pragma unroll
            for (int m = 0; m < 4; ++m) { const int row = row0 + ai * 128 + m * 16;
                const float rs = rs8[ai][m];
                const u32x4 ct = cst[ai][m];
#pragma unroll
                for (int bj = 0; bj < 2; ++bj) {
                    f32x4 z0 = acc[ai][bj][m][0] * rs, z1 = acc[ai][bj][m][1] * rs;
                    const int colt = 128 * bj + 32 * wc + 8 * fq;
                    if (pn < 5) {
                        if (dorope) {
                            float c[4], s[4];
#pragma unroll
                            for (int j = 0; j < 4; ++j) { c[j] = (float)__builtin_bit_cast(_Float16, (unsigned short)(ct[j] & 0xffffu)); s[j] = (float)__builtin_bit_cast(_Float16, (unsigned short)(ct[j] >> 16)); }
#pragma unroll
                            for (int j = 0; j < 4; ++j) { const float a1 = z0[j], a2 = z1[j]; z0[j] = a1 * c[j] - a2 * s[j]; z1[j] = a2 * c[j] + a1 * s[j]; }
                        }
                        if (pn < 4) { z0 = z0 * QSCALE; z1 = z1 * QSCALE; }
                        u32x4 w; w.x = cvtpk(z0.x, z0.y); w.y = cvtpk(z0.z, z0.w); w.z = cvtpk(z1.x, z1.y); w.w = cvtpk(z1.z, z1.w);
                        if (pn < 4) *(u32x4*)(Q + (size_t)row * 1024 + 256 * pn + colt) = w;
                        else        *(u32x4*)(K + (size_t)row * 256 + colt) = w;
                    } else if (pn == 5) {
                        u32x4 w; w.x = cvtpk(z0.x, z0.y); w.y = cvtpk(z0.z, z0.w); w.z = cvtpk(z1.x, z1.y); w.w = cvtpk(z1.z, z1.w);
                        *(u32x4*)(VT + (size_t)row * 256 + colt) = w;
                    } else {
                        const f32x2 s0 = silu_2((f32x2){z0.x, z0.y}), s1 = silu_2((f32x2){z0.z, z0.w}), s2 = silu_2((f32x2){z1.x, z1.y}), s3 = silu_2((f32x2){z1.z, z1.w});
                        u32x4 w; w.x = cvtpk(s0.x, s0.y); w.y = cvtpk(s1.x, s1.y); w.z = cvtpk(s2.x, s2.y); w.w = cvtpk(s3.x, s3.y);
                        *(u32x4*)(G + (size_t)row * 1024 + 256 * (pn - 6) + colt) = w;
                    }
                } }
    }
};

#define MFMA16(a, b, c) __builtin_amdgcn_mfma_f32_16x16x32_bf16((a), (b), (c), 0, 0, 0)

typedef short v4i16_t __attribute__((ext_vector_type(4)));
__device__ __forceinline__ float max3f(float a, float b, float c) { float r; asm("v_max3_f32 %0, %1, %2, %3" : "=v"(r) : "v"(a), "v"(b), "v"(c)); return r; }
__device__ __forceinline__ s16x4 trread(const LAS bf16* p) { return __builtin_bit_cast(s16x4, __builtin_amdgcn_ds_read_tr16_b64_v4i16((LAS v4i16_t*)p)); }
__device__ __forceinline__ bf16x8 cat8(s16x4 a, s16x4 b) { return __builtin_shufflevector(a, b, 0, 1, 2, 3, 4, 5, 6, 7); }

__device__ __forceinline__ int unit_tile(int u) { return 16 * (u & 7) + (u >> 5); }
__device__ __forceinline__ int unit_grp(int u) { return (u >> 3) & 3; }

__device__ __forceinline__ void issue_a(const Args& a, int c, int h, int tid, u32x4 (&pf)[9]) {
    const bf16* GV = (const bf16*)(a.ws + WS_GV);
#pragma unroll
    for (int it = 0; it < 8; ++it) { const int item = it * 512 + tid, cl = item & 31, j = item >> 5; pf[it] = *(const u32x4*)(GV + (size_t)(128 * c + j) * 1024 + 256 * h + 8 * cl); }
}
__device__ __forceinline__ void issue_b(const Args& a, int tt, int g, int tid, u32x4 (&pf)[9]) {
    const int b = tt >> 6, t0 = (tt & 63) * 128;
    const bf16* base = (const bf16*)(a.ws + WS_BX) + (size_t)b * SEQ * 1024 + 256 * g;
#pragma unroll
    for (int it = 0; it < 9; ++it) { const int item = it * 512 + tid, cl = item & 31, rr = item >> 5, pos = t0 - 8 + rr;
        pf[it] = (u32x4){0u, 0u, 0u, 0u};
        if (pos >= 0 && pos < SEQ) pf[it] = *(const u32x4*)(base + (size_t)pos * 1024 + 8 * cl); }
}
__device__ __forceinline__ void issue_next(const Args& a, int nkind, int nidx, int tid, u32x4 (&pf)[9]) {
    if (nkind == 0) issue_a(a, unit_tile(nidx), unit_grp(nidx), tid, pf); else if (nkind == 1) issue_b(a, unit_tile(nidx), unit_grp(nidx), tid, pf);
}

__device__ __forceinline__ void mixer_a_unit(const Args& a, LAS unsigned char* lds, int c, int h, u32x4 (&pf)[9], int nkind, int nidx) {
    int tid_ = threadIdx.x; asm volatile("" : "+v"(tid_));
    const int tid = tid_, lane = tid & 63, w = __builtin_amdgcn_readfirstlane(tid >> 6), fr = lane & 15, fq = lane >> 4;
    constexpr int VS2 = 264, WS_ = 136;
    LAS bf16* V = (LAS bf16*)lds;
    LAS bf16* Ws = (LAS bf16*)(lds + 67584);
    LAS float* rvs = (LAS float*)(lds + 67584 + 34816);
    const unsigned char* ws = a.ws;
    const bf16* UG = (const bf16*)(ws + WS_UG); const float* vss = (const float*)(ws + WS_VSS);
    bf16* Y0 = (bf16*)a.out;
    const float* wsp = a.in[4] + (size_t)h * 16384; const float* bsp = a.in[5] + h * 128; const float* gv = a.in[3];
    f32x4 wsr[8];
#pragma unroll
    for (int it = 0; it < 8; ++it) { const int item = it * 512 + tid, j4 = item & 31, i = item >> 5; wsr[it] = *(const f32x4*)(wsp + i * 128 + 4 * j4); }
    if (tid < 128) rvs[tid] = 1.f / sqrtf(sum16(vss + (size_t)(128 * c + tid) * 16) * (1.f / 1024.f) + EPS);
#pragma unroll
    for (int it = 0; it < 8; ++it) { const int item = it * 512 + tid, cl = item & 31, j = item >> 5; *(LAS u32x4*)(V + j * VS2 + 8 * cl) = pf[it]; }
    issue_next(a, nkind, nidx, tid, pf);
    __syncthreads();
#pragma unroll
    for (int it = 0; it < 8; ++it) { const int item = it * 512 + tid, j4 = item & 31, i = item >> 5;
        const f32x4 r = *(const LAS f32x4*)(rvs + 4 * j4); const f32x4 v = wsr[it];
        u32x2 o; o.x = cvtpk(v.x * r.x, v.y * r.y); o.y = cvtpk(v.z * r.z, v.w * r.w);
        *(LAS u32x2*)(Ws + i * WS_ + 4 * j4) = o; }
    u32x4 ugr[8];
#pragma unroll
    for (int it = 0; it < 8; ++it) ugr[it] = *(const u32x4*)(UG + (size_t)(128 * c + 16 * it + fr) * 1024 + 256 * h + 32 * w + 8 * fq);
    __syncthreads();
    f32x4 acc[2][8];
#pragma unroll
    for (int dt = 0; dt < 2; ++dt)
#pragma unroll
        for (int it = 0; it < 8; ++it) acc[dt][it] = (f32x4){0.f, 0.f, 0.f, 0.f};
    const LAS bf16* vb = V + (8 * fq + ((lane >> 2) & 3)) * VS2 + 32 * w + 8 * (lane & 3);
#pragma unroll
    for (int ks = 0; ks < 4; ++ks) {
        bf16x8 af[2], bfr[8];
#pragma unroll
        for (int dt = 0; dt < 2; ++dt) { const LAS bf16* p = vb + (32 * ks) * VS2 + 4 * dt; af[dt] = cat8(trread(p), trread(p + 4 * VS2)); }
#pragma unroll
        for (int it = 0; it < 8; ++it) bfr[it] = *(const LAS bf16x8*)(Ws + (16 * it + fr) * WS_ + 32 * ks + 8 * fq);
#pragma unroll
        for (int dt = 0; dt < 2; ++dt)
#pragma unroll
            for (int it = 0; it < 8; ++it) acc[dt][it] = MFMA16(af[dt], bfr[it], acc[dt][it]);
    }
    {   const int col = 256 * h + 32 * w + 8 * fq; const f32x4 g0 = *(const f32x4*)(gv + col), g1 = *(const f32x4*)(gv + col + 4);
#pragma unroll
        for (int it = 0; it < 8; ++it) { const int i = 16 * it + fr, row = 128 * c + i; const float bs = bsp[i];
            const u32x4 ug = ugr[it];
            const f32x4 m0 = acc[0][it] * g0 + bs, m1 = acc[1][it] * g1 + bs;
            u32x4 o; o.x = cvtpk(bflo(ug.x) * m0.x, bfhi(ug.x) * m0.y); o.y = cvtpk(bflo(ug.y) * m0.z, bfhi(ug.y) * m0.w); o.z = cvtpk(bflo(ug.z) * m1.x, bfhi(ug.z) * m1.y); o.w = cvtpk(bflo(ug.w) * m1.z, bfhi(ug.w) * m1.w);
            *(u32x4*)(Y0 + (size_t)row * 2048 + col) = o; } }
    __syncthreads();
}

__device__ __forceinline__ void mixer_b_unit(const Args& a, LAS unsigned char* lds, int tt, int g, u32x4 (&pf)[9], int nkind, int nidx) {
    int tid_ = threadIdx.x; asm volatile("" : "+v"(tid_));
    const int tid = tid_, lane = tid & 63, w = __builtin_amdgcn_readfirstlane(tid >> 6), fr = lane & 15, fq = lane >> 4;
    constexpr int PS = 264;
    LAS bf16* Bs = (LAS bf16*)lds;
    LAS bf16* P = (LAS bf16*)(lds + 76032);
    const unsigned char* ws = a.ws;
    const bf16* BG = (const bf16*)(ws + WS_BG); const bf16* WGT = (const bf16*)(ws + WS_WGT) + (size_t)g * 65536;
    bf16* Y0 = (bf16*)a.out; const float* bscale = a.in[7];
    const int b = tt >> 6, t0 = (tt & 63) * 128;
#pragma unroll
    for (int it = 0; it < 9; ++it) { const int item = it * 512 + tid, cl = item & 31, rr = item >> 5; *(LAS u32x4*)(Bs + rr * PS + 8 * cl) = pf[it]; }
    bf16x8 wf[8][2];
#pragma unroll
    for (int ks = 0; ks < 8; ++ks)
#pragma unroll
        for (int et = 0; et < 2; ++et) wf[ks][et] = *(const bf16x8*)(WGT + (size_t)(32 * w + 8 * (fr >> 2) + 4 * et + (fr & 3)) * 256 + 32 * ks + 8 * fq);
    u32x4 bgr[8];
#pragma unroll
    for (int it = 0; it < 8; ++it) bgr[it] = *(const u32x4*)(BG + (size_t)(128 * tt + 16 * it + fr) * 1024 + 256 * g + 32 * w + 8 * fq);
    __syncthreads();
    {
        const int cl = tid & 31, tr = tid >> 5, half = 1 << g;
        const LAS bf16* col = Bs + 8 * cl;
        float s[8];
#pragma unroll
        for (int e = 0; e < 8; ++e) s[e] = 0.f;
        for (int rr = 8 * tr + 8 - half; rr < 8 * tr + 8 + half; ++rr) { const u32x4 r = *(const LAS u32x4*)(col + rr * PS);
#pragma unroll
            for (int e = 0; e < 4; ++e) { s[2 * e] += bflo(r[e]); s[2 * e + 1] += bfhi(r[e]); } }
        for (int k = 0; k < 8; ++k) { const int tl = 8 * tr + k, t = t0 + tl; const int lo = max(t - half, 0), hi = min(t + half, SEQ); const float inv = 1.f / (float)(hi - lo);
            const u32x4 r = *(const LAS u32x4*)(col + (tl + 8) * PS);
            u32x4 o;
#pragma unroll
            for (int e = 0; e < 4; ++e) o[e] = cvtpk(s[2 * e] * inv - bflo(r[e]), s[2 * e + 1] * inv - bfhi(r[e]));
            *(LAS u32x4*)(P + tl * PS + 8 * cl) = o;
            const u32x4 qa = *(const LAS u32x4*)(col + (tl + 8 + half) * PS), qs = *(const LAS u32x4*)(col + (tl + 8 - half) * PS);
#pragma unroll
            for (int e = 0; e < 4; ++e) { s[2 * e] += bflo(qa[e]) - bflo(qs[e]); s[2 * e + 1] += bfhi(qa[e]) - bfhi(qs[e]); } }
    }
    __syncthreads();
    f32x4 acc[2][8];
#pragma unroll
    for (int et = 0; et < 2; ++et)
#pragma unroll
        for (int it = 0; it < 8; ++it) acc[et][it] = (f32x4){0.f, 0.f, 0.f, 0.f};
#pragma unroll
    for (int ks = 0; ks < 8; ++ks) {
        bf16x8 bfr[8];
#pragma unroll
        for (int it = 0; it < 8; ++it) bfr[it] = *(const LAS bf16x8*)(P + (16 * it + fr) * PS + 32 * ks + 8 * fq);
#pragma unroll
        for (int et = 0; et < 2; ++et)
#pragma unroll
            for (int it = 0; it < 8; ++it) acc[et][it] = MFMA16(wf[ks][et], bfr[it], acc[et][it]);
    }
    issue_next(a, nkind, nidx, tid, pf);
    {   const int col = 256 * g + 32 * w + 8 * fq; const f32x4 s0 = *(const f32x4*)(bscale + col), s1 = *(const f32x4*)(bscale + col + 4);
#pragma unroll
        for (int it = 0; it < 8; ++it) { const int row = 128 * tt + 16 * it + fr;
            const u32x4 bg = bgr[it];
            const f32x4 y0 = acc[0][it] * s0, y1 = acc[1][it] * s1;
            u32x4 o; o.x = cvtpk(bflo(bg.x) * y0.x, bfhi(bg.x) * y0.y); o.y = cvtpk(bflo(bg.y) * y0.z, bfhi(bg.y) * y0.w); o.z = cvtpk(bflo(bg.z) * y1.x, bfhi(bg.z) * y1.y); o.w = cvtpk(bflo(bg.w) * y1.z, bfhi(bg.w) * y1.w);
            *(u32x4*)(Y0 + (size_t)row * 2048 + 1024 + col) = o; } }
    __syncthreads();
}

__device__ __forceinline__ void attn_issue(const Args& a, int u, int tid, u32x4 (&kr)[6], u32x4 (&vr)[6]) {
    if (u >= 512) return;
    const int gq = unit_tile(u), b = gq >> 6, qb = gq & 63, kvh = unit_grp(u), kb0 = (qb - 1) * 128;
    const bf16* Kg = (const bf16*)(a.ws + WS_K); const bf16* Vg = (const bf16*)(a.ws + WS_VT);
#pragma unroll
    for (int it = 0; it < 6; ++it) { const int item = it * 512 + tid, ch = item & 7, key = item >> 3; const int pos = kb0 + key;
        kr[it] = (u32x4){0u, 0u, 0u, 0u}; vr[it] = (u32x4){0u, 0u, 0u, 0u};
        if (pos >= 0 && pos < SEQ) { const size_t off = (size_t)(b * SEQ + pos) * 256 + kvh * 64 + 8 * ch; kr[it] = *(const u32x4*)(Kg + off); vr[it] = *(const u32x4*)(Vg + off); } }
}
__device__ __forceinline__ void attn_unit(const Args& a, LAS unsigned char* lds, int b, int qb, int kvh, u32x4 (&kr)[6], u32x4 (&vr)[6], int unext) {
    int tid_ = threadIdx.x; asm volatile("" : "+v"(tid_));
    const int tid = tid_, lane = tid & 63, w = __builtin_amdgcn_readfirstlane(tid >> 6), fr = lane & 15, fq = lane >> 4;
    constexpr int KS = 72, VS = 80;
    LAS bf16* Ks = (LAS bf16*)lds;
    LAS bf16* Vs = (LAS bf16*)(lds + 55296);
    const unsigned char* ws = a.ws;
    const bf16* Qg = (const bf16*)(ws + WS_Q); const bf16* Gg = (const bf16*)(ws + WS_G);
    bf16* Y1 = (bf16*)(a.ws + WS_Y1);
    const int kb0 = (qb - 1) * 128;
    const int head = kvh * 4 + (w >> 1);
    const size_t qbase = (size_t)(b * SEQ + qb * 128 + (w & 1) * 64 + fr) * 1024 + head * 64;
#pragma unroll
    for (int it = 0; it < 6; ++it) { const int item = it * 512 + tid, ch = item & 7, key = item >> 3; *(LAS u32x4*)(Ks + key * KS + 8 * ch) = kr[it];
        const u32x4 v = vr[it]; *(LAS u32x4*)(Vs + key * VS + 8 * ch) = (key & 1) ? (u32x4){v.z, v.w, v.x, v.y} : v; }
    attn_issue(a, unext, tid, kr, vr);
    bf16x8 q0 = *(const bf16x8*)(Qg + qbase + 8 * fq), q1 = *(const bf16x8*)(Qg + qbase + 32 + 8 * fq);
    __syncthreads();
    const float sink2 = a.in[11][head] * LOG2E;
    const bool edge = (qb == 0) || (qb == SEQ / 128 - 1);
    const LAS bf16* vtb = Vs + (4 * fq + ((lane >> 2) & 3)) * VS + 8 * (lane & 3);
    const int vsw = 4 * ((lane >> 2) & 1);
    for (int it = 0; it < 4; ++it) {
        const int rowoff = (w & 1) * 64 + 16 * it;
        const size_t qoff = qbase + (size_t)(16 * it) * 1024;
        const u32x4 g0 = *(const u32x4*)(Gg + qoff + 8 * fq), g1 = *(const u32x4*)(Gg + qoff + 32 + 8 * fq);
        const bf16x8 qa = q0, qb2 = q1;
        if (it < 3) { q0 = *(const bf16x8*)(Qg + qoff + 16 * 1024 + 8 * fq); q1 = *(const bf16x8*)(Qg + qoff + 16 * 1024 + 32 + 8 * fq); }
        const int kt0 = (rowoff >> 4) & ~1;
        f32x4 S[18];
        const LAS bf16* kpb = Ks + (16 * kt0 + fr) * KS + 8 * fq;
#pragma unroll
        for (int j = 0; j < 18; ++j) { const LAS bf16* kp = kpb + j * (16 * KS);
            f32x4 s = {0.f, 0.f, 0.f, 0.f};
            s = MFMA16(*(const LAS bf16x8*)kp, qa, s); s = MFMA16(*(const LAS bf16x8*)(kp + 32), qb2, s); S[j] = s;
            }
        const int qpos = qb * 128 + rowoff + fr, kbase = kb0 + 16 * kt0 + 4 * fq;
        const int klo = max(qpos - 128, 0), khi = min(qpos + 128, SEQ - 1);
        int mbase = kbase - klo; const unsigned mspan = (unsigned)(khi - klo);
        asm volatile("" : "+v"(mbase));
#define ATT_MASK_TILE(j) do { _Pragma("unroll") for (int r = 0; r < 4; ++r) { const bool ok = (unsigned)(mbase + (16 * (j) + r)) <= mspan; S[j][r] = ok ? S[j][r] : -1e30f; } } while (0)
        if (edge) {
#pragma unroll
            for (int j = 0; j < 18; ++j) ATT_MASK_TILE(j);
        } else {
            ATT_MASK_TILE(0); ATT_MASK_TILE(1); ATT_MASK_TILE(16); ATT_MASK_TILE(17);
        }
#undef ATT_MASK_TILE
        float mx = sink2;
#pragma unroll
        for (int j = 0; j < 18; ++j) { mx = max3f(mx, S[j][0], S[j][1]); mx = max3f(mx, S[j][2], S[j][3]); }
        mx = fq_max(mx);
        f32x2 l2 = {0.f, 0.f};
#pragma unroll
        for (int j = 0; j < 18; ++j) { const f32x2 p0 = exp2_2((f32x2){S[j][0], S[j][1]} - mx), p1 = exp2_2((f32x2){S[j][2], S[j][3]} - mx);
            S[j] = (f32x4){p0.x, p0.y, p1.x, p1.y}; l2 += p0 + p1; }
        float l = l2.x + l2.y;
        l = fq_sum(l);
        l += fast_exp2(sink2 - mx);
        const float rl = 1.f / l;
        const LAS bf16* vpb = vtb + (16 * kt0) * VS;
        f32x4 O[4];
#pragma unroll
        for (int dt = 0; dt < 4; ++dt) O[dt] = (f32x4){0.f, 0.f, 0.f, 0.f};
#pragma unroll
        for (int jp = 0; jp < 9; ++jp) {
            u32x4 pw; pw.x = cvtpk(S[2 * jp][0], S[2 * jp][1]); pw.y = cvtpk(S[2 * jp][2], S[2 * jp][3]); pw.z = cvtpk(S[2 * jp + 1][0], S[2 * jp + 1][1]); pw.w = cvtpk(S[2 * jp + 1][2], S[2 * jp + 1][3]);
            const bf16x8 pf = __builtin_bit_cast(bf16x8, pw);
            const LAS bf16* vp = vpb + jp * (32 * VS);
#pragma unroll
            for (int dt = 0; dt < 4; ++dt) { const LAS bf16* p = vp + 32 * (dt >> 1) + ((dt & 1) ? 4 - vsw : vsw);
                O[dt] = MFMA16(cat8(trread(p), trread(p + 16 * VS)), pf, O[dt]); }
        }
        {
            const f32x4 a0 = O[0] * rl, a1 = O[1] * rl, a2 = O[2] * rl, a3 = O[3] * rl;
            u32x4 o0, o1;
            o0.x = cvtpk(a0.x * bflo(g0.x), a0.y * bfhi(g0.x)); o0.y = cvtpk(a0.z * bflo(g0.y), a0.w * bfhi(g0.y)); o0.z = cvtpk(a1.x * bflo(g0.z), a1.y * bfhi(g0.z)); o0.w = cvtpk(a1.z * bflo(g0.w), a1.w * bfhi(g0.w));
            o1.x = cvtpk(a2.x * bflo(g1.x), a2.y * bfhi(g1.x)); o1.y = cvtpk(a2.z * bflo(g1.y), a2.w * bfhi(g1.y)); o1.z = cvtpk(a3.x * bflo(g1.z), a3.y * bfhi(g1.z)); o1.w = cvtpk(a3.z * bflo(g1.w), a3.w * bfhi(g1.w));
            *(u32x4*)(Y1 + qoff + 8 * fq) = o0; *(u32x4*)(Y1 + qoff + 32 + 8 * fq) = o1;
        }
    }
    __syncthreads();
}

#define RLX_AGENT __ATOMIC_RELAXED, __HIP_MEMORY_SCOPE_AGENT
#define XB_TMO      128
#define XB_XCNT(j)  (256  + 64 * (j))
#define XB_XSUB(j)  (1280 + 64 * (j))
#define XB_XGEN(j)  (2304 + 64 * (j))
#define XB_TOP      3328
#define XB_TOPGEN   3392
#define XCD_BAR_WORDS 3456
#define XB_SPIN_CAP (1u << 18)

__device__ __forceinline__ unsigned xb_ld(unsigned* p)              { return __hip_atomic_load(p, __ATOMIC_RELAXED, __HIP_MEMORY_SCOPE_AGENT); }
__device__ __forceinline__ unsigned xb_add(unsigned* p, unsigned v) { return __hip_atomic_fetch_add(p, v, __ATOMIC_RELAXED, __HIP_MEMORY_SCOPE_AGENT); }
__device__ __forceinline__ unsigned xb_xcc_id() { return (unsigned)__builtin_amdgcn_s_getreg((3 << 11) | 20) & 0xFu; }
#define XB_SPIN(cond, bar) do { unsigned _sp = 0; while (cond) { __builtin_amdgcn_s_sleep(1); \
    if ((++_sp & 255u) == 0u) { if (xb_ld(&(bar)[XB_TMO])) break; if (_sp > XB_SPIN_CAP) { atomicAdd(&(bar)[XB_TMO], 1u); break; } } } } while (0)

struct XcdBarrier {
    unsigned* bar; unsigned x;
    volatile LAS unsigned* st;
};

__device__ __forceinline__ XcdBarrier xcd_barrier_post(unsigned* bar, volatile LAS unsigned* st) {
    XcdBarrier b; b.bar = bar; b.x = xb_xcc_id(); b.st = st;
    if (threadIdx.x == 0) (void)xb_add(&bar[XB_XCNT(b.x)], 1u);
    return b;
}
__device__ __forceinline__ void xcd_barrier_complete(unsigned* bar, unsigned x, unsigned& nloc, unsigned& nx) {
    const unsigned G = gridDim.x * gridDim.y * gridDim.z;
    unsigned sum, cnt, mine, sp = 0u;
    for (;;) {
        sum = 0u; cnt = 0u; mine = 0u;
#pragma unroll
        for (unsigned j = 0; j < 16; ++j) { const unsigned c = xb_ld(&bar[XB_XCNT(j)]); sum += c; cnt += (c > 0u) ? 1u : 0u; mine = (j == x) ? c : mine; }
        if (sum == G) break;
        __builtin_amdgcn_s_sleep(1);
        if ((++sp & 255u) == 0u) { if (xb_ld(&bar[XB_TMO])) break; if (sp > XB_SPIN_CAP) { atomicAdd(&bar[XB_TMO], 1u); break; } }
    }
    nloc = mine > 0u ? mine : 1u; nx = cnt > 0u ? cnt : 1u;
}

__device__ __forceinline__ void xcd_barrier(const XcdBarrier& b) {
    asm volatile("s_waitcnt vmcnt(0)" ::: "memory");
    __syncthreads();
    if (threadIdx.x == 0) {
        unsigned* bar = b.bar;
        __builtin_amdgcn_s_waitcnt(0);
        unsigned nloc = b.st[0], nx = b.st[1];
        if (nloc == 0u) { xcd_barrier_complete(bar, b.x, nloc, nx); b.st[0] = nloc; b.st[1] = nx; }
        const unsigned old = xb_add(&bar[XB_XSUB(b.x)], 1u);
        const unsigned gen = old / nloc;
        if (old + 1u == (gen + 1u) * nloc) {
            __builtin_amdgcn_fence(__ATOMIC_RELEASE, "agent");
            asm volatile("s_waitcnt vmcnt(0)" ::: "memory");
            const unsigned og = xb_add(&bar[XB_TOP], 1u);
            const unsigned tg = og / nx;
            if (og + 1u == (tg + 1u) * nx) xb_add(&bar[XB_TOPGEN], 1u);
            else XB_SPIN(xb_ld(&bar[XB_TOPGEN]) == tg, bar);
            __builtin_amdgcn_fence(__ATOMIC_ACQUIRE, "agent");
            xb_add(&bar[XB_XGEN(b.x)], 1u);
            asm volatile("s_waitcnt vmcnt(0)" ::: "memory");
        } else {
            XB_SPIN(xb_ld(&bar[XB_XGEN(b.x)]) == gen, bar);
            __builtin_amdgcn_fence(__ATOMIC_ACQUIRE, "agent");
            asm volatile("s_waitcnt vmcnt(0)" ::: "memory");
        }
    }
    __syncthreads();
}

#define XB_SPIN_TIGHT(cond, bar) do { unsigned _sp = 0; while (cond) { \
    if ((++_sp & 255u) == 0u) { if (xb_ld(&(bar)[XB_TMO])) break; if (_sp > XB_SPIN_CAP) { atomicAdd(&(bar)[XB_TMO], 1u); break; } } } } while (0)
#define XB_MISMATCH 192
__device__ __forceinline__ void xcd_local_barrier(const XcdBarrier& b) {
    asm volatile("s_waitcnt vmcnt(0)" ::: "memory");
    __syncthreads();
    if (threadIdx.x == 0) {
        unsigned* bar = b.bar;
        __builtin_amdgcn_s_waitcnt(0);
        const unsigned nloc = b.st[0];
        const unsigned old = xb_add(&bar[XB_XSUB(b.x)], 1u);
        const unsigned gen = old / nloc;
        if (old + 1u == (gen + 1u) * nloc) xb_add(&bar[XB_XGEN(b.x)], 1u);
        else XB_SPIN_TIGHT(xb_ld(&bar[XB_XGEN(b.x)]) == gen, bar);
        __builtin_amdgcn_fence(__ATOMIC_ACQUIRE, "agent");
        asm volatile("s_waitcnt vmcnt(0)" ::: "memory");
    }
    __syncthreads();
}

__device__ __forceinline__ void xcd_barrier_arrive(const XcdBarrier& b) {
    asm volatile("s_waitcnt vmcnt(0)" ::: "memory");
    __syncthreads();
    if (threadIdx.x == 0) {
        unsigned* bar = b.bar;
        __builtin_amdgcn_s_waitcnt(0);
        const unsigned nloc = b.st[0], nx = b.st[1];
        const unsigned old = xb_add(&bar[XB_XSUB(b.x)], 1u);
        const unsigned gen = old / nloc;
        if (old + 1u == (gen + 1u) * nloc) {
            __builtin_amdgcn_fence(__ATOMIC_RELEASE, "agent");
            asm volatile("s_waitcnt vmcnt(0)" ::: "memory");
            const unsigned og = xb_add(&bar[XB_TOP], 1u);
            const unsigned tg = og / nx;
            if (og + 1u == (tg + 1u) * nx) xb_add(&bar[XB_TOPGEN], 1u);
            xb_add(&bar[XB_XGEN(b.x)], 1u);
        } else {
            XB_SPIN_TIGHT(xb_ld(&bar[XB_XGEN(b.x)]) == gen, bar);
        }
        __builtin_amdgcn_fence(__ATOMIC_ACQUIRE, "agent");
        asm volatile("s_waitcnt vmcnt(0)" ::: "memory");
    }
    __syncthreads();
}
__device__ __forceinline__ void xcd_barrier_wait_top(const XcdBarrier& b, unsigned target) {
    if (threadIdx.x == 0) {
        unsigned* bar = b.bar;
        XB_SPIN_TIGHT(xb_ld(&bar[XB_TOPGEN]) < target, bar);
        __builtin_amdgcn_fence(__ATOMIC_ACQUIRE, "agent");
        asm volatile("s_waitcnt vmcnt(0)" ::: "memory");
    }
    __syncthreads();
}

constexpr size_t WS_BAR = 22 * MiB + 256 * 1024;
constexpr int LDS_ST_OFF = 147392;

__device__ __forceinline__ XcdBarrier mkbar(const Args& a, LAS unsigned char* lds) { XcdBarrier b; b.bar = (unsigned*)(a.ws + WS_BAR); b.x = xb_xcc_id(); b.st = (volatile LAS unsigned*)(lds + LDS_ST_OFF); return b; }

struct EpiFinal {
    static constexpr bool PERM = true, AFTER_DRAIN = true;
    const bf16* x1b; float* out; float* ss; const float* gfin; unsigned char* wsb; int fast;
    __device__ __forceinline__ void fused(const f32x4 (&acc)[2][2][4][2], const pg8::Unit& u, int wr, int wc, int fr, int fq, LAS unsigned char* lds, int wid, int lane) const {
        const int row0 = u.pm * 256 + wr * 64 + fr, col0 = u.pn * 256 + 32 * wc + 8 * fq;
        f32x4 v[2][4][2][2];
#pragma unroll
        for (int ai = 0; ai < 2; ++ai)
#pragma unroll
            for (int m = 0; m < 4; ++m) { const int row = row0 + ai * 128 + m * 16; float s = 0.f;
#pragma unroll
                for (int bj = 0; bj < 2; ++bj) { const size_t off = (size_t)row * 1024 + col0 + bj * 128;
                    const u32x4 r = *(const u32x4*)(x1b + off);
                    const f32x4 v0 = (f32x4){bflo(r.x), bfhi(r.x), bflo(r.y), bfhi(r.y)} + acc[ai][bj][m][0], v1 = (f32x4){bflo(r.z), bfhi(r.z), bflo(r.w), bfhi(r.w)} + acc[ai][bj][m][1];
                    v[ai][m][bj][0] = v0; v[ai][m][bj][1] = v1;
                    s += (v0.x * v0.x + v0.y * v0.y) + (v0.z * v0.z + v0.w * v0.w) + (v1.x * v1.x + v1.y * v1.y) + (v1.z * v1.z + v1.w * v1.w); }
                s = fq_sum(s);
                if (fq == 0) ss[(size_t)row * 16 + u.pn * 4 + wc] = s; }
        { XcdBarrier b; b.bar = (unsigned*)(wsb + WS_BAR); b.x = xb_xcc_id(); b.st = (volatile LAS unsigned*)(lds + LDS_ST_OFF); if (fast) xcd_local_barrier(b); else xcd_barrier(b); }
        f32x4 g[2][2];
#pragma unroll
        for (int bj = 0; bj < 2; ++bj) { g[bj][0] = *(const f32x4*)(gfin + col0 + bj * 128); g[bj][1] = *(const f32x4*)(gfin + col0 + bj * 128 + 4); }
#pragma unroll
        for (int ai = 0; ai < 2; ++ai)
#pragma unroll
            for (int m = 0; m < 4; ++m) { const int row = row0 + ai * 128 + m * 16;
                const float rs = 1.f / sqrtf(sum16(ss + (size_t)row * 16) * (1.f / DM) + EPS);
#pragma unroll
                for (int bj = 0; bj < 2; ++bj) { const size_t off = (size_t)row * 1024 + col0 + bj * 128;
                    *(f32x4*)(out + off) = v[ai][m][bj][0] * rs * g[bj][0]; *(f32x4*)(out + off + 4) = v[ai][m][bj][1] * rs * g[bj][1]; } }
    }
};

#ifndef PH
#define PH 0xFF
#endif
__global__ void __launch_bounds__(512, 2) fwd_megakernel(Args a) {
    extern __shared__ __attribute__((aligned(16))) unsigned char lds_raw[];
    LAS unsigned char* lds = (LAS unsigned char*)lds_raw;
    cg::grid_group grid = cg::this_grid();
    unsigned char* ws = a.ws;
    const int G = gridDim.x, bid = blockIdx.x;

    volatile LAS unsigned* st = (volatile LAS unsigned*)(lds + LDS_ST_OFF);
    unsigned* barw = (unsigned*)(ws + WS_BAR);
    if (threadIdx.x < 4) st[threadIdx.x] = 0u;
    __syncthreads();
    (void)xcd_barrier_post(barw, st);
    if (threadIdx.x == 0) atomicOr(barw + 64 + (bid & 7), 1u << xb_xcc_id());
    if (a.use_cg_sync) grid.sync();
#if (PH >> 0) & 1
    p0_prep(a, lds);
#ifdef DUP_P0
    p0_prep(a, lds);
#endif
#endif
    xcd_barrier(mkbar(a, lds));
    bool fast = (G == 256);
#pragma unroll
    for (int g8 = 0; g8 < 8; ++g8) { const unsigned m = (unsigned)__builtin_amdgcn_readfirstlane((int)xb_ld(barw + 64 + g8)); fast = fast && (m != 0u) && ((m & (m - 1u)) == 0u); }
#ifdef PROBE_FAST
    if (!fast) return;
#endif
#define LOCAL_BAR() do { if (fast) xcd_local_barrier(mkbar(a, lds)); else xcd_barrier(mkbar(a, lds)); } while (0)
#ifdef DUP_BAR
#define GRID_BAR() do { xcd_barrier(mkbar(a, lds)); xcd_barrier(mkbar(a, lds)); } while (0)
#else
#define GRID_BAR() xcd_barrier(mkbar(a, lds))
#endif
#if (PH >> 1) & 1
    {
        pg8::Gemm g{(const bf16*)(ws + WS_XB), (const bf16*)(ws + WS_W0T), MTOK, 5120, 1024}; pg8::StaticOrder S; S.init(MTOK, 5120, G, bid);
        EpiIn0 E{(const float*)(ws + WS_R0), (bf16*)(ws + WS_UG), (bf16*)(ws + WS_GV), (bf16*)(ws + WS_BX), (bf16*)(ws + WS_BG), (float*)(ws + WS_VSS)};
        pg8::gemm_phase<EpiIn0, pg8::StaticOrder, true, true>(lds, g, S, E);
    }
#endif
    if (fast) xcd_barrier_arrive(mkbar(a, lds)); else xcd_barrier(mkbar(a, lds));
#if (PH >> 2) & 1
    {
        u32x4 pf[9];
        int tid_ = threadIdx.x; asm volatile("" : "+v"(tid_));
        int kind = 0, idx = bid;
        if (idx >= 512) kind = 2;
        issue_next(a, kind, idx, tid_, pf);
        while (kind < 2) {
            int nkind = kind, nidx = idx + G;
            if (nidx >= 512) { nkind = kind + 1; nidx = bid; }
            if (fast && kind == 0 && nkind == 1) xcd_barrier_wait_top(mkbar(a, lds), 2u);
            if (kind == 0) mixer_a_unit(a, lds, unit_tile(idx), unit_grp(idx), pf, nkind, nidx);
            else           mixer_b_unit(a, lds, unit_tile(idx), unit_grp(idx), pf, nkind, nidx);
            kind = nkind; idx = nidx;
        }
    }
#endif
    LOCAL_BAR();
#if (PH >> 3) & 1
    {
        pg8::Gemm g{(const bf16*)a.out, (const bf16*)(ws + WS_WO0T), MTOK, 1024, 2048}; pg8::StaticOrder S; S.init(MTOK, 1024, G, bid);
        typedef EpiRes<true, false, true> Epi3;
        Epi3 E{(const void*)(ws + WS_XB), nullptr, (bf16*)(ws + WS_XB), (float*)(ws + WS_SS1)};
        pg8::gemm_phase<Epi3, pg8::StaticOrder, true, true>(lds, g, S, E);
#ifdef DUP_G2
        pg8::gemm_phase<Epi3, pg8::StaticOrder, true, true>(lds, g, S, E);
#endif
    }
#endif
    LOCAL_BAR();
#if (PH >> 4) & 1
    {
        pg8::Gemm g{(const bf16*)(ws + WS_XB), (const bf16*)(ws + WS_W1T), MTOK, 2560, 1024}; pg8::StaticOrder S; S.init(MTOK, 2560, G, bid);
        EpiIn1 E{(const float*)(ws + WS_SS1), (const unsigned*)(ws + WS_ROPE), (bf16*)(ws + WS_Q), (bf16*)(ws + WS_K), (bf16*)(ws + WS_VT), (bf16*)(ws + WS_G)};
        pg8::gemm_phase<EpiIn1, pg8::StaticOrder, true, true>(lds, g, S, E);
#ifdef DUP_G3
        pg8::gemm_phase<EpiIn1, pg8::StaticOrder, true, true>(lds, g, S, E);
#endif
    }
#endif
    GRID_BAR();
#if (PH >> 5) & 1
#ifndef DUP_ATT
#define DUP_ATT 1
#endif
    {
        u32x4 kr[6], vr[6];
        int tid_ = threadIdx.x; asm volatile("" : "+v"(tid_));
        attn_issue(a, bid, tid_, kr, vr);
        for (int u = bid; u < 512; u += G) attn_unit(a, lds, unit_tile(u) >> 6, unit_tile(u) & 63, unit_grp(u), kr, vr, u + G);
    }
#endif
    LOCAL_BAR();
#if (PH >> 6) & 1
    if (G == 256) {
        pg8::Gemm g{(const bf16*)(ws + WS_Y1), (const bf16*)(ws + WS_WO1T), MTOK, 1024, 1024}; pg8::StaticOrder S; S.init(MTOK, 1024, G, bid);
        EpiFinal E{(const bf16*)(ws + WS_XB), a.out, (float*)(ws + WS_SS2), a.in[13], a.ws, fast ? 1 : 0};
        pg8::gemm_phase<EpiFinal, pg8::StaticOrder, false, true>(lds, g, S, E);
#ifdef DUP_G4
        pg8::gemm_phase<EpiFinal, pg8::StaticOrder, false, true>(lds, g, S, E);
#endif
    } else {
        {
            pg8::Gemm g{(const bf16*)(ws + WS_Y1), (const bf16*)(ws + WS_WO1T), MTOK, 1024, 1024}; pg8::StaticOrder S; S.init(MTOK, 1024, G, bid);
            typedef EpiRes<true, true, false> Epi6;
            Epi6 E{(const void*)(ws + WS_XB), a.out, nullptr, (float*)(ws + WS_SS2)};
            pg8::gemm_phase<Epi6, pg8::StaticOrder, true, true>(lds, g, S, E);
        }
        GRID_BAR();
        int tid_ = threadIdx.x; asm volatile("" : "+v"(tid_));
        const int tid = tid_, lane = tid & 63, wave = __builtin_amdgcn_readfirstlane(tid >> 6), gw = bid * 8 + wave, NGW = G * 8;
        const float* ss2 = (const float*)(ws + WS_SS2); const f32x4* fn = (const f32x4*)a.in[13] + lane;
        f32x4 gn[4];
#pragma unroll
        for (int j = 0; j < 4; ++j) gn[j] = fn[64 * j];
        for (int m = gw; m < MTOK; m += NGW) {
            const float rs = 1.f / sqrtf(sum16(ss2 + (size_t)m * 16) * (1.f / DM) + EPS);
            f32x4* xr = (f32x4*)(a.out + (size_t)m * DM) + lane;
#pragma unroll
            for (int j = 0; j < 4; ++j) xr[64 * j] = xr[64 * j] * rs * gn[j];
        }
    }
#endif
}

extern "C" void kernel_launch(void* const* d_in, const int* in_sizes, int n_in, void* d_out, int out_size, void* d_ws, size_t ws_size, hipStream_t stream) {
    static int grid = 0;
    if (grid == 0) {
        if (n_in != 14 || out_size != MTOK * DM || ws_size < WS_END) { fprintf(stderr, "kernel_launch: unexpected problem shape (n_in %d out %d ws %zu)\n", n_in, out_size, ws_size); grid = -1; return; }
        int dev = 0, cus = 0, per_cu = 0;
        hipGetDevice(&dev);
        hipDeviceGetAttribute(&cus, hipDeviceAttributeMultiprocessorCount, dev);
        if (hipFuncSetAttribute((const void*)fwd_megakernel, hipFuncAttributeMaxDynamicSharedMemorySize, LDS_BYTES) != hipSuccess) { fprintf(stderr, "kernel_launch: hipFuncSetAttribute failed\n"); grid = -1; return; }
        if (hipOccupancyMaxActiveBlocksPerMultiprocessor(&per_cu, (const void*)fwd_megakernel, 512, LDS_BYTES) != hipSuccess || per_cu < 1) { fprintf(stderr, "kernel_launch: occupancy query failed (%d)\n", per_cu); (void)hipGetLastError(); grid = -1; return; }
        grid = cus * per_cu;
    }
    if (grid < 0) return;
    if (hipMemsetAsync((char*)d_ws + WS_BAR, 0, XCD_BAR_WORDS * 4, stream) != hipSuccess) { fprintf(stderr, "kernel_launch: hipMemsetAsync failed\n"); return; }
    Args a{};
    for (int i = 0; i < 14; ++i) a.in[i] = (const float*)d_in[i];
    a.out = (float*)d_out; a.ws = (unsigned char*)d_ws;
    void* args[] = {&a};
    hipError_t e = hipLaunchCooperativeKernel((const void*)fwd_megakernel, dim3(grid), dim3(512), args, LDS_BYTES, stream);
    if (e != hipSuccess) fprintf(stderr, "kernel_launch: cooperative launch failed: %s (grid %d)\n", hipGetErrorString(e), grid);
}
```

```cpp
#include <hip/hip_runtime.h>
#include <hip/hip_cooperative_groups.h>
#include <cstdio>
#include <cstdint>
namespace cg = cooperative_groups;
namespace pg8 {
#define PG8_LAS __attribute__((address_space(3)))
typedef unsigned short bf16_t;
typedef short bf16x8 __attribute__((ext_vector_type(8)));
typedef float f32x4 __attribute__((ext_vector_type(4)));
typedef unsigned u32x4 __attribute__((ext_vector_type(4)));
constexpr int BM = 256, BK = 64, HALF = 128, HTB = HALF * BK * 2  , STAGE_BYTES = 8 * HTB, NXCD = 8, WGM = 8;

__host__ __device__ __forceinline__ int lds_byte(int r, int c) { const int st = (r >> 4) * 2 + (c >> 5), rr = r & 15, cc = c & 31, ob = rr * 64 + cc * 2; return st * 1024 + (ob ^ (((ob >> 9) & 1) << 5)); }
__host__ __device__ __forceinline__ void stage_rc(int b, int& R, int& C) { const int st = b / 1024, sb = b % 1024, swz = sb ^ (((sb >> 9) & 1) << 5); R = (st >> 1) * 16 + swz / 64; C = (st & 1) * 32 + (swz % 64) / 2; }
__host__ __device__ __forceinline__ int perm32(int rho) { const int n = rho >> 4, i = rho & 15; return 8 * (i >> 2) + 4 * n + (i & 3); }

struct Unit { int pm, pn; };
struct Gemm { const bf16_t* A; const bf16_t* Bt; int M, N, K; };

struct StaticOrder {
    int nM, nN, nwg, G, c;
    __host__ __device__ void init(int M, int N, int G_, int c_) { nM = M / BM; nN = N / BM; nwg = nM * nN; G = G_; c = c_; }
    __host__ __device__ bool next(int i, Unit& u) const {
        const long L = (long)i * G + c; if (L >= nwg) return false;
        int wgid = (int)L; { const int q = nwg / NXCD, r = nwg % NXCD, xcd = wgid % NXCD, off = wgid / NXCD; wgid = (xcd < r ? xcd * (q + 1) : r * (q + 1) + (xcd - r) * q) + off; }
        const int nig = WGM * nN, gid = wgid / nig, fm = gid * WGM, gsz = (nM - fm) < WGM ? (nM - fm) : WGM;
        u.pm = fm + ((wgid % nig) % gsz); u.pn = (wgid % nig) / gsz; return true;
    }
    __device__ __forceinline__ void a_ready(const Unit&) const {}
    __device__ __forceinline__ void done(const Unit&) const {}
};

__device__ __forceinline__ unsigned cvt_pk_bf16(float lo, float hi) { unsigned r; asm volatile("v_cvt_pk_bf16_f32 %0, %1, %2" : "=v"(r) : "v"(lo), "v"(hi)); return r; }
template <class Epi, class Sched, bool ALIGN_EPI = false, bool SP2 = false>
__device__ __forceinline__ void gemm_phase(PG8_LAS unsigned char* lds, const Gemm g, const Sched& S, const Epi& E) {
    int tid_ = threadIdx.x; asm volatile("" : "+v"(tid_));
    const int tid = tid_, wid = __builtin_amdgcn_readfirstlane(tid >> 6), lane = tid & 63, wr = wid >> 2, wc = wid & 3, fr = lane & 15, fq = lane >> 4;
    const int K = g.K, nt = K / BK;
    unsigned voffA[2], voffB[2];
#pragma unroll
    for (int i = 0; i < 2; ++i) { int R, C; stage_rc(tid * 16 + i * 8192, R, C); const int Rb = Epi::PERM ? ((R & ~31) + perm32(R & 31)) : R;
        voffA[i] = (unsigned)(R * K + C) * 2u; voffB[i] = (unsigned)(Rb * K + C) * 2u; }
    const size_t kstep = (size_t)(BK * 2);
    const size_t hstep = (size_t)HALF * K * 2;
    const size_t tstep = 2 * hstep;
    const unsigned ldsw = (unsigned)wid * 1024u;
    const int aoff = lds_byte(wr * 64 + fr, fq * 8), boff = lds_byte(wc * 32 + fr, fq * 8);
#define PG8_SA(b, h) (((b) * 2 + (h)) * HTB)
#define PG8_SB(b, h) ((4 + (b) * 2 + (h)) * HTB)
#define PG8_STAGE(bufoff, gbase, voff) do { _Pragma("unroll") for (int _i = 0; _i < 2; ++_i) \
        __builtin_amdgcn_global_load_lds((const unsigned*)((const char*)(gbase) + (voff)[_i]), (PG8_LAS unsigned*)(lds + (bufoff) + ldsw + _i * 8192), 16, 0, 0); } while (0)
#define PG8_LDA(dst, b, h) do { _Pragma("unroll") for (int m = 0; m < 4; ++m) _Pragma("unroll") for (int k = 0; k < 2; ++k) dst[m][k] = *(const PG8_LAS bf16x8*)(lds + PG8_SA(b, h) + aoff + m * 2048 + k * 1024); } while (0)
#define PG8_LDB(dst, b, h) do { _Pragma("unroll") for (int n = 0; n < 2; ++n) _Pragma("unroll") for (int k = 0; k < 2; ++k) dst[n][k] = *(const PG8_LAS bf16x8*)(lds + PG8_SB(b, h) + boff + n * 2048 + k * 1024); } while (0)
#define PG8_MMA(ai, bj, At, Bt) do { __builtin_amdgcn_s_setprio(1); _Pragma("unroll") for (int m = 0; m < 4; ++m) _Pragma("unroll") for (int n = 0; n < 2; ++n) _Pragma("unroll") for (int k = 0; k < 2; ++k) \
        acc[ai][bj][m][n] = __builtin_amdgcn_mfma_f32_16x16x32_bf16(Bt[n][k], At[m][k], acc[ai][bj][m][n], 0, 0, 0); __builtin_amdgcn_s_setprio(0); } while (0)
#define PG8_WAIT_V(n) asm volatile("s_waitcnt vmcnt(" #n ")" ::: "memory")
#define PG8_WAIT_L(n) asm volatile("s_waitcnt lgkmcnt(" #n ")" ::: "memory")
#define PG8_BAR __builtin_amdgcn_s_barrier()
#define PG8_SCHED __builtin_amdgcn_sched_barrier(0)
    Unit cur, nxt; int ui = 0;
    if (!S.next(0, cur)) return;
    f32x4 acc[2][2][4][2];
#pragma unroll
    for (int a = 0; a < 2; ++a)
#pragma unroll
        for (int b = 0; b < 2; ++b)
#pragma unroll
            for (int m = 0; m < 4; ++m)
#pragma unroll
                for (int n = 0; n < 2; ++n) acc[a][b][m][n] = (f32x4){0.f, 0.f, 0.f, 0.f};
    bf16x8 At[4][2], B0[2][2], B1[2][2];
    const char* cA = (const char*)g.A + (size_t)cur.pm * tstep; const char* cB = (const char*)g.Bt + (size_t)cur.pn * tstep;
    S.a_ready(cur);
    if constexpr (SP2) {
        PG8_STAGE(PG8_SB(0, 0), cB, voffB); PG8_STAGE(PG8_SB(0, 1), cB + hstep, voffB); PG8_STAGE(PG8_SA(0, 0), cA, voffA); PG8_STAGE(PG8_SA(0, 1), cA + hstep, voffA);
        if (wr == 1) PG8_BAR;
        PG8_WAIT_V(2); PG8_BAR;
        PG8_STAGE(PG8_SB(1, 0), cB + kstep, voffB); PG8_STAGE(PG8_SA(1, 0), cA + kstep, voffA); PG8_STAGE(PG8_SB(1, 1), cB + hstep + kstep, voffB);
        PG8_WAIT_V(6); PG8_BAR;
    } else {
        PG8_STAGE(PG8_SB(0, 0), cB, voffB); PG8_STAGE(PG8_SA(0, 0), cA, voffA); PG8_STAGE(PG8_SB(0, 1), cB + hstep, voffB); PG8_STAGE(PG8_SA(0, 1), cA + hstep, voffA);
        if (wr == 1) PG8_BAR;
        PG8_WAIT_V(4); PG8_BAR;
        PG8_STAGE(PG8_SB(1, 0), cB + kstep, voffB); PG8_STAGE(PG8_SA(1, 0), cA + kstep, voffA); PG8_STAGE(PG8_SB(1, 1), cB + hstep + kstep, voffB);
        PG8_WAIT_V(6); PG8_BAR;
    }
    for (;;) {
        const bool has_next = S.next(ui + 1, nxt);
        const char* nA = has_next ? (const char*)g.A + (size_t)nxt.pm * tstep : cA; const char* nB = has_next ? (const char*)g.Bt + (size_t)nxt.pn * tstep : cB;
        for (int t = 0; t < nt; t += 2) {
            const bool last = (t == nt - 2);
            const char* a1 = cA + (size_t)(t + 1) * kstep;
            const char* a2 = last ? nA : cA + (size_t)(t + 2) * kstep; const char* b2 = last ? nB : cB + (size_t)(t + 2) * kstep;
            const char* a3 = a2 + kstep; const char* b3 = b2 + kstep;
            if (last && has_next) S.a_ready(nxt);
            if constexpr (SP2) {
            PG8_LDB(B0, 0, 0); PG8_LDB(B1, 0, 1); PG8_SCHED; PG8_LDA(At, 0, 0); PG8_STAGE(PG8_SA(1, 1), a1 + hstep, voffA);
            PG8_WAIT_V(8); PG8_WAIT_L(0); PG8_BAR; PG8_MMA(0, 0, At, B0); PG8_MMA(0, 1, At, B1); PG8_BAR; PG8_SCHED;
            PG8_LDA(At, 0, 1); PG8_STAGE(PG8_SB(0, 0), b2, voffB); PG8_STAGE(PG8_SB(0, 1), b2 + hstep, voffB); PG8_STAGE(PG8_SA(0, 0), a2, voffA);
            PG8_WAIT_V(8); PG8_WAIT_L(0); PG8_BAR; PG8_MMA(1, 0, At, B0); PG8_MMA(1, 1, At, B1); PG8_BAR; PG8_SCHED;
            PG8_LDB(B0, 1, 0); PG8_LDB(B1, 1, 1); PG8_SCHED; PG8_LDA(At, 1, 0); PG8_STAGE(PG8_SA(0, 1), a2 + hstep, voffA);
            PG8_WAIT_V(8); PG8_WAIT_L(0); PG8_BAR; PG8_MMA(0, 0, At, B0); PG8_MMA(0, 1, At, B1); PG8_BAR; PG8_SCHED;
            PG8_LDA(At, 1, 1); PG8_STAGE(PG8_SB(1, 0), b3, voffB); PG8_STAGE(PG8_SB(1, 1), b3 + hstep, voffB); PG8_STAGE(PG8_SA(1, 0), a3, voffA);
            PG8_WAIT_V(8); PG8_WAIT_L(0); PG8_BAR; PG8_MMA(1, 0, At, B0); PG8_MMA(1, 1, At, B1); PG8_BAR; PG8_SCHED;
            } else {
            PG8_LDB(B0, 0, 0); PG8_SCHED; PG8_LDA(At, 0, 0); PG8_STAGE(PG8_SA(1, 1), a1 + hstep, voffA);
            PG8_WAIT_L(8); PG8_BAR; PG8_WAIT_L(0); PG8_MMA(0, 0, At, B0); PG8_BAR; PG8_SCHED;
            PG8_LDB(B1, 0, 1); PG8_STAGE(PG8_SB(0, 0), b2, voffB);
            PG8_BAR; PG8_WAIT_L(0); PG8_MMA(0, 1, At, B1); PG8_BAR;
            PG8_LDA(At, 0, 1); PG8_STAGE(PG8_SA(0, 0), a2, voffA);
            PG8_BAR; PG8_WAIT_L(0); PG8_MMA(1, 0, At, B0); PG8_BAR; PG8_SCHED;
            PG8_STAGE(PG8_SB(0, 1), b2 + hstep, voffB);
            PG8_WAIT_V(6); PG8_BAR; PG8_MMA(1, 1, At, B1); PG8_BAR;
            PG8_LDB(B0, 1, 0); PG8_SCHED; PG8_LDA(At, 1, 0); PG8_STAGE(PG8_SA(0, 1), a2 + hstep, voffA);
            PG8_WAIT_L(8); PG8_BAR; PG8_WAIT_L(0); PG8_MMA(0, 0, At, B0); PG8_BAR; PG8_SCHED;
            PG8_LDB(B1, 1, 1); PG8_STAGE(PG8_SB(1, 0), b3, voffB);
            PG8_BAR; PG8_WAIT_L(0); PG8_MMA(0, 1, At, B1); PG8_BAR;
            PG8_LDA(At, 1, 1); PG8_STAGE(PG8_SA(1, 0), a3, voffA);
            PG8_BAR; PG8_WAIT_L(0); PG8_MMA(1, 0, At, B0); PG8_BAR; PG8_SCHED;
            PG8_STAGE(PG8_SB(1, 1), b3 + hstep, voffB);
            PG8_WAIT_V(6); PG8_BAR; PG8_MMA(1, 1, At, B1); PG8_BAR;
            }
        }
        if constexpr (ALIGN_EPI) { if (wr == 0) PG8_BAR; }
        if constexpr (!Epi::AFTER_DRAIN) { E(acc, cur, wr, wc, fr, fq); S.done(cur); }
        if (!has_next) break;
#pragma unroll
        for (int a = 0; a < 2; ++a)
#pragma unroll
            for (int b = 0; b < 2; ++b)
#pragma unroll
                for (int m = 0; m < 4; ++m)
#pragma unroll
                    for (int n = 0; n < 2; ++n) acc[a][b][m][n] = (f32x4){0.f, 0.f, 0.f, 0.f};
        cur = nxt; cA = nA; cB = nB; ++ui;
        if constexpr (ALIGN_EPI) { if (wr == 1) PG8_BAR; }
    }
    PG8_WAIT_V(0);
    if constexpr (!ALIGN_EPI) { if (wr == 0) PG8_BAR; }
    PG8_BAR;
    if constexpr (Epi::AFTER_DRAIN) { E.fused(acc, cur, wr, wc, fr, fq, lds, wid, lane); S.done(cur); }
#undef PG8_SA
#undef PG8_SB
#undef PG8_STAGE
#undef PG8_LDA
#undef PG8_LDB
#undef PG8_MMA
#undef PG8_WAIT_V
#undef PG8_WAIT_L
#undef PG8_BAR
#undef PG8_SCHED
}
}

#define LAS __attribute__((address_space(3)))
typedef unsigned short bf16;
typedef float f32x4 __attribute__((ext_vector_type(4)));
typedef float f32x2 __attribute__((ext_vector_type(2)));
typedef unsigned u32x4 __attribute__((ext_vector_type(4)));
typedef unsigned u32x2 __attribute__((ext_vector_type(2)));
typedef short bf16x8 __attribute__((ext_vector_type(8)));
typedef short s16x4 __attribute__((ext_vector_type(4)));

constexpr int SEQ = 8192, DM = 1024, MTOK = 16384;
constexpr int LDS_BYTES = 147456;
constexpr float EPS = 1e-6f;
constexpr float LOG2E = 1.4426950408889634f;
constexpr float QSCALE = 0.125f * LOG2E;

constexpr size_t MiB = 1u << 20;
constexpr size_t WS_W0T  = 0;
constexpr size_t WS_WO0T = 10 * MiB;
constexpr size_t WS_W1T  = 14 * MiB;
constexpr size_t WS_WO1T = 19 * MiB;
constexpr size_t WS_WGT  = 21 * MiB;
constexpr size_t WS_ROPE = 21 * MiB + 512 * 1024;
constexpr size_t WS_R0   = 22 * MiB;
constexpr size_t WS_VSS  = 23 * MiB;
constexpr size_t WS_SS1  = 24 * MiB;
constexpr size_t WS_SS2  = 25 * MiB;
constexpr size_t WS_XB   = 26 * MiB;
constexpr size_t WS_Z    = 58 * MiB;
constexpr size_t WS_UG = WS_Z, WS_GV = WS_Z + 32 * MiB, WS_BX = WS_Z + 64 * MiB, WS_BG = WS_Z + 96 * MiB;
constexpr size_t WS_Q  = WS_Z;
constexpr size_t WS_G  = WS_Z + 32 * MiB;
constexpr size_t WS_Y1 = WS_Z + 64 * MiB;
constexpr size_t WS_K  = WS_Z + 128 * MiB;
constexpr size_t WS_VT = WS_Z + 136 * MiB;
constexpr size_t WS_END = WS_Z + 144 * MiB;

__device__ __forceinline__ unsigned cvtpk(float lo, float hi) { return pg8::cvt_pk_bf16(lo, hi); }
__device__ __forceinline__ float bflo(unsigned u) { return __builtin_bit_cast(float, u << 16); }
__device__ __forceinline__ float bfhi(unsigned u) { return __builtin_bit_cast(float, u & 0xffff0000u); }
__device__ __forceinline__ float fast_exp2(float x) { return __builtin_amdgcn_exp2f(x); }
__device__ __forceinline__ float fast_rcp(float x) { return __builtin_amdgcn_rcpf(x); }
__device__ __forceinline__ float silu_f(float x) { return x * fast_rcp(1.f + fast_exp2(-x * LOG2E)); }
__device__ __forceinline__ float gelu_f(float x) { const float t = x * (1.f + 0.044715f * x * x) * (-1.5957691216057308f * LOG2E); return x * fast_rcp(1.f + fast_exp2(t)); }
__device__ __forceinline__ f32x2 exp2_2(f32x2 v) { return (f32x2){fast_exp2(v.x), fast_exp2(v.y)}; }
__device__ __forceinline__ f32x2 rcp_2(f32x2 v) { return (f32x2){fast_rcp(v.x), fast_rcp(v.y)}; }
__device__ __forceinline__ f32x2 min_2(f32x2 v, float m) { return (f32x2){fminf(v.x, m), fminf(v.y, m)}; }
constexpr float GC1 = -1.5957691216057308f * LOG2E, GC2 = 0.044715f;
__device__ __forceinline__ f32x2 gelu_arg(f32x2 u) { return min_2((u * u * (GC1 * GC2) + GC1) * u, 126.f); }
__device__ __forceinline__ f32x2 gelu_2(f32x2 u) { return u * rcp_2(exp2_2(gelu_arg(u)) + 1.f); }
__device__ __forceinline__ f32x2 silu_2(f32x2 g) { return g * rcp_2(exp2_2(min_2(g * (-LOG2E), 126.f)) + 1.f); }
__device__ __forceinline__ f32x2 gelu_silu_2(f32x2 u, f32x2 g) {
    const f32x2 e1 = exp2_2(gelu_arg(u)), e2 = exp2_2(min_2(g * (-LOG2E), 126.f));
    const f32x2 d = e1 + 1.f, d2 = e2 * d + d;
    return (u * g) * rcp_2(d2);
}
__device__ __forceinline__ void swap16(float v, float& a, float& b) { const auto r = __builtin_amdgcn_permlane16_swap(__builtin_bit_cast(unsigned, v), __builtin_bit_cast(unsigned, v), false, false); a = __builtin_bit_cast(float, (unsigned)r[0]); b = __builtin_bit_cast(float, (unsigned)r[1]); }
__device__ __forceinline__ void swap32(float v, float& a, float& b) { const auto r = __builtin_amdgcn_permlane32_swap(__builtin_bit_cast(unsigned, v), __builtin_bit_cast(unsigned, v), false, false); a = __builtin_bit_cast(float, (unsigned)r[0]); b = __builtin_bit_cast(float, (unsigned)r[1]); }
__device__ __forceinline__ float max2f(float a, float b) { float r; asm("v_max_f32_e32 %0, %1, %2" : "=v"(r) : "v"(a), "v"(b)); return r; }
__device__ __forceinline__ float fq_sum(float v) { float a, b; swap16(v, a, b); v = a + b; swap32(v, a, b); return a + b; }
__device__ __forceinline__ float fq_max(float v) { float a, b; swap16(v, a, b); v = max2f(a, b); swap32(v, a, b); return max2f(a, b); }
__device__ __forceinline__ float wave_sum(float v) {
#pragma unroll
    for (int o = 1; o < 64; o <<= 1) v += __shfl_xor(v, o);
    return v;
}
__device__ __forceinline__ float sum16(const float* p) {
    const f32x4 a = *(const f32x4*)p, b = *(const f32x4*)(p + 4), c = *(const f32x4*)(p + 8), d = *(const f32x4*)(p + 12);
    return ((a.x + a.y) + (a.z + a.w)) + ((b.x + b.y) + (b.z + b.w)) + (((c.x + c.y) + (c.z + c.w)) + ((d.x + d.y) + (d.z + d.w)));
}
#define LDS_WAIT() asm volatile("s_waitcnt lgkmcnt(0)" ::: "memory")

struct Args {
    const float* in[14];
    float* out; unsigned char* ws;
    int use_cg_sync, pad;
};

__device__ __forceinline__ void transpose_item(const float* __restrict__ W, int K, int N, bf16* __restrict__ WT, const float* __restrict__ g, int k0, int dst_n0, int src_n0, bool permqk, LAS float* scr, int lane) {
    float wv[32];
#pragma unroll
    for (int i = 0; i < 32; ++i) { const int kk = 2 * i + (lane >> 5); wv[i] = __builtin_nontemporal_load(W + (size_t)(k0 + kk) * N + src_n0 + (lane & 31)); }
    if (g) {
#pragma unroll
        for (int i = 0; i < 32; ++i) wv[i] *= g[k0 + 2 * i + (lane >> 5)];
    }
#pragma unroll
    for (int i = 0; i < 32; ++i) scr[(2 * i + (lane >> 5)) * 33 + (lane & 31)] = wv[i];
    LDS_WAIT(); asm volatile("" ::: "memory");
    const int c = lane & 7;
#pragma unroll
    for (int j = 0; j < 4; ++j) { const int n = (lane >> 3) + 8 * j; int ns = n;
        if (permqk && n < 16) ns = (n & 3) | ((n & 4) << 1) | ((n & 8) >> 1);
        const LAS float* s = scr + (8 * c) * 33 + ns;
        u32x4 o; o.x = cvtpk(s[0 * 33], s[1 * 33]); o.y = cvtpk(s[2 * 33], s[3 * 33]); o.z = cvtpk(s[4 * 33], s[5 * 33]); o.w = cvtpk(s[6 * 33], s[7 * 33]);
        *(u32x4*)(WT + (size_t)(dst_n0 + n) * K + k0 + 8 * c) = o; }
    LDS_WAIT(); asm volatile("" ::: "memory");
}

template <int PART>
__device__ __forceinline__ void p0_prep(const Args& a, LAS unsigned char* lds) {
    int tid_ = threadIdx.x; asm volatile("" : "+v"(tid_));
    const int tid = tid_, lane = tid & 63, wave = __builtin_amdgcn_readfirstlane(tid >> 6);
    const int G = gridDim.x, gw = blockIdx.x * 8 + wave, NGW = G * 8;
    LAS float* scr = (LAS float*)(lds + wave * 16384);
    unsigned char* ws = a.ws;
    const float* x = a.in[0];
    constexpr int I_W0 = 16 * 160, I_WO0 = 32 * 32, I_W1 = 16 * 80, I_WO1 = 16 * 32, I_WG = 4 * 4 * 8;
    constexpr int NITEMS = I_W0 + I_WO0 + I_W1 + I_WO1 + I_WG;
    for (int it = gw + (PART ? I_W0 : 0); it < (PART ? NITEMS : I_W0); it += NGW) {
        int r = it;
        if (r < I_W0) {
            const int kb = r / 160, nb = r % 160, n0 = nb * 32; int src;
            if (n0 < 2048) { const int pn = n0 >> 8, within = n0 & 255, bj = within >> 7, ch = 128 * pn + (within & 127); src = bj ? 2048 + ch : ch; }
            else if (n0 < 3072) src = 1024 + (n0 - 2048);
            else src = n0;
            transpose_item(a.in[2], 1024, 5120, (bf16*)(ws + WS_W0T), a.in[1], kb * 64, n0, src, false, scr, lane); continue; }
        r -= I_W0;
        if (r < I_WO0) { const int kb = r / 32, nb = r % 32; transpose_item(a.in[8], 2048, 1024, (bf16*)(ws + WS_WO0T), nullptr, kb * 64, nb * 32, nb * 32, false, scr, lane); continue; }
        r -= I_WO0;
        if (r < I_W1) { const int kb = r / 80, nb = r % 80, n0 = nb * 32; const bool pq = (n0 < 1280) && ((n0 & 63) == 0);
            transpose_item(a.in[10], 1024, 2560, (bf16*)(ws + WS_W1T), a.in[9], kb * 64, n0, n0, pq, scr, lane); continue; }
        r -= I_W1;
        if (r < I_WO1) { const int kb = r / 32, nb = r % 32; transpose_item(a.in[12], 1024, 1024, (bf16*)(ws + WS_WO1T), nullptr, kb * 64, nb * 32, nb * 32, false, scr, lane); continue; }
        r -= I_WO1;
        { const int gi = r / 32, rr = r % 32, kb = rr / 8, nb = rr % 8;
          transpose_item(a.in[6] + (size_t)gi * 65536, 256, 256, (bf16*)(ws + WS_WGT) + (size_t)gi * 65536, nullptr, kb * 64, nb * 32, nb * 32, false, scr, lane); }
    }
    if (PART == 0) {
        bf16* XB = (bf16*)(ws + WS_XB); float* R0 = (float*)(ws + WS_R0);
        for (int m0 = gw; m0 < MTOK; m0 += 4 * NGW) {
            f32x4 v[4][4];
#pragma unroll
            for (int r = 0; r < 4; ++r) { const int m = min(m0 + r * NGW, MTOK - 1); const f32x4* xr = (const f32x4*)(x + (size_t)m * DM) + lane;
#pragma unroll
                for (int j = 0; j < 4; ++j) v[r][j] = __builtin_nontemporal_load(xr + 64 * j); }
#pragma unroll
            for (int r = 0; r < 4; ++r) { const int m = m0 + r * NGW; float s = 0.f;
#pragma unroll
                for (int j = 0; j < 4; ++j) s += (v[r][j].x * v[r][j].x + v[r][j].y * v[r][j].y) + (v[r][j].z * v[r][j].z + v[r][j].w * v[r][j].w);
                s = wave_sum(s);
                if (m < MTOK) {
                    u32x2* o = (u32x2*)(XB + (size_t)m * DM) + lane;
#pragma unroll
                    for (int j = 0; j < 4; ++j) { u32x2 w; w.x = cvtpk(v[r][j].x, v[r][j].y); w.y = cvtpk(v[r][j].z, v[r][j].w); o[64 * j] = w; }
                    if (lane == 0) R0[m] = 1.f / sqrtf(s * (1.f / DM) + EPS);
                } }
        }
    }
    if (PART == 1) {
        unsigned* T = (unsigned*)(ws + WS_ROPE);
        for (int e = blockIdx.x * 512 + tid; e < SEQ * 8; e += G * 512) {
            const int pos = e >> 3, i = e & 7;
            const float inv = (float)exp2(-(double)i * (18.931568569324174 / 8.0));
            const float ang = (float)pos * inv;
            const double rev = (double)ang * 0.15915494309189535; const double fr = rev - rint(rev);
            const float rf = (float)fr;
            T[e] = (unsigned)__builtin_bit_cast(unsigned short, (_Float16)__builtin_amdgcn_cosf(rf)) | ((unsigned)__builtin_bit_cast(unsigned short, (_Float16)__builtin_amdgcn_sinf(rf)) << 16);
        }
    }
}

#define EPI_ARGS const f32x4 (&acc)[2][2][4][2], const pg8::Unit& u, int wr, int wc, int fr, int fq


struct EpiIn0 {
    static constexpr bool PERM = true, AFTER_DRAIN = false;
    const float* r0; bf16 *UG, *GV, *BX, *BG; float* vss;
    __device__ __forceinline__ void operator()(EPI_ARGS) const {
        const int row0 = u.pm * 256 + wr * 64 + fr, pn = u.pn;
        float rs8[2][4];
#pragma unroll
        for (int ai = 0; ai < 2; ++ai)
#pragma unroll
            for (int m = 0; m < 4; ++m) rs8[ai][m] = r0[row0 + ai * 128 + m * 16];
        if (pn < 8) {
            const int col = 128 * pn + 32 * wc + 8 * fq;
#pragma unroll
            for (int ai = 0; ai < 2; ++ai)
#pragma unroll
                for (int m = 0; m < 4; ++m) { const int row = row0 + ai * 128 + m * 16; const float rs = rs8[ai][m];
                    u32x4 w;
#pragma unroll
                    for (int n = 0; n < 2; ++n) { const f32x4 au = acc[ai][0][m][n] * rs, ag = acc[ai][1][m][n] * rs;
                        const f32x2 o0 = gelu_silu_2((f32x2){au.x, au.y}, (f32x2){ag.x, ag.y}), o1 = gelu_silu_2((f32x2){au.z, au.w}, (f32x2){ag.z, ag.w});
                        w[2 * n] = cvtpk(o0.x, o0.y); w[2 * n + 1] = cvtpk(o1.x, o1.y); }
                    *(u32x4*)(UG + (size_t)row * 1024 + col) = w; }
        } else if (pn < 12) {
            const int col = 256 * (pn - 8) + 32 * wc + 8 * fq;
#pragma unroll
            for (int ai = 0; ai < 2; ++ai)
#pragma unroll
                for (int m = 0; m < 4; ++m) { const int row = row0 + ai * 128 + m * 16; const float rs = rs8[ai][m]; float ss = 0.f;
#pragma unroll
                    for (int bj = 0; bj < 2; ++bj) { u32x4 w;
#pragma unroll
                        for (int n = 0; n < 2; ++n) { const f32x4 av = acc[ai][bj][m][n] * rs;
                            const f32x2 o0 = gelu_2((f32x2){av.x, av.y}), o1 = gelu_2((f32x2){av.z, av.w});
                            const f32x2 q = o0 * o0 + o1 * o1; ss += q.x + q.y;
                            w[2 * n] = cvtpk(o0.x, o0.y); w[2 * n + 1] = cvtpk(o1.x, o1.y); }
                        *(u32x4*)(GV + (size_t)row * 1024 + col + bj * 128) = w; }
                    ss = fq_sum(ss);
                    if (fq == 0) vss[(size_t)row * 16 + (pn - 8) * 4 + wc] = ss; }
        } else {
            const bool isg = pn >= 16; bf16* O = isg ? BG : BX;
            const int col = 256 * (pn - (isg ? 16 : 12)) + 32 * wc + 8 * fq;
#pragma unroll
            for (int ai = 0; ai < 2; ++ai)
#pragma unroll
                for (int m = 0; m < 4; ++m) { const int row = row0 + ai * 128 + m * 16; const float rs = rs8[ai][m];
#pragma unroll
                    for (int bj = 0; bj < 2; ++bj) { u32x4 w;
#pragma unroll
                        for (int n = 0; n < 2; ++n) { const f32x4 av = acc[ai][bj][m][n] * rs;
                            f32x2 o0 = (f32x2){av.x, av.y}, o1 = (f32x2){av.z, av.w};
                            if (isg) { o0 = silu_2(o0); o1 = silu_2(o1); }
                            w[2 * n] = cvtpk(o0.x, o0.y); w[2 * n + 1] = cvtpk(o1.x, o1.y); }
                        *(u32x4*)(O + (size_t)row * 1024 + col + bj * 128) = w; } }
        }
    }
};

template <bool XIN_BF16, bool OUT_F32, bool OUT_BF16>
struct EpiRes {
    static constexpr bool PERM = true, AFTER_DRAIN = false;
    const void* xin; float* xo; bf16* xb; float* ss;
    __device__ __forceinline__ void load_batch(f32x4 (&x)[2][2][2], int row0, int col0, int b) const {
#pragma unroll
        for (int mm = 0; mm < 2; ++mm)
#pragma unroll
            for (int bj = 0; bj < 2; ++bj) { const size_t off = (size_t)(row0 + (b >> 1) * 128 + (2 * (b & 1) + mm) * 16) * 1024 + col0 + bj * 128;
                if (XIN_BF16) { const u32x4 r = *(const u32x4*)((const bf16*)xin + off); x[mm][bj][0] = (f32x4){bflo(r.x), bfhi(r.x), bflo(r.y), bfhi(r.y)}; x[mm][bj][1] = (f32x4){bflo(r.z), bfhi(r.z), bflo(r.w), bfhi(r.w)}; }
                else { x[mm][bj][0] = *(const f32x4*)((const float*)xin + off); x[mm][bj][1] = *(const f32x4*)((const float*)xin + off + 4); } }
    }
    __device__ __forceinline__ void operator()(EPI_ARGS) const {
        const int row0 = u.pm * 256 + wr * 64 + fr, col0 = u.pn * 256 + 32 * wc + 8 * fq;
        f32x4 xa[2][2][2], xb2[2][2][2];
        load_batch(xa, row0, col0, 0);
#pragma unroll
        for (int b = 0; b < 4; ++b) {
            if (b + 1 < 4) { if (b & 1) load_batch(xa, row0, col0, b + 1); else load_batch(xb2, row0, col0, b + 1); }
            const int ai = b >> 1;
#pragma unroll
            for (int mm = 0; mm < 2; ++mm) { const int m = 2 * (b & 1) + mm, row = row0 + ai * 128 + m * 16; float s = 0.f;
#pragma unroll
                for (int bj = 0; bj < 2; ++bj) { const size_t off = (size_t)row * 1024 + col0 + bj * 128;
                    const f32x4 v0 = ((b & 1) ? xb2[mm][bj][0] : xa[mm][bj][0]) + acc[ai][bj][m][0], v1 = ((b & 1) ? xb2[mm][bj][1] : xa[mm][bj][1]) + acc[ai][bj][m][1];
                    if (OUT_F32) { *(f32x4*)(xo + off) = v0; *(f32x4*)(xo + off + 4) = v1; }
                    s += (v0.x * v0.x + v0.y * v0.y) + (v0.z * v0.z + v0.w * v0.w) + (v1.x * v1.x + v1.y * v1.y) + (v1.z * v1.z + v1.w * v1.w);
                    if (OUT_BF16) { u32x4 w; w.x = cvtpk(v0.x, v0.y); w.y = cvtpk(v0.z, v0.w); w.z = cvtpk(v1.x, v1.y); w.w = cvtpk(v1.z, v1.w); *(u32x4*)(xb + off) = w; } }
                s = fq_sum(s);
                if (fq == 0) ss[(size_t)row * 16 + u.pn * 4 + wc] = s; }
        }
    }
};

struct EpiIn1 {
    static constexpr bool PERM = true, AFTER_DRAIN = false;
    const float* ss1; const unsigned* rope; bf16 *Q, *K, *VT, *G;
    __device__ __forceinline__ void operator()(EPI_ARGS) const {
        const int row0 = u.pm * 256 + wr * 64 + fr, pn = u.pn;
        const bool dorope = (pn < 5) && ((wc & 1) == 0) && (fq < 2);
        float rs8[2][4];
        {
            f32x4 part[2][4];
#pragma unroll
            for (int ai = 0; ai < 2; ++ai)
#pragma unroll
                for (int m = 0; m < 4; ++m) part[ai][m] = *(const f32x4*)(ss1 + (size_t)(row0 + ai * 128 + m * 16) * 16 + 4 * fq);
#pragma unroll
            for (int ai = 0; ai < 2; ++ai)
#pragma unroll
                for (int m = 0; m < 4; ++m) { const f32x4 pq = part[ai][m]; rs8[ai][m] = 1.f / sqrtf(fq_sum((pq.x + pq.y) + (pq.z + pq.w)) * (1.f / DM) + EPS); }
        }
        u32x4 cst[2][4];
#pragma unroll
        for (int ai = 0; ai < 2; ++ai)
#pragma unroll
            for (int m = 0; m < 4; ++m) { cst[ai][m] = (u32x4){0x3c00u, 0x3c00u, 0x3c00u, 0x3c00u};
                if (dorope) cst[ai][m] = *(const u32x4*)(rope + (size_t)((row0 + ai * 128 + m * 16) & (SEQ - 1)) * 8 + 4 * fq); }
#pragma unroll
        for (int ai = 0; ai < 2; ++ai)
#pragma unroll
            for (int m = 0; m < 4; ++m) { const int row = row0 + ai * 128 + m * 16;
                const float rs = rs8[ai][m];
                const u32x4 ct = cst[ai][m];
#pragma unroll
                for (int bj = 0; bj < 2; ++bj) {
                    f32x4 z0 = acc[ai][bj][m][0] * rs, z1 = acc[ai][bj][m][1] * rs;
                    const int colt = 128 * bj + 32 * wc + 8 * fq;
                    if (pn < 5) {
                        if (dorope) {
                            float c[4], s[4];
#pragma unroll
                            for (int j = 0; j < 4; ++j) { c[j] = (float)__builtin_bit_cast(_Float16, (unsigned short)(ct[j] & 0xffffu)); s[j] = (float)__builtin_bit_cast(_Float16, (unsigned short)(ct[j] >> 16)); }
#pragma unroll
                            for (int j = 0; j < 4; ++j) { const float a1 = z0[j], a2 = z1[j]; z0[j] = a1 * c[j] - a2 * s[j]; z1[j] = a2 * c[j] + a1 * s[j]; }
                        }
                        if (pn < 4) { z0 = z0 * QSCALE; z1 = z1 * QSCALE; }
                        u32x4 w; w.x = cvtpk(z0.x, z0.y); w.y = cvtpk(z0.z, z0.w); w.z = cvtpk(z1.x, z1.y); w.w = cvtpk(z1.z, z1.w);
                        if (pn < 4) *(u32x4*)(Q + (size_t)row * 1024 + 256 * pn + colt) = w;
                        else        *(u32x4*)(K + (size_t)row * 256 + colt) = w;
                    } else if (pn == 5) {
                        u32x4 w; w.x = cvtpk(z0.x, z0.y); w.y = cvtpk(z0.z, z0.w); w.z = cvtpk(z1.x, z1.y); w.w = cvtpk(z1.z, z1.w);
                        *(u32x4*)(VT + (size_t)row * 256 + colt) = w;
                    } else {
                        const f32x2 s0 = silu_2((f32x2){z0.x, z0.y}), s1 = silu_2((f32x2){z0.z, z0.w}), s2 = silu_2((f32x2){z1.x, z1.y}), s3 = silu_2((f32x2){z1.z, z1.w});
                        u32x4 w; w.x = cvtpk(s0.x, s0.y); w.y = cvtpk(s1.x, s1.y); w.z = cvtpk(s2.x, s2.y); w.w = cvtpk(s3.x, s3.y);
                        *(u32x4*)(G + (size_t)row * 1024 + 256 * (pn - 6) + colt) = w;
                    }
                } }
    }
};

#define MFMA16(a, b, c) __builtin_amdgcn_mfma_f32_16x16x32_bf16((a), (b), (c), 0, 0, 0)

typedef short v4i16_t __attribute__((ext_vector_type(4)));
__device__ __forceinline__ float max3f(float a, float b, float c) { float r; asm("v_max3_f32 %0, %1, %2, %3" : "=v"(r) : "v"(a), "v"(b), "v"(c)); return r; }
__device__ __forceinline__ s16x4 trread(const LAS bf16* p) { return __builtin_bit_cast(s16x4, __builtin_amdgcn_ds_read_tr16_b64_v4i16((LAS v4i16_t*)p)); }
__device__ __forceinline__ bf16x8 cat8(s16x4 a, s16x4 b) { return __builtin_shufflevector(a, b, 0, 1, 2, 3, 4, 5, 6, 7); }

__device__ __forceinline__ int unit_tile(int u) { return 16 * (u & 7) + (u >> 5); }
__device__ __forceinline__ int unit_grp(int u) { return (u >> 3) & 3; }

__device__ __forceinline__ void issue_a(const Args& a, int c, int h, int tid, u32x4 (&pf)[9]) {
    const bf16* GV = (const bf16*)(a.ws + WS_GV);
#pragma unroll
    for (int it = 0; it < 8; ++it) { const int item = it * 512 + tid, cl = item & 31, j = item >> 5; pf[it] = *(const u32x4*)(GV + (size_t)(128 * c + j) * 1024 + 256 * h + 8 * cl); }
}
__device__ __forceinline__ void issue_b(const Args& a, int tt, int g, int tid, u32x4 (&pf)[9]) {
    const int b = tt >> 6, t0 = (tt & 63) * 128;
    const bf16* base = (const bf16*)(a.ws + WS_BX) + (size_t)b * SEQ * 1024 + 256 * g;
#pragma unroll
    for (int it = 0; it < 9; ++it) { const int item = it * 512 + tid, cl = item & 31, rr = item >> 5, pos = t0 - 8 + rr;
        pf[it] = (u32x4){0u, 0u, 0u, 0u};
        if (pos >= 0 && pos < SEQ) pf[it] = *(const u32x4*)(base + (size_t)pos * 1024 + 8 * cl); }
}
__device__ __forceinline__ void issue_next(const Args& a, int nkind, int nidx, int tid, u32x4 (&pf)[9]) {
    if (nkind == 0) issue_a(a, unit_tile(nidx), unit_grp(nidx), tid, pf); else if (nkind == 1) issue_b(a, unit_tile(nidx), unit_grp(nidx), tid, pf);
}

__device__ __forceinline__ void mixer_a_unit(const Args& a, LAS unsigned char* lds, int c, int h, u32x4 (&pf)[9], int nkind, int nidx) {
    int tid_ = threadIdx.x; asm volatile("" : "+v"(tid_));
    const int tid = tid_, lane = tid & 63, w = __builtin_amdgcn_readfirstlane(tid >> 6), fr = lane & 15, fq = lane >> 4;
    constexpr int VS2 = 264, WS_ = 136;
    LAS bf16* V = (LAS bf16*)lds;
    LAS bf16* Ws = (LAS bf16*)(lds + 67584);
    LAS float* rvs = (LAS float*)(lds + 67584 + 34816);
    const unsigned char* ws = a.ws;
    const bf16* UG = (const bf16*)(ws + WS_UG); const float* vss = (const float*)(ws + WS_VSS);
    bf16* Y0 = (bf16*)a.out;
    const float* wsp = a.in[4] + (size_t)h * 16384; const float* bsp = a.in[5] + h * 128; const float* gv = a.in[3];
    f32x4 wsr[8];
#pragma unroll
    for (int it = 0; it < 8; ++it) { const int item = it * 512 + tid, j4 = item & 31, i = item >> 5; wsr[it] = *(const f32x4*)(wsp + i * 128 + 4 * j4); }
    if (tid < 128) rvs[tid] = 1.f / sqrtf(sum16(vss + (size_t)(128 * c + tid) * 16) * (1.f / 1024.f) + EPS);
#pragma unroll
    for (int it = 0; it < 8; ++it) { const int item = it * 512 + tid, cl = item & 31, j = item >> 5; *(LAS u32x4*)(V + j * VS2 + 8 * cl) = pf[it]; }
    issue_next(a, nkind, nidx, tid, pf);
    __syncthreads();
#pragma unroll
    for (int it = 0; it < 8; ++it) { const int item = it * 512 + tid, j4 = item & 31, i = item >> 5;
        const f32x4 r = *(const LAS f32x4*)(rvs + 4 * j4); const f32x4 v = wsr[it];
        u32x2 o; o.x = cvtpk(v.x * r.x, v.y * r.y); o.y = cvtpk(v.z * r.z, v.w * r.w);
        *(LAS u32x2*)(Ws + i * WS_ + 4 * j4) = o; }
    u32x4 ugr[8];
#pragma unroll
    for (int it = 0; it < 8; ++it) ugr[it] = *(const u32x4*)(UG + (size_t)(128 * c + 16 * it + fr) * 1024 + 256 * h + 32 * w + 8 * fq);
    __syncthreads();
    f32x4 acc[2][8];
#pragma unroll
    for (int dt = 0; dt < 2; ++dt)
#pragma unroll
        for (int it = 0; it < 8; ++it) acc[dt][it] = (f32x4){0.f, 0.f, 0.f, 0.f};
    const LAS bf16* vb = V + (8 * fq + ((lane >> 2) & 3)) * VS2 + 32 * w + 8 * (lane & 3);
#pragma unroll
    for (int ks = 0; ks < 4; ++ks) {
        bf16x8 af[2], bfr[8];
#pragma unroll
        for (int dt = 0; dt < 2; ++dt) { const LAS bf16* p = vb + (32 * ks) * VS2 + 4 * dt; af[dt] = cat8(trread(p), trread(p + 4 * VS2)); }
#pragma unroll
        for (int it = 0; it < 8; ++it) bfr[it] = *(const LAS bf16x8*)(Ws + (16 * it + fr) * WS_ + 32 * ks + 8 * fq);
#pragma unroll
        for (int dt = 0; dt < 2; ++dt)
#pragma unroll
            for (int it = 0; it < 8; ++it) acc[dt][it] = MFMA16(af[dt], bfr[it], acc[dt][it]);
    }
    {   const int col = 256 * h + 32 * w + 8 * fq; const f32x4 g0 = *(const f32x4*)(gv + col), g1 = *(const f32x4*)(gv + col + 4);
#pragma unroll
        for (int it = 0; it < 8; ++it) { const int i = 16 * it + fr, row = 128 * c + i; const float bs = bsp[i];
            const u32x4 ug = ugr[it];
            const f32x4 m0 = acc[0][it] * g0 + bs, m1 = acc[1][it] * g1 + bs;
            u32x4 o; o.x = cvtpk(bflo(ug.x) * m0.x, bfhi(ug.x) * m0.y); o.y = cvtpk(bflo(ug.y) * m0.z, bfhi(ug.y) * m0.w); o.z = cvtpk(bflo(ug.z) * m1.x, bfhi(ug.z) * m1.y); o.w = cvtpk(bflo(ug.w) * m1.z, bfhi(ug.w) * m1.w);
            *(u32x4*)(Y0 + (size_t)row * 2048 + col) = o; } }
    __syncthreads();
}

__device__ __forceinline__ void mixer_b_unit(const Args& a, LAS unsigned char* lds, int tt, int g, u32x4 (&pf)[9], int nkind, int nidx) {
    int tid_ = threadIdx.x; asm volatile("" : "+v"(tid_));
    const int tid = tid_, lane = tid & 63, w = __builtin_amdgcn_readfirstlane(tid >> 6), fr = lane & 15, fq = lane >> 4;
    constexpr int PS = 264;
    LAS bf16* Bs = (LAS bf16*)lds;
    LAS bf16* P = (LAS bf16*)(lds + 76032);
    const unsigned char* ws = a.ws;
    const bf16* BG = (const bf16*)(ws + WS_BG); const bf16* WGT = (const bf16*)(ws + WS_WGT) + (size_t)g * 65536;
    bf16* Y0 = (bf16*)a.out; const float* bscale = a.in[7];
    const int b = tt >> 6, t0 = (tt & 63) * 128;
#pragma unroll
    for (int it = 0; it < 9; ++it) { const int item = it * 512 + tid, cl = item & 31, rr = item >> 5; *(LAS u32x4*)(Bs + rr * PS + 8 * cl) = pf[it]; }
    bf16x8 wf[8][2];
#pragma unroll
    for (int ks = 0; ks < 8; ++ks)
#pragma unroll
        for (int et = 0; et < 2; ++et) wf[ks][et] = *(const bf16x8*)(WGT + (size_t)(32 * w + 8 * (fr >> 2) + 4 * et + (fr & 3)) * 256 + 32 * ks + 8 * fq);
    u32x4 bgr[8];
#pragma unroll
    for (int it = 0; it < 8; ++it) bgr[it] = *(const u32x4*)(BG + (size_t)(128 * tt + 16 * it + fr) * 1024 + 256 * g + 32 * w + 8 * fq);
    __syncthreads();
    {
        const int cl = tid & 31, tr = tid >> 5, half = 1 << g;
        const LAS bf16* col = Bs + 8 * cl;
        float s[8];
#pragma unroll
        for (int e = 0; e < 8; ++e) s[e] = 0.f;
        for (int rr = 8 * tr + 8 - half; rr < 8 * tr + 8 + half; ++rr) { const u32x4 r = *(const LAS u32x4*)(col + rr * PS);
#pragma unroll
            for (int e = 0; e < 4; ++e) { s[2 * e] += bflo(r[e]); s[2 * e + 1] += bfhi(r[e]); } }
        for (int k = 0; k < 8; ++k) { const int tl = 8 * tr + k, t = t0 + tl; const int lo = max(t - half, 0), hi = min(t + half, SEQ); const float inv = 1.f / (float)(hi - lo);
            const u32x4 r = *(const LAS u32x4*)(col + (tl + 8) * PS);
            u32x4 o;
#pragma unroll
            for (int e = 0; e < 4; ++e) o[e] = cvtpk(s[2 * e] * inv - bflo(r[e]), s[2 * e + 1] * inv - bfhi(r[e]));
            *(LAS u32x4*)(P + tl * PS + 8 * cl) = o;
            const u32x4 qa = *(const LAS u32x4*)(col + (tl + 8 + half) * PS), qs = *(const LAS u32x4*)(col + (tl + 8 - half) * PS);
#pragma unroll
            for (int e = 0; e < 4; ++e) { s[2 * e] += bflo(qa[e]) - bflo(qs[e]); s[2 * e + 1] += bfhi(qa[e]) - bfhi(qs[e]); } }
    }
    __syncthreads();
    f32x4 acc[2][8];
#pragma unroll
    for (int et = 0; et < 2; ++et)
#pragma unroll
        for (int it = 0; it < 8; ++it) acc[et][it] = (f32x4){0.f, 0.f, 0.f, 0.f};
#pragma unroll
    for (int ks = 0; ks < 8; ++ks) {
        bf16x8 bfr[8];
#pragma unroll
        for (int it = 0; it < 8; ++it) bfr[it] = *(const LAS bf16x8*)(P + (16 * it + fr) * PS + 32 * ks + 8 * fq);
#pragma unroll
        for (int et = 0; et < 2; ++et)
#pragma unroll
            for (int it = 0; it < 8; ++it) acc[et][it] = MFMA16(wf[ks][et], bfr[it], acc[et][it]);
    }
    issue_next(a, nkind, nidx, tid, pf);
    {   const int col = 256 * g + 32 * w + 8 * fq; const f32x4 s0 = *(const f32x4*)(bscale + col), s1 = *(const f32x4*)(bscale + col + 4);
#pragma unroll
        for (int it = 0; it < 8; ++it) { const int row = 128 * tt + 16 * it + fr;
            const u32x4 bg = bgr[it];
            const f32x4 y0 = acc[0][it] * s0, y1 = acc[1][it] * s1;
            u32x4 o; o.x = cvtpk(bflo(bg.x) * y0.x, bfhi(bg.x) * y0.y); o.y = cvtpk(bflo(bg.y) * y0.z, bfhi(bg.y) * y0.w); o.z = cvtpk(bflo(bg.z) * y1.x, bfhi(bg.z) * y1.y); o.w = cvtpk(bflo(bg.w) * y1.z, bfhi(bg.w) * y1.w);
            *(u32x4*)(Y0 + (size_t)row * 2048 + 1024 + col) = o; } }
    __syncthreads();
}

__device__ __forceinline__ void attn_issue(const Args& a, int u, int tid, u32x4 (&kr)[6], u32x4 (&vr)[6]) {
    if (u >= 512) return;
    const int gq = unit_tile(u), b = gq >> 6, qb = gq & 63, kvh = unit_grp(u), kb0 = (qb - 1) * 128;
    const bf16* Kg = (const bf16*)(a.ws + WS_K); const bf16* Vg = (const bf16*)(a.ws + WS_VT);
#pragma unroll
    for (int it = 0; it < 6; ++it) { const int item = it * 512 + tid, ch = item & 7, key = item >> 3; const int pos = kb0 + key;
        kr[it] = (u32x4){0u, 0u, 0u, 0u}; vr[it] = (u32x4){0u, 0u, 0u, 0u};
        if (pos >= 0 && pos < SEQ) { const size_t off = (size_t)(b * SEQ + pos) * 256 + kvh * 64 + 8 * ch; kr[it] = *(const u32x4*)(Kg + off); vr[it] = *(const u32x4*)(Vg + off); } }
}
__device__ __forceinline__ void attn_unit(const Args& a, LAS unsigned char* lds, int b, int qb, int kvh, u32x4 (&kr)[6], u32x4 (&vr)[6], int unext) {
    int tid_ = threadIdx.x; asm volatile("" : "+v"(tid_));
    const int tid = tid_, lane = tid & 63, w = __builtin_amdgcn_readfirstlane(tid >> 6), fr = lane & 15, fq = lane >> 4;
    constexpr int KS = 72, VS = 80;
    LAS bf16* Ks = (LAS bf16*)lds;
    LAS bf16* Vs = (LAS bf16*)(lds + 55296);
    const unsigned char* ws = a.ws;
    const bf16* Qg = (const bf16*)(ws + WS_Q); const bf16* Gg = (const bf16*)(ws + WS_G);
    bf16* Y1 = (bf16*)(a.ws + WS_Y1);
    const int kb0 = (qb - 1) * 128;
    const int head = kvh * 4 + (w >> 1);
    const size_t qbase = (size_t)(b * SEQ + qb * 128 + (w & 1) * 64 + fr) * 1024 + head * 64;
#pragma unroll
    for (int it = 0; it < 6; ++it) { const int item = it * 512 + tid, ch = item & 7, key = item >> 3; *(LAS u32x4*)(Ks + key * KS + 8 * ch) = kr[it];
        const u32x4 v = vr[it]; *(LAS u32x4*)(Vs + key * VS + 8 * ch) = (key & 1) ? (u32x4){v.z, v.w, v.x, v.y} : v; }
    attn_issue(a, unext, tid, kr, vr);
    bf16x8 q0 = *(const bf16x8*)(Qg + qbase + 8 * fq), q1 = *(const bf16x8*)(Qg + qbase + 32 + 8 * fq);
    __syncthreads();
    const float sink2 = a.in[11][head] * LOG2E;
    const bool edge = (qb == 0) || (qb == SEQ / 128 - 1);
    const LAS bf16* vtb = Vs + (4 * fq + ((lane >> 2) & 3)) * VS + 8 * (lane & 3);
    const int vsw = 4 * ((lane >> 2) & 1);
    for (int it = 0; it < 4; ++it) {
        const int rowoff = (w & 1) * 64 + 16 * it;
        const size_t qoff = qbase + (size_t)(16 * it) * 1024;
        const u32x4 g0 = *(const u32x4*)(Gg + qoff + 8 * fq), g1 = *(const u32x4*)(Gg + qoff + 32 + 8 * fq);
        const bf16x8 qa = q0, qb2 = q1;
        if (it < 3) { q0 = *(const bf16x8*)(Qg + qoff + 16 * 1024 + 8 * fq); q1 = *(const bf16x8*)(Qg + qoff + 16 * 1024 + 32 + 8 * fq); }
        const int kt0 = (rowoff >> 4) & ~1;
        f32x4 S[18];
        const LAS bf16* kpb = Ks + (16 * kt0 + fr) * KS + 8 * fq;
#pragma unroll
        for (int j = 0; j < 18; ++j) { const LAS bf16* kp = kpb + j * (16 * KS);
            f32x4 s = {0.f, 0.f, 0.f, 0.f};
            s = MFMA16(*(const LAS bf16x8*)kp, qa, s); s = MFMA16(*(const LAS bf16x8*)(kp + 32), qb2, s); S[j] = s;
            }
        const int qpos = qb * 128 + rowoff + fr, kbase = kb0 + 16 * kt0 + 4 * fq;
        const int klo = max(qpos - 128, 0), khi = min(qpos + 128, SEQ - 1);
        int mbase = kbase - klo; const unsigned mspan = (unsigned)(khi - klo);
        asm volatile("" : "+v"(mbase));
#define ATT_MASK_TILE(j) do { _Pragma("unroll") for (int r = 0; r < 4; ++r) { const bool ok = (unsigned)(mbase + (16 * (j) + r)) <= mspan; S[j][r] = ok ? S[j][r] : -1e30f; } } while (0)
        if (edge) {
#pragma unroll
            for (int j = 0; j < 18; ++j) ATT_MASK_TILE(j);
        } else {
            ATT_MASK_TILE(0); ATT_MASK_TILE(1); ATT_MASK_TILE(16); ATT_MASK_TILE(17);
        }
#undef ATT_MASK_TILE
        float mx = sink2;
#pragma unroll
        for (int j = 0; j < 18; ++j) { mx = max3f(mx, S[j][0], S[j][1]); mx = max3f(mx, S[j][2], S[j][3]); }
        mx = fq_max(mx);
        f32x2 l2 = {0.f, 0.f};
#pragma unroll
        for (int j = 0; j < 18; ++j) { const f32x2 p0 = exp2_2((f32x2){S[j][0], S[j][1]} - mx), p1 = exp2_2((f32x2){S[j][2], S[j][3]} - mx);
            S[j] = (f32x4){p0.x, p0.y, p1.x, p1.y}; l2 += p0 + p1; }
        float l = l2.x + l2.y;
        l = fq_sum(l);
        l += fast_exp2(sink2 - mx);
        const float rl = 1.f / l;
        const LAS bf16* vpb = vtb + (16 * kt0) * VS;
        f32x4 O[4];
#pragma unroll
        for (int dt = 0; dt < 4; ++dt) O[dt] = (f32x4){0.f, 0.f, 0.f, 0.f};
#pragma unroll
        for (int jp = 0; jp < 9; ++jp) {
            u32x4 pw; pw.x = cvtpk(S[2 * jp][0], S[2 * jp][1]); pw.y = cvtpk(S[2 * jp][2], S[2 * jp][3]); pw.z = cvtpk(S[2 * jp + 1][0], S[2 * jp + 1][1]); pw.w = cvtpk(S[2 * jp + 1][2], S[2 * jp + 1][3]);
            const bf16x8 pf = __builtin_bit_cast(bf16x8, pw);
            const LAS bf16* vp = vpb + jp * (32 * VS);
#pragma unroll
            for (int dt = 0; dt < 4; ++dt) { const LAS bf16* p = vp + 32 * (dt >> 1) + ((dt & 1) ? 4 - vsw : vsw);
                O[dt] = MFMA16(cat8(trread(p), trread(p + 16 * VS)), pf, O[dt]); }
        }
        {
            const f32x4 a0 = O[0] * rl, a1 = O[1] * rl, a2 = O[2] * rl, a3 = O[3] * rl;
            u32x4 o0, o1;
            o0.x = cvtpk(a0.x * bflo(g0.x), a0.y * bfhi(g0.x)); o0.y = cvtpk(a0.z * bflo(g0.y), a0.w * bfhi(g0.y)); o0.z = cvtpk(a1.x * bflo(g0.z), a1.y * bfhi(g0.z)); o0.w = cvtpk(a1.z * bflo(g0.w), a1.w * bfhi(g0.w));
            o1.x = cvtpk(a2.x * bflo(g1.x), a2.y * bfhi(g1.x)); o1.y = cvtpk(a2.z * bflo(g1.y), a2.w * bfhi(g1.y)); o1.z = cvtpk(a3.x * bflo(g1.z), a3.y * bfhi(g1.z)); o1.w = cvtpk(a3.z * bflo(g1.w), a3.w * bfhi(g1.w));
            *(u32x4*)(Y1 + qoff + 8 * fq) = o0; *(u32x4*)(Y1 + qoff + 32 + 8 * fq) = o1;
        }
    }
    __syncthreads();
}

#define RLX_AGENT __ATOMIC_RELAXED, __HIP_MEMORY_SCOPE_AGENT
#define XB_TMO      128
#define XB_XCNT(j)  (256  + 64 * (j))
#define XB_XSUB(j)  (1280 + 64 * (j))
#define XB_XGEN(j)  (2304 + 64 * (j))
#define XB_TOP      3328
#define XB_TOPGEN   3392
#define XCD_BAR_WORDS 3456
#define XB_SPIN_CAP (1u << 18)

__device__ __forceinline__ unsigned xb_ld(unsigned* p)              { return __hip_atomic_load(p, __ATOMIC_RELAXED, __HIP_MEMORY_SCOPE_AGENT); }
__device__ __forceinline__ unsigned xb_add(unsigned* p, unsigned v) { return __hip_atomic_fetch_add(p, v, __ATOMIC_RELAXED, __HIP_MEMORY_SCOPE_AGENT); }
__device__ __forceinline__ unsigned xb_xcc_id() { return (unsigned)__builtin_amdgcn_s_getreg((3 << 11) | 20) & 0xFu; }
#define XB_SPIN(cond, bar) do { unsigned _sp = 0; while (cond) { __builtin_amdgcn_s_sleep(1); \
    if ((++_sp & 255u) == 0u) { if (xb_ld(&(bar)[XB_TMO])) break; if (_sp > XB_SPIN_CAP) { atomicAdd(&(bar)[XB_TMO], 1u); break; } } } } while (0)

struct XcdBarrier {
    unsigned* bar; unsigned x;
    volatile LAS unsigned* st;
};

__device__ __forceinline__ XcdBarrier xcd_barrier_post(unsigned* bar, volatile LAS unsigned* st) {
    XcdBarrier b; b.bar = bar; b.x = xb_xcc_id(); b.st = st;
    if (threadIdx.x == 0) (void)xb_add(&bar[XB_XCNT(b.x)], 1u);
    return b;
}
__device__ __forceinline__ void xcd_barrier_complete(unsigned* bar, unsigned x, unsigned& nloc, unsigned& nx) {
    const unsigned G = gridDim.x * gridDim.y * gridDim.z;
    unsigned sum, cnt, mine, sp = 0u;
    for (;;) {
        sum = 0u; cnt = 0u; mine = 0u;
#pragma unroll
        for (unsigned j = 0; j < 16; ++j) { const unsigned c = xb_ld(&bar[XB_XCNT(j)]); sum += c; cnt += (c > 0u) ? 1u : 0u; mine = (j == x) ? c : mine; }
        if (sum == G) break;
        __builtin_amdgcn_s_sleep(1);
        if ((++sp & 255u) == 0u) { if (xb_ld(&bar[XB_TMO])) break; if (sp > XB_SPIN_CAP) { atomicAdd(&bar[XB_TMO], 1u); break; } }
    }
    nloc = mine > 0u ? mine : 1u; nx = cnt > 0u ? cnt : 1u;
}

__device__ __forceinline__ void xcd_barrier(const XcdBarrier& b) {
    asm volatile("s_waitcnt vmcnt(0)" ::: "memory");
    __syncthreads();
    if (threadIdx.x == 0) {
        unsigned* bar = b.bar;
        __builtin_amdgcn_s_waitcnt(0);
        unsigned nloc = b.st[0], nx = b.st[1];
        if (nloc == 0u) { xcd_barrier_complete(bar, b.x, nloc, nx); b.st[0] = nloc; b.st[1] = nx; }
        const unsigned old = xb_add(&bar[XB_XSUB(b.x)], 1u);
        const unsigned gen = old / nloc;
        if (old + 1u == (gen + 1u) * nloc) {
            __builtin_amdgcn_fence(__ATOMIC_RELEASE, "agent");
            asm volatile("s_waitcnt vmcnt(0)" ::: "memory");
            const unsigned og = xb_add(&bar[XB_TOP], 1u);
            const unsigned tg = og / nx;
            if (og + 1u == (tg + 1u) * nx) xb_add(&bar[XB_TOPGEN], 1u);
            else XB_SPIN(xb_ld(&bar[XB_TOPGEN]) == tg, bar);
            __builtin_amdgcn_fence(__ATOMIC_ACQUIRE, "agent");
            xb_add(&bar[XB_XGEN(b.x)], 1u);
            asm volatile("s_waitcnt vmcnt(0)" ::: "memory");
        } else {
            XB_SPIN(xb_ld(&bar[XB_XGEN(b.x)]) == gen, bar);
            __builtin_amdgcn_fence(__ATOMIC_ACQUIRE, "agent");
            asm volatile("s_waitcnt vmcnt(0)" ::: "memory");
        }
    }
    __syncthreads();
}

#define XB_SPIN_TIGHT(cond, bar) do { unsigned _sp = 0; while (cond) { \
    if ((++_sp & 255u) == 0u) { if (xb_ld(&(bar)[XB_TMO])) break; if (_sp > XB_SPIN_CAP) { atomicAdd(&(bar)[XB_TMO], 1u); break; } } } } while (0)
#define XB_MISMATCH 192
__device__ __forceinline__ void xcd_local_barrier(const XcdBarrier& b) {
    asm volatile("s_waitcnt vmcnt(0)" ::: "memory");
    __syncthreads();
    if (threadIdx.x == 0) {
        unsigned* bar = b.bar;
        __builtin_amdgcn_s_waitcnt(0);
        const unsigned nloc = b.st[0];
        const unsigned old = xb_add(&bar[XB_XSUB(b.x)], 1u);
        const unsigned gen = old / nloc;
        if (old + 1u == (gen + 1u) * nloc) xb_add(&bar[XB_XGEN(b.x)], 1u);
        else XB_SPIN_TIGHT(xb_ld(&bar[XB_XGEN(b.x)]) == gen, bar);
        __builtin_amdgcn_fence(__ATOMIC_ACQUIRE, "agent");
        asm volatile("s_waitcnt vmcnt(0)" ::: "memory");
    }
    __syncthreads();
}

__device__ __forceinline__ void xcd_barrier_arrive(const XcdBarrier& b) {
    asm volatile("s_waitcnt vmcnt(0)" ::: "memory");
    __syncthreads();
    if (threadIdx.x == 0) {
        unsigned* bar = b.bar;
        __builtin_amdgcn_s_waitcnt(0);
        unsigned nloc = b.st[0], nx = b.st[1];
        if (nloc == 0u) { xcd_barrier_complete(bar, b.x, nloc, nx); b.st[0] = nloc; b.st[1] = nx; }
        const unsigned old = xb_add(&bar[XB_XSUB(b.x)], 1u);
        const unsigned gen = old / nloc;
        if (old + 1u == (gen + 1u) * nloc) {
            __builtin_amdgcn_fence(__ATOMIC_RELEASE, "agent");
            asm volatile("s_waitcnt vmcnt(0)" ::: "memory");
            const unsigned og = xb_add(&bar[XB_TOP], 1u);
            const unsigned tg = og / nx;
            if (og + 1u == (tg + 1u) * nx) xb_add(&bar[XB_TOPGEN], 1u);
            xb_add(&bar[XB_XGEN(b.x)], 1u);
        } else {
            XB_SPIN_TIGHT(xb_ld(&bar[XB_XGEN(b.x)]) == gen, bar);
        }
        __builtin_amdgcn_fence(__ATOMIC_ACQUIRE, "agent");
        asm volatile("s_waitcnt vmcnt(0)" ::: "memory");
    }
    __syncthreads();
}
__device__ __forceinline__ void xcd_barrier_wait_top(const XcdBarrier& b, unsigned target) {
    if (threadIdx.x == 0) {
        unsigned* bar = b.bar;
        XB_SPIN_TIGHT(xb_ld(&bar[XB_TOPGEN]) < target, bar);
        __builtin_amdgcn_fence(__ATOMIC_ACQUIRE, "agent");
        asm volatile("s_waitcnt vmcnt(0)" ::: "memory");
    }
    __syncthreads();
}

constexpr size_t WS_BAR = 22 * MiB + 256 * 1024;
constexpr int LDS_ST_OFF = 147392;

__device__ __forceinline__ XcdBarrier mkbar(const Args& a, LAS unsigned char* lds) { XcdBarrier b; b.bar = (unsigned*)(a.ws + WS_BAR); b.x = xb_xcc_id(); b.st = (volatile LAS unsigned*)(lds + LDS_ST_OFF); return b; }

struct EpiFinal {
    static constexpr bool PERM = true, AFTER_DRAIN = true;
    const bf16* x1b; float* out; float* ss; const float* gfin; unsigned char* wsb; int fast;
    __device__ __forceinline__ void fused(const f32x4 (&acc)[2][2][4][2], const pg8::Unit& u, int wr, int wc, int fr, int fq, LAS unsigned char* lds, int wid, int lane) const {
        const int row0 = u.pm * 256 + wr * 64 + fr, col0 = u.pn * 256 + 32 * wc + 8 * fq;
        f32x4 v[2][4][2][2];
#pragma unroll
        for (int ai = 0; ai < 2; ++ai)
#pragma unroll
            for (int m = 0; m < 4; ++m) { const int row = row0 + ai * 128 + m * 16; float s = 0.f;
#pragma unroll
                for (int bj = 0; bj < 2; ++bj) { const size_t off = (size_t)row * 1024 + col0 + bj * 128;
                    const u32x4 r = *(const u32x4*)(x1b + off);
                    const f32x4 v0 = (f32x4){bflo(r.x), bfhi(r.x), bflo(r.y), bfhi(r.y)} + acc[ai][bj][m][0], v1 = (f32x4){bflo(r.z), bfhi(r.z), bflo(r.w), bfhi(r.w)} + acc[ai][bj][m][1];
                    v[ai][m][bj][0] = v0; v[ai][m][bj][1] = v1;
                    s += (v0.x * v0.x + v0.y * v0.y) + (v0.z * v0.z + v0.w * v0.w) + (v1.x * v1.x + v1.y * v1.y) + (v1.z * v1.z + v1.w * v1.w); }
                s = fq_sum(s);
                if (fq == 0) ss[(size_t)row * 16 + u.pn * 4 + wc] = s; }
        { XcdBarrier b; b.bar = (unsigned*)(wsb + WS_BAR); b.x = xb_xcc_id(); b.st = (volatile LAS unsigned*)(lds + LDS_ST_OFF); if (fast) xcd_local_barrier(b); else xcd_barrier(b); }
        f32x4 g[2][2];
#pragma unroll
        for (int bj = 0; bj < 2; ++bj) { g[bj][0] = *(const f32x4*)(gfin + col0 + bj * 128); g[bj][1] = *(const f32x4*)(gfin + col0 + bj * 128 + 4); }
#pragma unroll
        for (int ai = 0; ai < 2; ++ai)
#pragma unroll
            for (int m = 0; m < 4; ++m) { const int row = row0 + ai * 128 + m * 16;
                const float rs = 1.f / sqrtf(sum16(ss + (size_t)row * 16) * (1.f / DM) + EPS);
#pragma unroll
                for (int bj = 0; bj < 2; ++bj) { const size_t off = (size_t)row * 1024 + col0 + bj * 128;
                    *(f32x4*)(out + off) = v[ai][m][bj][0] * rs * g[bj][0]; *(f32x4*)(out + off + 4) = v[ai][m][bj][1] * rs * g[bj][1]; } }
    }
};

#ifndef PH
#define PH 0xFF
#endif
__global__ void __launch_bounds__(512, 2) fwd_megakernel(Args a) {
    extern __shared__ __attribute__((aligned(16))) unsigned char lds_raw[];
    LAS unsigned char* lds = (LAS unsigned char*)lds_raw;
    cg::grid_group grid = cg::this_grid();
    unsigned char* ws = a.ws;
    const int G = gridDim.x, bid = blockIdx.x;

    volatile LAS unsigned* st = (volatile LAS unsigned*)(lds + LDS_ST_OFF);
    unsigned* barw = (unsigned*)(ws + WS_BAR);
    if (threadIdx.x < 4) st[threadIdx.x] = 0u;
    __syncthreads();
    (void)xcd_barrier_post(barw, st);
    if (threadIdx.x == 0) atomicOr(barw + 64 + (bid & 7), 1u << xb_xcc_id());
    if (a.use_cg_sync) grid.sync();
#if (PH >> 0) & 1
    p0_prep<0>(a, lds);
#endif
    xcd_barrier_arrive(mkbar(a, lds));
#if (PH >> 0) & 1
    p0_prep<1>(a, lds);
#endif
    xcd_barrier_wait_top(mkbar(a, lds), 1u);
    bool fast = (G == 256);
#pragma unroll
    for (int g8 = 0; g8 < 8; ++g8) { const unsigned m = (unsigned)__builtin_amdgcn_readfirstlane((int)xb_ld(barw + 64 + g8)); fast = fast && (m != 0u) && ((m & (m - 1u)) == 0u); }
#ifdef PROBE_FAST
    if (!fast) return;
#endif
#define LOCAL_BAR() do { if (fast) xcd_local_barrier(mkbar(a, lds)); else xcd_barrier(mkbar(a, lds)); } while (0)
#ifdef DUP_BAR
#define GRID_BAR() do { xcd_barrier(mkbar(a, lds)); xcd_barrier(mkbar(a, lds)); } while (0)
#else
#define GRID_BAR() xcd_barrier(mkbar(a, lds))
#endif
#if (PH >> 1) & 1
    {
        pg8::Gemm g{(const bf16*)(ws + WS_XB), (const bf16*)(ws + WS_W0T), MTOK, 5120, 1024}; pg8::StaticOrder S; S.init(MTOK, 5120, G, bid);
        EpiIn0 E{(const float*)(ws + WS_R0), (bf16*)(ws + WS_UG), (bf16*)(ws + WS_GV), (bf16*)(ws + WS_BX), (bf16*)(ws + WS_BG), (float*)(ws + WS_VSS)};
        pg8::gemm_phase<EpiIn0, pg8::StaticOrder, true, true>(lds, g, S, E);
    }
#endif
    if (fast) xcd_barrier_arrive(mkbar(a, lds)); else xcd_barrier(mkbar(a, lds));
#if (PH >> 2) & 1
    {
        u32x4 pf[9];
        int tid_ = threadIdx.x; asm volatile("" : "+v"(tid_));
        int kind = 0, idx = bid;
        if (idx >= 512) kind = 2;
        issue_next(a, kind, idx, tid_, pf);
        while (kind < 2) {
            int nkind = kind, nidx = idx + G;
            if (nidx >= 512) { nkind = kind + 1; nidx = bid; }
            if (fast && kind == 0 && nkind == 1) xcd_barrier_wait_top(mkbar(a, lds), 2u);
            if (kind == 0) mixer_a_unit(a, lds, unit_tile(idx), unit_grp(idx), pf, nkind, nidx);
            else           mixer_b_unit(a, lds, unit_tile(idx), unit_grp(idx), pf, nkind, nidx);
            kind = nkind; idx = nidx;
        }
    }
#endif
    LOCAL_BAR();
#if (PH >> 3) & 1
    {
        pg8::Gemm g{(const bf16*)a.out, (const bf16*)(ws + WS_WO0T), MTOK, 1024, 2048}; pg8::StaticOrder S; S.init(MTOK, 1024, G, bid);
        typedef EpiRes<true, false, true> Epi3;
        Epi3 E{(const void*)(ws + WS_XB), nullptr, (bf16*)(ws + WS_XB), (float*)(ws + WS_SS1)};
        pg8::gemm_phase<Epi3, pg8::StaticOrder, true, true>(lds, g, S, E);
#ifdef DUP_G2
        pg8::gemm_phase<Epi3, pg8::StaticOrder, true, true>(lds, g, S, E);
#endif
    }
#endif
    LOCAL_BAR();
#if (PH >> 4) & 1
    {
        pg8::Gemm g{(const bf16*)(ws + WS_XB), (const bf16*)(ws + WS_W1T), MTOK, 2560, 1024}; pg8::StaticOrder S; S.init(MTOK, 2560, G, bid);
        EpiIn1 E{(const float*)(ws + WS_SS1), (const unsigned*)(ws + WS_ROPE), (bf16*)(ws + WS_Q), (bf16*)(ws + WS_K), (bf16*)(ws + WS_VT), (bf16*)(ws + WS_G)};
        pg8::gemm_phase<EpiIn1, pg8::StaticOrder, true, true>(lds, g, S, E);
#ifdef DUP_G3
        pg8::gemm_phase<EpiIn1, pg8::StaticOrder, true, true>(lds, g, S, E);
#endif
    }
#endif
    GRID_BAR();
#if (PH >> 5) & 1
#ifndef DUP_ATT
#define DUP_ATT 1
#endif
    {
        u32x4 kr[6], vr[6];
        int tid_ = threadIdx.x; asm volatile("" : "+v"(tid_));
        attn_issue(a, bid, tid_, kr, vr);
        for (int u = bid; u < 512; u += G) attn_unit(a, lds, unit_tile(u) >> 6, unit_tile(u) & 63, unit_grp(u), kr, vr, u + G);
    }
#endif
    LOCAL_BAR();
#if (PH >> 6) & 1
    if (G == 256) {
        pg8::Gemm g{(const bf16*)(ws + WS_Y1), (const bf16*)(ws + WS_WO1T), MTOK, 1024, 1024}; pg8::StaticOrder S; S.init(MTOK, 1024, G, bid);
        EpiFinal E{(const bf16*)(ws + WS_XB), a.out, (float*)(ws + WS_SS2), a.in[13], a.ws, fast ? 1 : 0};
        pg8::gemm_phase<EpiFinal, pg8::StaticOrder, false, true>(lds, g, S, E);
#ifdef DUP_G4
        pg8::gemm_phase<EpiFinal, pg8::StaticOrder, false, true>(lds, g, S, E);
#endif
    } else {
        {
            pg8::Gemm g{(const bf16*)(ws + WS_Y1), (const bf16*)(ws + WS_WO1T), MTOK, 1024, 1024}; pg8::StaticOrder S; S.init(MTOK, 1024, G, bid);
            typedef EpiRes<true, true, false> Epi6;
            Epi6 E{(const void*)(ws + WS_XB), a.out, nullptr, (float*)(ws + WS_SS2)};
            pg8::gemm_phase<Epi6, pg8::StaticOrder, true, true>(lds, g, S, E);
        }
        GRID_BAR();
        int tid_ = threadIdx.x; asm volatile("" : "+v"(tid_));
        const int tid = tid_, lane = tid & 63, wave = __builtin_amdgcn_readfirstlane(tid >> 6), gw = bid * 8 + wave, NGW = G * 8;
        const float* ss2 = (const float*)(ws + WS_SS2); const f32x4* fn = (const f32x4*)a.in[13] + lane;
        f32x4 gn[4];
#pragma unroll
        for (int j = 0; j < 4; ++j) gn[j] = fn[64 * j];
        for (int m = gw; m < MTOK; m += NGW) {
            const float rs = 1.f / sqrtf(sum16(ss2 + (size_t)m * 16) * (1.f / DM) + EPS);
            f32x4* xr = (f32x4*)(a.out + (size_t)m * DM) + lane;
#pragma unroll
            for (int j = 0; j < 4; ++j) xr[64 * j] = xr[64 * j] * rs * gn[j];
        }
    }
#endif
}

extern "C" void kernel_launch(void* const* d_in, const int* in_sizes, int n_in, void* d_out, int out_size, void* d_ws, size_t ws_size, hipStream_t stream) {
    static int grid = 0;
    if (grid == 0) {
        if (n_in != 14 || out_size != MTOK * DM || ws_size < WS_END) { fprintf(stderr, "kernel_launch: unexpected problem shape (n_in %d out %d ws %zu)\n", n_in, out_size, ws_size); grid = -1; return; }
        int dev = 0, cus = 0, per_cu = 0;
        hipGetDevice(&dev);
        hipDeviceGetAttribute(&cus, hipDeviceAttributeMultiprocessorCount, dev);
        if (hipFuncSetAttribute((const void*)fwd_megakernel, hipFuncAttributeMaxDynamicSharedMemorySize, LDS_BYTES) != hipSuccess) { fprintf(stderr, "kernel_launch: hipFuncSetAttribute failed\n"); grid = -1; return; }
        if (hipOccupancyMaxActiveBlocksPerMultiprocessor(&per_cu, (const void*)fwd_megakernel, 512, LDS_BYTES) != hipSuccess || per_cu < 1) { fprintf(stderr, "kernel_launch: occupancy query failed (%d)\n", per_cu); (void)hipGetLastError(); grid = -1; return; }
        grid = cus * per_cu;
    }
    if (grid < 0) return;
    if (hipMemsetAsync((char*)d_ws + WS_BAR, 0, XCD_BAR_WORDS * 4, stream) != hipSuccess) { fprintf(stderr, "kernel_launch: hipMemsetAsync failed\n"); return; }
    Args a{};
    for (int i = 0; i < 14; ++i) a.in[i] = (const float*)d_in[i];
    a.out = (float*)d_out; a.ws = (unsigned char*)d_ws;
    void* args[] = {&a};
    hipError_t e = hipLaunchCooperativeKernel((const void*)fwd_megakernel, dim3(grid), dim3(512), args, LDS_BYTES, stream);
    if (e != hipSuccess) fprintf(stderr, "kernel_launch: cooperative launch failed: %s (grid %d)\n", hipGetErrorString(e), grid);
}
```

```cpp
#include <hip/hip_runtime.h>
#include <hip/hip_cooperative_groups.h>
#include <cstdio>
#include <cstdint>
namespace cg = cooperative_groups;
namespace pg8 {
#define PG8_LAS __attribute__((address_space(3)))
typedef unsigned short bf16_t;
typedef short bf16x8 __attribute__((ext_vector_type(8)));
typedef float f32x4 __attribute__((ext_vector_type(4)));
typedef unsigned u32x4 __attribute__((ext_vector_type(4)));
constexpr int BM = 256, BK = 64, HALF = 128, HTB = HALF * BK * 2  , STAGE_BYTES = 8 * HTB, NXCD = 8, WGM = 8;

__host__ __device__ __forceinline__ int lds_byte(int r, int c) { const int st = (r >> 4) * 2 + (c >> 5), rr = r & 15, cc = c & 31, ob = rr * 64 + cc * 2; return st * 1024 + (ob ^ (((ob >> 9) & 1) << 5)); }
__host__ __device__ __forceinline__ void stage_rc(int b, int& R, int& C) { const int st = b / 1024, sb = b % 1024, swz = sb ^ (((sb >> 9) & 1) << 5); R = (st >> 1) * 16 + swz / 64; C = (st & 1) * 32 + (swz % 64) / 2; }
__host__ __device__ __forceinline__ int perm32(int rho) { const int n = rho >> 4, i = rho & 15; return 8 * (i >> 2) + 4 * n + (i & 3); }

struct Unit { int pm, pn; };
struct Gemm { const bf16_t* A; const bf16_t* Bt; int M, N, K; };

struct StaticOrder {
    int nM, nN, nwg, G, c;
    __host__ __device__ void init(int M, int N, int G_, int c_) { nM = M / BM; nN = N / BM; nwg = nM * nN; G = G_; c = c_; }
    __host__ __device__ bool next(int i, Unit& u) const {
        const long L = (long)i * G + c; if (L >= nwg) return false;
        int wgid = (int)L; { const int q = nwg / NXCD, r = nwg % NXCD, xcd = wgid % NXCD, off = wgid / NXCD; wgid = (xcd < r ? xcd * (q + 1) : r * (q + 1) + (xcd - r) * q) + off; }
        const int nig = WGM * nN, gid = wgid / nig, fm = gid * WGM, gsz = (nM - fm) < WGM ? (nM - fm) : WGM;
        u.pm = fm + ((wgid % nig) % gsz); u.pn = (wgid % nig) / gsz; return true;
    }
    __device__ __forceinline__ void a_ready(const Unit&) const {}
    __device__ __forceinline__ void done(const Unit&) const {}
};

__device__ __forceinline__ unsigned cvt_pk_bf16(float lo, float hi) { unsigned r; asm volatile("v_cvt_pk_bf16_f32 %0, %1, %2" : "=v"(r) : "v"(lo), "v"(hi)); return r; }
template <class Epi, class Sched, bool ALIGN_EPI = false, bool SP2 = false>
__device__ __forceinline__ void gemm_phase(PG8_LAS unsigned char* lds, const Gemm g, const Sched& S, const Epi& E) {
    int tid_ = threadIdx.x; asm volatile("" : "+v"(tid_));
    const int tid = tid_, wid = __builtin_amdgcn_readfirstlane(tid >> 6), lane = tid & 63, wr = wid >> 2, wc = wid & 3, fr = lane & 15, fq = lane >> 4;
    const int K = g.K, nt = K / BK;
    unsigned voffA[2], voffB[2];
#pragma unroll
    for (int i = 0; i < 2; ++i) { int R, C; stage_rc(tid * 16 + i * 8192, R, C); const int Rb = Epi::PERM ? ((R & ~31) + perm32(R & 31)) : R;
        voffA[i] = (unsigned)(R * K + C) * 2u; voffB[i] = (unsigned)(Rb * K + C) * 2u; }
    const size_t kstep = (size_t)(BK * 2);
    const size_t hstep = (size_t)HALF * K * 2;
    const size_t tstep = 2 * hstep;
    const unsigned ldsw = (unsigned)wid * 1024u;
    const int aoff = lds_byte(wr * 64 + fr, fq * 8), boff = lds_byte(wc * 32 + fr, fq * 8);
#define PG8_SA(b, h) (((b) * 2 + (h)) * HTB)
#define PG8_SB(b, h) ((4 + (b) * 2 + (h)) * HTB)
#define PG8_STAGE(bufoff, gbase, voff) do { _Pragma("unroll") for (int _i = 0; _i < 2; ++_i) \
        __builtin_amdgcn_global_load_lds((const unsigned*)((const char*)(gbase) + (voff)[_i]), (PG8_LAS unsigned*)(lds + (bufoff) + ldsw + _i * 8192), 16, 0, 0); } while (0)
#define PG8_LDA(dst, b, h) do { _Pragma("unroll") for (int m = 0; m < 4; ++m) _Pragma("unroll") for (int k = 0; k < 2; ++k) dst[m][k] = *(const PG8_LAS bf16x8*)(lds + PG8_SA(b, h) + aoff + m * 2048 + k * 1024); } while (0)
#define PG8_LDB(dst, b, h) do { _Pragma("unroll") for (int n = 0; n < 2; ++n) _Pragma("unroll") for (int k = 0; k < 2; ++k) dst[n][k] = *(const PG8_LAS bf16x8*)(lds + PG8_SB(b, h) + boff + n * 2048 + k * 1024); } while (0)
#define PG8_MMA(ai, bj, At, Bt) do { __builtin_amdgcn_s_setprio(1); _Pragma("unroll") for (int m = 0; m < 4; ++m) _Pragma("unroll") for (int n = 0; n < 2; ++n) _Pragma("unroll") for (int k = 0; k < 2; ++k) \
        acc[ai][bj][m][n] = __builtin_amdgcn_mfma_f32_16x16x32_bf16(Bt[n][k], At[m][k], acc[ai][bj][m][n], 0, 0, 0); __builtin_amdgcn_s_setprio(0); } while (0)
#define PG8_WAIT_V(n) asm volatile("s_waitcnt vmcnt(" #n ")" ::: "memory")
#define PG8_WAIT_L(n) asm volatile("s_waitcnt lgkmcnt(" #n ")" ::: "memory")
#define PG8_BAR __builtin_amdgcn_s_barrier()
#define PG8_SCHED __builtin_amdgcn_sched_barrier(0)
    Unit cur, nxt; int ui = 0;
    if (!S.next(0, cur)) return;
    f32x4 acc[2][2][4][2];
#pragma unroll
    for (int a = 0; a < 2; ++a)
#pragma unroll
        for (int b = 0; b < 2; ++b)
#pragma unroll
            for (int m = 0; m < 4; ++m)
#pragma unroll
                for (int n = 0; n < 2; ++n) acc[a][b][m][n] = (f32x4){0.f, 0.f, 0.f, 0.f};
    bf16x8 At[4][2], B0[2][2], B1[2][2];
    const char* cA = (const char*)g.A + (size_t)cur.pm * tstep; const char* cB = (const char*)g.Bt + (size_t)cur.pn * tstep;
    S.a_ready(cur);
    if constexpr (SP2) {
        PG8_STAGE(PG8_SB(0, 0), cB, voffB); PG8_STAGE(PG8_SB(0, 1), cB + hstep, voffB); PG8_STAGE(PG8_SA(0, 0), cA, voffA); PG8_STAGE(PG8_SA(0, 1), cA + hstep, voffA);
        if (wr == 1) PG8_BAR;
        PG8_WAIT_V(2); PG8_BAR;
        PG8_STAGE(PG8_SB(1, 0), cB + kstep, voffB); PG8_STAGE(PG8_SA(1, 0), cA + kstep, voffA); PG8_STAGE(PG8_SB(1, 1), cB + hstep + kstep, voffB);
        PG8_WAIT_V(6); PG8_BAR;
    } else {
        PG8_STAGE(PG8_SB(0, 0), cB, voffB); PG8_STAGE(PG8_SA(0, 0), cA, voffA); PG8_STAGE(PG8_SB(0, 1), cB + hstep, voffB); PG8_STAGE(PG8_SA(0, 1), cA + hstep, voffA);
        if (wr == 1) PG8_BAR;
        PG8_WAIT_V(4); PG8_BAR;
        PG8_STAGE(PG8_SB(1, 0), cB + kstep, voffB); PG8_STAGE(PG8_SA(1, 0), cA + kstep, voffA); PG8_STAGE(PG8_SB(1, 1), cB + hstep + kstep, voffB);
        PG8_WAIT_V(6); PG8_BAR;
    }
    for (;;) {
        const bool has_next = S.next(ui + 1, nxt);
        const char* nA = has_next ? (const char*)g.A + (size_t)nxt.pm * tstep : cA; const char* nB = has_next ? (const char*)g.Bt + (size_t)nxt.pn * tstep : cB;
        for (int t = 0; t < nt; t += 2) {
            const bool last = (t == nt - 2);
            const char* a1 = cA + (size_t)(t + 1) * kstep;
            const char* a2 = last ? nA : cA + (size_t)(t + 2) * kstep; const char* b2 = last ? nB : cB + (size_t)(t + 2) * kstep;
            const char* a3 = a2 + kstep; const char* b3 = b2 + kstep;
            if (last && has_next) S.a_ready(nxt);
            if constexpr (SP2) {
            PG8_LDB(B0, 0, 0); PG8_LDB(B1, 0, 1); PG8_SCHED; PG8_LDA(At, 0, 0); PG8_STAGE(PG8_SA(1, 1), a1 + hstep, voffA);
            PG8_WAIT_V(8); PG8_WAIT_L(0); PG8_BAR; PG8_MMA(0, 0, At, B0); PG8_MMA(0, 1, At, B1); PG8_BAR; PG8_SCHED;
            PG8_LDA(At, 0, 1); PG8_STAGE(PG8_SB(0, 0), b2, voffB); PG8_STAGE(PG8_SB(0, 1), b2 + hstep, voffB); PG8_STAGE(PG8_SA(0, 0), a2, voffA);
            PG8_WAIT_V(8); PG8_WAIT_L(0); PG8_BAR; PG8_MMA(1, 0, At, B0); PG8_MMA(1, 1, At, B1); PG8_BAR; PG8_SCHED;
            PG8_LDB(B0, 1, 0); PG8_LDB(B1, 1, 1); PG8_SCHED; PG8_LDA(At, 1, 0); PG8_STAGE(PG8_SA(0, 1), a2 + hstep, voffA);
            PG8_WAIT_V(8); PG8_WAIT_L(0); PG8_BAR; PG8_MMA(0, 0, At, B0); PG8_MMA(0, 1, At, B1); PG8_BAR; PG8_SCHED;
            PG8_LDA(At, 1, 1); PG8_STAGE(PG8_SB(1, 0), b3, voffB); PG8_STAGE(PG8_SB(1, 1), b3 + hstep, voffB); PG8_STAGE(PG8_SA(1, 0), a3, voffA);
            PG8_WAIT_V(8); PG8_WAIT_L(0); PG8_BAR; PG8_MMA(1, 0, At, B0); PG8_MMA(1, 1, At, B1); PG8_BAR; PG8_SCHED;
            } else {
            PG8_LDB(B0, 0, 0); PG8_SCHED; PG8_LDA(At, 0, 0); PG8_STAGE(PG8_SA(1, 1), a1 + hstep, voffA);
            PG8_WAIT_L(8); PG8_BAR; PG8_WAIT_L(0); PG8_MMA(0, 0, At, B0); PG8_BAR; PG8_SCHED;
            PG8_LDB(B1, 0, 1); PG8_STAGE(PG8_SB(0, 0), b2, voffB);
            PG8_BAR; PG8_WAIT_L(0); PG8_MMA(0, 1, At, B1); PG8_BAR;
            PG8_LDA(At, 0, 1); PG8_STAGE(PG8_SA(0, 0), a2, voffA);
            PG8_BAR; PG8_WAIT_L(0); PG8_MMA(1, 0, At, B0); PG8_BAR; PG8_SCHED;
            PG8_STAGE(PG8_SB(0, 1), b2 + hstep, voffB);
            PG8_WAIT_V(6); PG8_BAR; PG8_MMA(1, 1, At, B1); PG8_BAR;
            PG8_LDB(B0, 1, 0); PG8_SCHED; PG8_LDA(At, 1, 0); PG8_STAGE(PG8_SA(0, 1), a2 + hstep, voffA);
            PG8_WAIT_L(8); PG8_BAR; PG8_WAIT_L(0); PG8_MMA(0, 0, At, B0); PG8_BAR; PG8_SCHED;
            PG8_LDB(B1, 1, 1); PG8_STAGE(PG8_SB(1, 0), b3, voffB);
            PG8_BAR; PG8_WAIT_L(0); PG8_MMA(0, 1, At, B1); PG8_BAR;
            PG8_LDA(At, 1, 1); PG8_STAGE(PG8_SA(1, 0), a3, voffA);
            PG8_BAR; PG8_WAIT_L(0); PG8_MMA(1, 0, At, B0); PG8_BAR; PG8_SCHED;
            PG8_STAGE(PG8_SB(1, 1), b3 + hstep, voffB);
            PG8_WAIT_V(6); PG8_BAR; PG8_MMA(1, 1, At, B1); PG8_BAR;
            }
        }
        if constexpr (ALIGN_EPI) { if (wr == 0) PG8_BAR; }
        if constexpr (!Epi::AFTER_DRAIN) { E(acc, cur, wr, wc, fr, fq); S.done(cur); }
        if (!has_next) break;
#pragma unroll
        for (int a = 0; a < 2; ++a)
#pragma unroll
            for (int b = 0; b < 2; ++b)
#pragma unroll
                for (int m = 0; m < 4; ++m)
#pragma unroll
                    for (int n = 0; n < 2; ++n) acc[a][b][m][n] = (f32x4){0.f, 0.f, 0.f, 0.f};
        cur = nxt; cA = nA; cB = nB; ++ui;
        if constexpr (ALIGN_EPI) { if (wr == 1) PG8_BAR; }
    }
    PG8_WAIT_V(0);
    if constexpr (!ALIGN_EPI) { if (wr == 0) PG8_BAR; }
    PG8_BAR;
    if constexpr (Epi::AFTER_DRAIN) { E.fused(acc, cur, wr, wc, fr, fq, lds, wid, lane); S.done(cur); }
#undef PG8_SA
#undef PG8_SB
#undef PG8_STAGE
#undef PG8_LDA
#undef PG8_LDB
#undef PG8_MMA
#undef PG8_WAIT_V
#undef PG8_WAIT_L
#undef PG8_BAR
#undef PG8_SCHED
}
}

#define LAS __attribute__((address_space(3)))
typedef unsigned short bf16;
typedef float f32x4 __attribute__((ext_vector_type(4)));
typedef float f32x2 __attribute__((ext_vector_type(2)));
typedef unsigned u32x4 __attribute__((ext_vector_type(4)));
typedef unsigned u32x2 __attribute__((ext_vector_type(2)));
typedef short bf16x8 __attribute__((ext_vector_type(8)));
typedef short s16x4 __attribute__((ext_vector_type(4)));

constexpr int SEQ = 8192, DM = 1024, MTOK = 16384;
constexpr int LDS_BYTES = 147456;
constexpr float EPS = 1e-6f;
constexpr float LOG2E = 1.4426950408889634f;
constexpr float QSCALE = 0.125f * LOG2E;

constexpr size_t MiB = 1u << 20;
constexpr size_t WS_W0T  = 0;
constexpr size_t WS_WO0T = 10 * MiB;
constexpr size_t WS_W1T  = 14 * MiB;
constexpr size_t WS_WO1T = 19 * MiB;
constexpr size_t WS_WGT  = 21 * MiB;
constexpr size_t WS_ROPE = 21 * MiB + 512 * 1024;
constexpr size_t WS_R0   = 22 * MiB;
constexpr size_t WS_VSS  = 23 * MiB;
constexpr size_t WS_SS1  = 24 * MiB;
constexpr size_t WS_SS2  = 25 * MiB;
constexpr size_t WS_XB   = 26 * MiB;
constexpr size_t WS_Z    = 58 * MiB;
constexpr size_t WS_UG = WS_Z, WS_GV = WS_Z + 32 * MiB, WS_BX = WS_Z + 64 * MiB, WS_BG = WS_Z + 96 * MiB;
constexpr size_t WS_Q  = WS_Z;
constexpr size_t WS_G  = WS_Z + 32 * MiB;
constexpr size_t WS_Y1 = WS_Z + 64 * MiB;
constexpr size_t WS_K  = WS_Z + 128 * MiB;
constexpr size_t WS_VT = WS_Z + 136 * MiB;
constexpr size_t WS_END = WS_Z + 144 * MiB;

__device__ __forceinline__ unsigned cvtpk(float lo, float hi) { return pg8::cvt_pk_bf16(lo, hi); }
__device__ __forceinline__ float bflo(unsigned u) { return __builtin_bit_cast(float, u << 16); }
__device__ __forceinline__ float bfhi(unsigned u) { return __builtin_bit_cast(float, u & 0xffff0000u); }
__device__ __forceinline__ float fast_exp2(float x) { return __builtin_amdgcn_exp2f(x); }
__device__ __forceinline__ float fast_rcp(float x) { return __builtin_amdgcn_rcpf(x); }
__device__ __forceinline__ float silu_f(float x) { return x * fast_rcp(1.f + fast_exp2(-x * LOG2E)); }
__device__ __forceinline__ float gelu_f(float x) { const float t = x * (1.f + 0.044715f * x * x) * (-1.5957691216057308f * LOG2E); return x * fast_rcp(1.f + fast_exp2(t)); }
__device__ __forceinline__ f32x2 exp2_2(f32x2 v) { return (f32x2){fast_exp2(v.x), fast_exp2(v.y)}; }
__device__ __forceinline__ f32x2 rcp_2(f32x2 v) { return (f32x2){fast_rcp(v.x), fast_rcp(v.y)}; }
__device__ __forceinline__ f32x2 min_2(f32x2 v, float m) { return (f32x2){fminf(v.x, m), fminf(v.y, m)}; }
constexpr float GC1 = -1.5957691216057308f * LOG2E, GC2 = 0.044715f;
__device__ __forceinline__ f32x2 gelu_arg(f32x2 u) { return min_2((u * u * (GC1 * GC2) + GC1) * u, 126.f); }
__device__ __forceinline__ f32x2 gelu_2(f32x2 u) { return u * rcp_2(exp2_2(gelu_arg(u)) + 1.f); }
__device__ __forceinline__ f32x2 silu_2(f32x2 g) { return g * rcp_2(exp2_2(min_2(g * (-LOG2E), 126.f)) + 1.f); }
__device__ __forceinline__ f32x2 gelu_silu_2(f32x2 u, f32x2 g) {
    const f32x2 e1 = exp2_2(gelu_arg(u)), e2 = exp2_2(min_2(g * (-LOG2E), 126.f));
    const f32x2 d = e1 + 1.f, d2 = e2 * d + d;
    return (u * g) * rcp_2(d2);
}
__device__ __forceinline__ void swap16(float v, float& a, float& b) { const auto r = __builtin_amdgcn_permlane16_swap(__builtin_bit_cast(unsigned, v), __builtin_bit_cast(unsigned, v), false, false); a = __builtin_bit_cast(float, (unsigned)r[0]); b = __builtin_bit_cast(float, (unsigned)r[1]); }
__device__ __forceinline__ void swap32(float v, float& a, float& b) { const auto r = __builtin_amdgcn_permlane32_swap(__builtin_bit_cast(unsigned, v), __builtin_bit_cast(unsigned, v), false, false); a = __builtin_bit_cast(float, (unsigned)r[0]); b = __builtin_bit_cast(float, (unsigned)r[1]); }
__device__ __forceinline__ float max2f(float a, float b) { float r; asm("v_max_f32_e32 %0, %1, %2" : "=v"(r) : "v"(a), "v"(b)); return r; }
__device__ __forceinline__ float fq_sum(float v) { float a, b; swap16(v, a, b); v = a + b; swap32(v, a, b); return a + b; }
__device__ __forceinline__ float fq_max(float v) { float a, b; swap16(v, a, b); v = max2f(a, b); swap32(v, a, b); return max2f(a, b); }
__device__ __forceinline__ float wave_sum(float v) {
#pragma unroll
    for (int o = 1; o < 64; o <<= 1) v += __shfl_xor(v, o);
    return v;
}
__device__ __forceinline__ float sum16(const float* p) {
    const f32x4 a = *(const f32x4*)p, b = *(const f32x4*)(p + 4), c = *(const f32x4*)(p + 8), d = *(const f32x4*)(p + 12);
    return ((a.x + a.y) + (a.z + a.w)) + ((b.x + b.y) + (b.z + b.w)) + (((c.x + c.y) + (c.z + c.w)) + ((d.x + d.y) + (d.z + d.w)));
}
#define LDS_WAIT() asm volatile("s_waitcnt lgkmcnt(0)" ::: "memory")

struct Args {
    const float* in[14];
    float* out; unsigned char* ws;
    int use_cg_sync, pad;
};

__device__ __forceinline__ void transpose_item(const float* __restrict__ W, int K, int N, bf16* __restrict__ WT, const float* __restrict__ g, int k0, int dst_n0, int src_n0, bool permqk, LAS float* scr, int lane) {
    float wv[32];
#pragma unroll
    for (int i = 0; i < 32; ++i) { const int kk = 2 * i + (lane >> 5); wv[i] = __builtin_nontemporal_load(W + (size_t)(k0 + kk) * N + src_n0 + (lane & 31)); }
    if (g) {
#pragma unroll
        for (int i = 0; i < 32; ++i) wv[i] *= g[k0 + 2 * i + (lane >> 5)];
    }
#pragma unroll
    for (int i = 0; i < 32; ++i) scr[(2 * i + (lane >> 5)) * 33 + (lane & 31)] = wv[i];
    LDS_WAIT(); asm volatile("" ::: "memory");
    const int c = lane & 7;
#pragma unroll
    for (int j = 0; j < 4; ++j) { const int n = (lane >> 3) + 8 * j; int ns = n;
        if (permqk && n < 16) ns = (n & 3) | ((n & 4) << 1) | ((n & 8) >> 1);
        const LAS float* s = scr + (8 * c) * 33 + ns;
        u32x4 o; o.x = cvtpk(s[0 * 33], s[1 * 33]); o.y = cvtpk(s[2 * 33], s[3 * 33]); o.z = cvtpk(s[4 * 33], s[5 * 33]); o.w = cvtpk(s[6 * 33], s[7 * 33]);
        *(u32x4*)(WT + (size_t)(dst_n0 + n) * K + k0 + 8 * c) = o; }
    LDS_WAIT(); asm volatile("" ::: "memory");
}

template <int PART>
__device__ __forceinline__ void p0_prep(const Args& a, LAS unsigned char* lds) {
    int tid_ = threadIdx.x; asm volatile("" : "+v"(tid_));
    const int tid = tid_, lane = tid & 63, wave = __builtin_amdgcn_readfirstlane(tid >> 6);
    const int G = gridDim.x, gw = blockIdx.x * 8 + wave, NGW = G * 8;
    LAS float* scr = (LAS float*)(lds + wave * 16384);
    unsigned char* ws = a.ws;
    const float* x = a.in[0];
    constexpr int I_W0 = 16 * 160, I_WO0 = 32 * 32, I_W1 = 16 * 80, I_WO1 = 16 * 32, I_WG = 4 * 4 * 8;
    constexpr int NITEMS = I_W0 + I_WO0 + I_W1 + I_WO1 + I_WG;
    for (int it = gw + (PART ? I_W0 : 0); it < (PART ? NITEMS : I_W0); it += NGW) {
        int r = it;
        if (r < I_W0) {
            const int kb = r / 160, nb = r % 160, n0 = nb * 32; int src;
            if (n0 < 2048) { const int pn = n0 >> 8, within = n0 & 255, bj = within >> 7, ch = 128 * pn + (within & 127); src = bj ? 2048 + ch : ch; }
            else if (n0 < 3072) src = 1024 + (n0 - 2048);
            else src = n0;
            transpose_item(a.in[2], 1024, 5120, (bf16*)(ws + WS_W0T), a.in[1], kb * 64, n0, src, false, scr, lane); continue; }
        r -= I_W0;
        if (r < I_WO0) { const int kb = r / 32, nb = r % 32; transpose_item(a.in[8], 2048, 1024, (bf16*)(ws + WS_WO0T), nullptr, kb * 64, nb * 32, nb * 32, false, scr, lane); continue; }
        r -= I_WO0;
        if (r < I_W1) { const int kb = r / 80, nb = r % 80, n0 = nb * 32; const bool pq = (n0 < 1280) && ((n0 & 63) == 0);
            transpose_item(a.in[10], 1024, 2560, (bf16*)(ws + WS_W1T), a.in[9], kb * 64, n0, n0, pq, scr, lane); continue; }
        r -= I_W1;
        if (r < I_WO1) { const int kb = r / 32, nb = r % 32; transpose_item(a.in[12], 1024, 1024, (bf16*)(ws + WS_WO1T), nullptr, kb * 64, nb * 32, nb * 32, false, scr, lane); continue; }
        r -= I_WO1;
        { const int gi = r / 32, rr = r % 32, kb = rr / 8, nb = rr % 8;
          transpose_item(a.in[6] + (size_t)gi * 65536, 256, 256, (bf16*)(ws + WS_WGT) + (size_t)gi * 65536, nullptr, kb * 64, nb * 32, nb * 32, false, scr, lane); }
    }
    if (PART == 0) {
        bf16* XB = (bf16*)(ws + WS_XB); float* R0 = (float*)(ws + WS_R0);
        const int rbase = (G == 256) ? 2048 * (blockIdx.x & 7) + (blockIdx.x >> 3) * 8 + wave : gw, rstride = (G == 256) ? 256 : NGW;
        for (int m0 = rbase; m0 < MTOK && (m0 - rbase) < 8 * rstride * ((G == 256) ? 1 : 1024); m0 += 4 * rstride) {
            f32x4 v[4][4];
#pragma unroll
            for (int r = 0; r < 4; ++r) { const int m = min(m0 + r * rstride, MTOK - 1); const f32x4* xr = (const f32x4*)(x + (size_t)m * DM) + lane;
#pragma unroll
                for (int j = 0; j < 4; ++j) v[r][j] = __builtin_nontemporal_load(xr + 64 * j); }
#pragma unroll
            for (int r = 0; r < 4; ++r) { const int m = m0 + r * rstride; float s = 0.f;
#pragma unroll
                for (int j = 0; j < 4; ++j) s += (v[r][j].x * v[r][j].x + v[r][j].y * v[r][j].y) + (v[r][j].z * v[r][j].z + v[r][j].w * v[r][j].w);
                s = wave_sum(s);
                if (m < MTOK) {
                    u32x2* o = (u32x2*)(XB + (size_t)m * DM) + lane;
#pragma unroll
                    for (int j = 0; j < 4; ++j) { u32x2 w; w.x = cvtpk(v[r][j].x, v[r][j].y); w.y = cvtpk(v[r][j].z, v[r][j].w); o[64 * j] = w; }
                    if (lane == 0) R0[m] = 1.f / sqrtf(s * (1.f / DM) + EPS);
                } }
        }
    }
    if (PART == 1) {
        unsigned* T = (unsigned*)(ws + WS_ROPE);
        for (int e = blockIdx.x * 512 + tid; e < SEQ * 8; e += G * 512) {
            const int pos = e >> 3, i = e & 7;
            const float inv = (float)exp2(-(double)i * (18.931568569324174 / 8.0));
            const float ang = (float)pos * inv;
            const double rev = (double)ang * 0.15915494309189535; const double fr = rev - rint(rev);
            const float rf = (float)fr;
            T[e] = (unsigned)__builtin_bit_cast(unsigned short, (_Float16)__builtin_amdgcn_cosf(rf)) | ((unsigned)__builtin_bit_cast(unsigned short, (_Float16)__builtin_amdgcn_sinf(rf)) << 16);
        }
    }
}

#define EPI_ARGS const f32x4 (&acc)[2][2][4][2], const pg8::Unit& u, int wr, int wc, int fr, int fq


struct EpiIn0 {
    static constexpr bool PERM = true, AFTER_DRAIN = false;
    const float* r0; bf16 *UG, *GV, *BX, *BG; float* vss;
    __device__ __forceinline__ void operator()(EPI_ARGS) const {
        const int row0 = u.pm * 256 + wr * 64 + fr, pn = u.pn;
        float rs8[2][4];
#pragma unroll
        for (int ai = 0; ai < 2; ++ai)
#pragma unroll
            for (int m = 0; m < 4; ++m) rs8[ai][m] = r0[row0 + ai * 128 + m * 16];
        if (pn < 8) {
            const int col = 128 * pn + 32 * wc + 8 * fq;
#pragma unroll
            for (int ai = 0; ai < 2; ++ai)
#pragma unroll
                for (int m = 0; m < 4; ++m) { const int row = row0 + ai * 128 + m * 16; const float rs = rs8[ai][m];
                    u32x4 w;
#pragma unroll
                    for (int n = 0; n < 2; ++n) { const f32x4 au = acc[ai][0][m][n] * rs, ag = acc[ai][1][m][n] * rs;
                        const f32x2 o0 = gelu_silu_2((f32x2){au.x, au.y}, (f32x2){ag.x, ag.y}), o1 = gelu_silu_2((f32x2){au.z, au.w}, (f32x2){ag.z, ag.w});
                        w[2 * n] = cvtpk(o0.x, o0.y); w[2 * n + 1] = cvtpk(o1.x, o1.y); }
                    *(u32x4*)(UG + (size_t)row * 1024 + col) = w; }
        } else if (pn < 12) {
            const int col = 256 * (pn - 8) + 32 * wc + 8 * fq;
#pragma unroll
            for (int ai = 0; ai < 2; ++ai)
#pragma unroll
                for (int m = 0; m < 4; ++m) { const int row = row0 + ai * 128 + m * 16; const float rs = rs8[ai][m]; float ss = 0.f;
#pragma unroll
                    for (int bj = 0; bj < 2; ++bj) { u32x4 w;
#pragma unroll
                        for (int n = 0; n < 2; ++n) { const f32x4 av = acc[ai][bj][m][n] * rs;
                            const f32x2 o0 = gelu_2((f32x2){av.x, av.y}), o1 = gelu_2((f32x2){av.z, av.w});
                            const f32x2 q = o0 * o0 + o1 * o1; ss += q.x + q.y;
                            w[2 * n] = cvtpk(o0.x, o0.y); w[2 * n + 1] = cvtpk(o1.x, o1.y); }
                        *(u32x4*)(GV + (size_t)row * 1024 + col + bj * 128) = w; }
                    ss = fq_sum(ss);
                    if (fq == 0) vss[(size_t)row * 16 + (pn - 8) * 4 + wc] = ss; }
        } else {
            const bool isg = pn >= 16; bf16* O = isg ? BG : BX;
            const int col = 256 * (pn - (isg ? 16 : 12)) + 32 * wc + 8 * fq;
#pragma unroll
            for (int ai = 0; ai < 2; ++ai)
#pragma unroll
                for (int m = 0; m < 4; ++m) { const int row = row0 + ai * 128 + m * 16; const float rs = rs8[ai][m];
#pragma unroll
                    for (int bj = 0; bj < 2; ++bj) { u32x4 w;
#pragma unroll
                        for (int n = 0; n < 2; ++n) { const f32x4 av = acc[ai][bj][m][n] * rs;
                            f32x2 o0 = (f32x2){av.x, av.y}, o1 = (f32x2){av.z, av.w};
                            if (isg) { o0 = silu_2(o0); o1 = silu_2(o1); }
                            w[2 * n] = cvtpk(o0.x, o0.y); w[2 * n + 1] = cvtpk(o1.x, o1.y); }
                        *(u32x4*)(O + (size_t)row * 1024 + col + bj * 128) = w; } }
        }
    }
};

template <bool XIN_BF16, bool OUT_F32, bool OUT_BF16>
struct EpiRes {
    static constexpr bool PERM = true, AFTER_DRAIN = false;
    const void* xin; float* xo; bf16* xb; float* ss;
    __device__ __forceinline__ void load_batch(f32x4 (&x)[2][2][2], int row0, int col0, int b) const {
#pragma unroll
        for (int mm = 0; mm < 2; ++mm)
#pragma unroll
            for (int bj = 0; bj < 2; ++bj) { const size_t off = (size_t)(row0 + (b >> 1) * 128 + (2 * (b & 1) + mm) * 16) * 1024 + col0 + bj * 128;
                if (XIN_BF16) { const u32x4 r = *(const u32x4*)((const bf16*)xin + off); x[mm][bj][0] = (f32x4){bflo(r.x), bfhi(r.x), bflo(r.y), bfhi(r.y)}; x[mm][bj][1] = (f32x4){bflo(r.z), bfhi(r.z), bflo(r.w), bfhi(r.w)}; }
                else { x[mm][bj][0] = *(const f32x4*)((const float*)xin + off); x[mm][bj][1] = *(const f32x4*)((const float*)xin + off + 4); } }
    }
    __device__ __forceinline__ void operator()(EPI_ARGS) const {
        const int row0 = u.pm * 256 + wr * 64 + fr, col0 = u.pn * 256 + 32 * wc + 8 * fq;
        f32x4 xa[2][2][2], xb2[2][2][2];
        load_batch(xa, row0, col0, 0);
#pragma unroll
        for (int b = 0; b < 4; ++b) {
            if (b + 1 < 4) { if (b & 1) load_batch(xa, row0, col0, b + 1); else load_batch(xb2, row0, col0, b + 1); }
            const int ai = b >> 1;
#pragma unroll
            for (int mm = 0; mm < 2; ++mm) { const int m = 2 * (b & 1) + mm, row = row0 + ai * 128 + m * 16; float s = 0.f;
#pragma unroll
                for (int bj = 0; bj < 2; ++bj) { const size_t off = (size_t)row * 1024 + col0 + bj * 128;
                    const f32x4 v0 = ((b & 1) ? xb2[mm][bj][0] : xa[mm][bj][0]) + acc[ai][bj][m][0], v1 = ((b & 1) ? xb2[mm][bj][1] : xa[mm][bj][1]) + acc[ai][bj][m][1];
                    if (OUT_F32) { *(f32x4*)(xo + off) = v0; *(f32x4*)(xo + off + 4) = v1; }
                    s += (v0.x * v0.x + v0.y * v0.y) + (v0.z * v0.z + v0.w * v0.w) + (v1.x * v1.x + v1.y * v1.y) + (v1.z * v1.z + v1.w * v1.w);
                    if (OUT_BF16) { u32x4 w; w.x = cvtpk(v0.x, v0.y); w.y = cvtpk(v0.z, v0.w); w.z = cvtpk(v1.x, v1.y); w.w = cvtpk(v1.z, v1.w); *(u32x4*)(xb + off) = w; } }
                s = fq_sum(s);
                if (fq == 0) ss[(size_t)row * 16 + u.pn * 4 + wc] = s; }
        }
    }
};

struct EpiIn1 {
    static constexpr bool PERM = true, AFTER_DRAIN = false;
    const float* ss1; const unsigned* rope; bf16 *Q, *K, *VT, *G;
    __device__ __forceinline__ void operator()(EPI_ARGS) const {
        const int row0 = u.pm * 256 + wr * 64 + fr, pn = u.pn;
        const bool dorope = (pn < 5) && ((wc & 1) == 0) && (fq < 2);
        float rs8[2][4];
        {
            f32x4 part[2][4];
#pragma unroll
            for (int ai = 0; ai < 2; ++ai)
#pragma unroll
                for (int m = 0; m < 4; ++m) part[ai][m] = *(const f32x4*)(ss1 + (size_t)(row0 + ai * 128 + m * 16) * 16 + 4 * fq);
#pragma unroll
            for (int ai = 0; ai < 2; ++ai)
#pragma unroll
                for (int m = 0; m < 4; ++m) { const f32x4 pq = part[ai][m]; rs8[ai][m] = 1.f / sqrtf(fq_sum((pq.x + pq.y) + (pq.z + pq.w)) * (1.f / DM) + EPS); }
        }
        u32x4 cst[2][4];
#pragma unroll
        for (int ai = 0; ai < 2; ++ai)
#pragma unroll
            for (int m = 0; m < 4; ++m) { cst[ai][m] = (u32x4){0x3c00u, 0x3c00u, 0x3c00u, 0x3c00u};
                if (dorope) cst[ai][m] = *(const u32x4*)(rope + (size_t)((row0 + ai * 128 + m * 16) & (SEQ - 1)) * 8 + 4 * fq); }
#pragma unroll
        for (int ai = 0; ai < 2; ++ai)
#pragma unroll
            for (int m = 0; m < 4; ++m) { const int row = row0 + ai * 128 + m * 16;
                const float rs = rs8[ai][m];
                const u32x4 ct = cst[ai][m];
#pragma unroll
                for (int bj = 0; bj < 2; ++bj) {
                    f32x4 z0 = acc[ai][bj][m][0] * rs, z1 = acc[ai][bj][m][1] * rs;
                    const int colt = 128 * bj + 32 * wc + 8 * fq;
                    if (pn < 5) {
                        if (dorope) {
                            float c[4], s[4];
#pragma unroll
                            for (int j = 0; j < 4; ++j) { c[j] = (float)__builtin_bit_cast(_Float16, (unsigned short)(ct[j] & 0xffffu)); s[j] = (float)__builtin_bit_cast(_Float16, (unsigned short)(ct[j] >> 16)); }
#pragma unroll
                            for (int j = 0; j < 4; ++j) { const float a1 = z0[j], a2 = z1[j]; z0[j] = a1 * c[j] - a2 * s[j]; z1[j] = a2 * c[j] + a1 * s[j]; }
                        }
                        if (pn < 4) { z0 = z0 * QSCALE; z1 = z1 * QSCALE; }
                        u32x4 w; w.x = cvtpk(z0.x, z0.y); w.y = cvtpk(z0.z, z0.w); w.z = cvtpk(z1.x, z1.y); w.w = cvtpk(z1.z, z1.w);
                        if (pn < 4) *(u32x4*)(Q + (size_t)row * 1024 + 256 * pn + colt) = w;
                        else        *(u32x4*)(K + (size_t)row * 256 + colt) = w;
                    } else if (pn == 5) {
                        u32x4 w; w.x = cvtpk(z0.x, z0.y); w.y = cvtpk(z0.z, z0.w); w.z = cvtpk(z1.x, z1.y); w.w = cvtpk(z1.z, z1.w);
                        *(u32x4*)(VT + (size_t)row * 256 + colt) = w;
                    } else {
                        const f32x2 s0 = silu_2((f32x2){z0.x, z0.y}), s1 = silu_2((f32x2){z0.z, z0.w}), s2 = silu_2((f32x2){z1.x, z1.y}), s3 = silu_2((f32x2){z1.z, z1.w});
                        u32x4 w; w.x = cvtpk(s0.x, s0.y); w.y = cvtpk(s1.x, s1.y); w.z = cvtpk(s2.x, s2.y); w.w = cvtpk(s3.x, s3.y);
                        *(u32x4*)(G + (size_t)row * 1024 + 256 * (pn - 6) + colt) = w;
                    }
                } }
    }
};

#define MFMA16(a, b, c) __builtin_amdgcn_mfma_f32_16x16x32_bf16((a), (b), (c), 0, 0, 0)

typedef short v4i16_t __attribute__((ext_vector_type(4)));
__device__ __forceinline__ float max3f(float a, float b, float c) { float r; asm("v_max3_f32 %0, %1, %2, %3" : "=v"(r) : "v"(a), "v"(b), "v"(c)); return r; }
__device__ __forceinline__ s16x4 trread(const LAS bf16* p) { return __builtin_bit_cast(s16x4, __builtin_amdgcn_ds_read_tr16_b64_v4i16((LAS v4i16_t*)p)); }
__device__ __forceinline__ bf16x8 cat8(s16x4 a, s16x4 b) { return __builtin_shufflevector(a, b, 0, 1, 2, 3, 4, 5, 6, 7); }

__device__ __forceinline__ int unit_tile(int u) { return 16 * (u & 7) + (u >> 5); }
__device__ __forceinline__ int unit_grp(int u) { return (u >> 3) & 3; }

__device__ __forceinline__ void issue_a(const Args& a, int c, int h, int tid, u32x4 (&pf)[9]) {
    const bf16* GV = (const bf16*)(a.ws + WS_GV);
#pragma unroll
    for (int it = 0; it < 8; ++it) { const int item = it * 512 + tid, cl = item & 31, j = item >> 5; pf[it] = *(const u32x4*)(GV + (size_t)(128 * c + j) * 1024 + 256 * h + 8 * cl); }
}
__device__ __forceinline__ void issue_b(const Args& a, int tt, int g, int tid, u32x4 (&pf)[9]) {
    const int b = tt >> 6, t0 = (tt & 63) * 128;
    const bf16* base = (const bf16*)(a.ws + WS_BX) + (size_t)b * SEQ * 1024 + 256 * g;
#pragma unroll
    for (int it = 0; it < 9; ++it) { const int item = it * 512 + tid, cl = item & 31, rr = item >> 5, pos = t0 - 8 + rr;
        pf[it] = (u32x4){0u, 0u, 0u, 0u};
        if (pos >= 0 && pos < SEQ) pf[it] = *(const u32x4*)(base + (size_t)pos * 1024 + 8 * cl); }
}
__device__ __forceinline__ void issue_next(const Args& a, int nkind, int nidx, int tid, u32x4 (&pf)[9]) {
    if (nkind == 0) issue_a(a, unit_tile(nidx), unit_grp(nidx), tid, pf); else if (nkind == 1) issue_b(a, unit_tile(nidx), unit_grp(nidx), tid, pf);
}

__device__ __forceinline__ void mixer_a_unit(const Args& a, LAS unsigned char* lds, int c, int h, u32x4 (&pf)[9], int nkind, int nidx) {
    int tid_ = threadIdx.x; asm volatile("" : "+v"(tid_));
    const int tid = tid_, lane = tid & 63, w = __builtin_amdgcn_readfirstlane(tid >> 6), fr = lane & 15, fq = lane >> 4;
    constexpr int VS2 = 264, WS_ = 136;
    LAS bf16* V = (LAS bf16*)lds;
    LAS bf16* Ws = (LAS bf16*)(lds + 67584);
    LAS float* rvs = (LAS float*)(lds + 67584 + 34816);
    const unsigned char* ws = a.ws;
    const bf16* UG = (const bf16*)(ws + WS_UG); const float* vss = (const float*)(ws + WS_VSS);
    bf16* Y0 = (bf16*)a.out;
    const float* wsp = a.in[4] + (size_t)h * 16384; const float* bsp = a.in[5] + h * 128; const float* gv = a.in[3];
    f32x4 wsr[8];
#pragma unroll
    for (int it = 0; it < 8; ++it) { const int item = it * 512 + tid, j4 = item & 31, i = item >> 5; wsr[it] = *(const f32x4*)(wsp + i * 128 + 4 * j4); }
    if (tid < 128) rvs[tid] = 1.f / sqrtf(sum16(vss + (size_t)(128 * c + tid) * 16) * (1.f / 1024.f) + EPS);
#pragma unroll
    for (int it = 0; it < 8; ++it) { const int item = it * 512 + tid, cl = item & 31, j = item >> 5; *(LAS u32x4*)(V + j * VS2 + 8 * cl) = pf[it]; }
    issue_next(a, nkind, nidx, tid, pf);
    __syncthreads();
#pragma unroll
    for (int it = 0; it < 8; ++it) { const int item = it * 512 + tid, j4 = item & 31, i = item >> 5;
        const f32x4 r = *(const LAS f32x4*)(rvs + 4 * j4); const f32x4 v = wsr[it];
        u32x2 o; o.x = cvtpk(v.x * r.x, v.y * r.y); o.y = cvtpk(v.z * r.z, v.w * r.w);
        *(LAS u32x2*)(Ws + i * WS_ + 4 * j4) = o; }
    u32x4 ugr[8];
#pragma unroll
    for (int it = 0; it < 8; ++it) ugr[it] = *(const u32x4*)(UG + (size_t)(128 * c + 16 * it + fr) * 1024 + 256 * h + 32 * w + 8 * fq);
    __syncthreads();
    f32x4 acc[2][8];
#pragma unroll
    for (int dt = 0; dt < 2; ++dt)
#pragma unroll
        for (int it = 0; it < 8; ++it) acc[dt][it] = (f32x4){0.f, 0.f, 0.f, 0.f};
    const LAS bf16* vb = V + (8 * fq + ((lane >> 2) & 3)) * VS2 + 32 * w + 8 * (lane & 3);
#pragma unroll
    for (int ks = 0; ks < 4; ++ks) {
        bf16x8 af[2], bfr[8];
#pragma unroll
        for (int dt = 0; dt < 2; ++dt) { const LAS bf16* p = vb + (32 * ks) * VS2 + 4 * dt; af[dt] = cat8(trread(p), trread(p + 4 * VS2)); }
#pragma unroll
        for (int it = 0; it < 8; ++it) bfr[it] = *(const LAS bf16x8*)(Ws + (16 * it + fr) * WS_ + 32 * ks + 8 * fq);
#pragma unroll
        for (int dt = 0; dt < 2; ++dt)
#pragma unroll
            for (int it = 0; it < 8; ++it) acc[dt][it] = MFMA16(af[dt], bfr[it], acc[dt][it]);
    }
    {   const int col = 256 * h + 32 * w + 8 * fq; const f32x4 g0 = *(const f32x4*)(gv + col), g1 = *(const f32x4*)(gv + col + 4);
#pragma unroll
        for (int it = 0; it < 8; ++it) { const int i = 16 * it + fr, row = 128 * c + i; const float bs = bsp[i];
            const u32x4 ug = ugr[it];
            const f32x4 m0 = acc[0][it] * g0 + bs, m1 = acc[1][it] * g1 + bs;
            u32x4 o; o.x = cvtpk(bflo(ug.x) * m0.x, bfhi(ug.x) * m0.y); o.y = cvtpk(bflo(ug.y) * m0.z, bfhi(ug.y) * m0.w); o.z = cvtpk(bflo(ug.z) * m1.x, bfhi(ug.z) * m1.y); o.w = cvtpk(bflo(ug.w) * m1.z, bfhi(ug.w) * m1.w);
            *(u32x4*)(Y0 + (size_t)row * 2048 + col) = o; } }
    __syncthreads();
}

__device__ __forceinline__ void mixer_b_unit(const Args& a, LAS unsigned char* lds, int tt, int g, u32x4 (&pf)[9], int nkind, int nidx) {
    int tid_ = threadIdx.x; asm volatile("" : "+v"(tid_));
    const int tid = tid_, lane = tid & 63, w = __builtin_amdgcn_readfirstlane(tid >> 6), fr = lane & 15, fq = lane >> 4;
    constexpr int PS = 264;
    LAS bf16* Bs = (LAS bf16*)lds;
    LAS bf16* P = (LAS bf16*)(lds + 76032);
    const unsigned char* ws = a.ws;
    const bf16* BG = (const bf16*)(ws + WS_BG); const bf16* WGT = (const bf16*)(ws + WS_WGT) + (size_t)g * 65536;
    bf16* Y0 = (bf16*)a.out; const float* bscale = a.in[7];
    const int b = tt >> 6, t0 = (tt & 63) * 128;
#pragma unroll
    for (int it = 0; it < 9; ++it) { const int item = it * 512 + tid, cl = item & 31, rr = item >> 5; *(LAS u32x4*)(Bs + rr * PS + 8 * cl) = pf[it]; }
    bf16x8 wf[8][2];
#pragma unroll
    for (int ks = 0; ks < 8; ++ks)
#pragma unroll
        for (int et = 0; et < 2; ++et) wf[ks][et] = *(const bf16x8*)(WGT + (size_t)(32 * w + 8 * (fr >> 2) + 4 * et + (fr & 3)) * 256 + 32 * ks + 8 * fq);
    u32x4 bgr[8];
#pragma unroll
    for (int it = 0; it < 8; ++it) bgr[it] = *(const u32x4*)(BG + (size_t)(128 * tt + 16 * it + fr) * 1024 + 256 * g + 32 * w + 8 * fq);
    __syncthreads();
    {
        const int cl = tid & 31, tr = tid >> 5, half = 1 << g;
        const LAS bf16* col = Bs + 8 * cl;
        float s[8];
#pragma unroll
        for (int e = 0; e < 8; ++e) s[e] = 0.f;
        for (int rr = 8 * tr + 8 - half; rr < 8 * tr + 8 + half; ++rr) { const u32x4 r = *(const LAS u32x4*)(col + rr * PS);
#pragma unroll
            for (int e = 0; e < 4; ++e) { s[2 * e] += bflo(r[e]); s[2 * e + 1] += bfhi(r[e]); } }
        for (int k = 0; k < 8; ++k) { const int tl = 8 * tr + k, t = t0 + tl; const int lo = max(t - half, 0), hi = min(t + half, SEQ); const float inv = 1.f / (float)(hi - lo);
            const u32x4 r = *(const LAS u32x4*)(col + (tl + 8) * PS);
            u32x4 o;
#pragma unroll
            for (int e = 0; e < 4; ++e) o[e] = cvtpk(s[2 * e] * inv - bflo(r[e]), s[2 * e + 1] * inv - bfhi(r[e]));
            *(LAS u32x4*)(P + tl * PS + 8 * cl) = o;
            const u32x4 qa = *(const LAS u32x4*)(col + (tl + 8 + half) * PS), qs = *(const LAS u32x4*)(col + (tl + 8 - half) * PS);
#pragma unroll
            for (int e = 0; e < 4; ++e) { s[2 * e] += bflo(qa[e]) - bflo(qs[e]); s[2 * e + 1] += bfhi(qa[e]) - bfhi(qs[e]); } }
    }
    __syncthreads();
    f32x4 acc[2][8];
#pragma unroll
    for (int et = 0; et < 2; ++et)
#pragma unroll
        for (int it = 0; it < 8; ++it) acc[et][it] = (f32x4){0.f, 0.f, 0.f, 0.f};
#pragma unroll
    for (int ks = 0; ks < 8; ++ks) {
        bf16x8 bfr[8];
#pragma unroll
        for (int it = 0; it < 8; ++it) bfr[it] = *(const LAS bf16x8*)(P + (16 * it + fr) * PS + 32 * ks + 8 * fq);
#pragma unroll
        for (int et = 0; et < 2; ++et)
#pragma unroll
            for (int it = 0; it < 8; ++it) acc[et][it] = MFMA16(wf[ks][et], bfr[it], acc[et][it]);
    }
    issue_next(a, nkind, nidx, tid, pf);
    {   const int col = 256 * g + 32 * w + 8 * fq; const f32x4 s0 = *(const f32x4*)(bscale + col), s1 = *(const f32x4*)(bscale + col + 4);
#pragma unroll
        for (int it = 0; it < 8; ++it) { const int row = 128 * tt + 16 * it + fr;
            const u32x4 bg = bgr[it];
            const f32x4 y0 = acc[0][it] * s0, y1 = acc[1][it] * s1;
            u32x4 o; o.x = cvtpk(bflo(bg.x) * y0.x, bfhi(bg.x) * y0.y); o.y = cvtpk(bflo(bg.y) * y0.z, bfhi(bg.y) * y0.w); o.z = cvtpk(bflo(bg.z) * y1.x, bfhi(bg.z) * y1.y); o.w = cvtpk(bflo(bg.w) * y1.z, bfhi(bg.w) * y1.w);
            *(u32x4*)(Y0 + (size_t)row * 2048 + 1024 + col) = o; } }
    __syncthreads();
}

__device__ __forceinline__ void attn_issue(const Args& a, int u, int tid, u32x4 (&kr)[6], u32x4 (&vr)[6]) {
    if (u >= 512) return;
    const int gq = unit_tile(u), b = gq >> 6, qb = gq & 63, kvh = unit_grp(u), kb0 = (qb - 1) * 128;
    const bf16* Kg = (const bf16*)(a.ws + WS_K); const bf16* Vg = (const bf16*)(a.ws + WS_VT);
#pragma unroll
    for (int it = 0; it < 6; ++it) { const int item = it * 512 + tid, ch = item & 7, key = item >> 3; const int pos = kb0 + key;
        kr[it] = (u32x4){0u, 0u, 0u, 0u}; vr[it] = (u32x4){0u, 0u, 0u, 0u};
        if (pos >= 0 && pos < SEQ) { const size_t off = (size_t)(b * SEQ + pos) * 256 + kvh * 64 + 8 * ch; kr[it] = *(const u32x4*)(Kg + off); vr[it] = *(const u32x4*)(Vg + off); } }
}
__device__ __forceinline__ void attn_unit(const Args& a, LAS unsigned char* lds, int b, int qb, int kvh, u32x4 (&kr)[6], u32x4 (&vr)[6], int unext) {
    int tid_ = threadIdx.x; asm volatile("" : "+v"(tid_));
    const int tid = tid_, lane = tid & 63, w = __builtin_amdgcn_readfirstlane(tid >> 6), fr = lane & 15, fq = lane >> 4;
    constexpr int KS = 72, VS = 80;
    LAS bf16* Ks = (LAS bf16*)lds;
    LAS bf16* Vs = (LAS bf16*)(lds + 55296);
    const unsigned char* ws = a.ws;
    const bf16* Qg = (const bf16*)(ws + WS_Q); const bf16* Gg = (const bf16*)(ws + WS_G);
    bf16* Y1 = (bf16*)(a.ws + WS_Y1);
    const int kb0 = (qb - 1) * 128;
    const int head = kvh * 4 + (w >> 1);
    const size_t qbase = (size_t)(b * SEQ + qb * 128 + (w & 1) * 64 + fr) * 1024 + head * 64;
#pragma unroll
    for (int it = 0; it < 6; ++it) { const int item = it * 512 + tid, ch = item & 7, key = item >> 3; *(LAS u32x4*)(Ks + key * KS + 8 * ch) = kr[it];
        const u32x4 v = vr[it]; *(LAS u32x4*)(Vs + key * VS + 8 * ch) = (key & 1) ? (u32x4){v.z, v.w, v.x, v.y} : v; }
    attn_issue(a, unext, tid, kr, vr);
    bf16x8 q0 = *(const bf16x8*)(Qg + qbase + 8 * fq), q1 = *(const bf16x8*)(Qg + qbase + 32 + 8 * fq);
    __syncthreads();
    const float sink2 = a.in[11][head] * LOG2E;
    const bool edge = (qb == 0) || (qb == SEQ / 128 - 1);
    const LAS bf16* vtb = Vs + (4 * fq + ((lane >> 2) & 3)) * VS + 8 * (lane & 3);
    const int vsw = 4 * ((lane >> 2) & 1);
    for (int it = 0; it < 4; ++it) {
        const int rowoff = (w & 1) * 64 + 16 * it;
        const size_t qoff = qbase + (size_t)(16 * it) * 1024;
        const u32x4 g0 = *(const u32x4*)(Gg + qoff + 8 * fq), g1 = *(const u32x4*)(Gg + qoff + 32 + 8 * fq);
        const bf16x8 qa = q0, qb2 = q1;
        if (it < 3) { q0 = *(const bf16x8*)(Qg + qoff + 16 * 1024 + 8 * fq); q1 = *(const bf16x8*)(Qg + qoff + 16 * 1024 + 32 + 8 * fq); }
        const int kt0 = (rowoff >> 4) & ~1;
        f32x4 S[18];
        const LAS bf16* kpb = Ks + (16 * kt0 + fr) * KS + 8 * fq;
#pragma unroll
        for (int j = 0; j < 18; ++j) { const LAS bf16* kp = kpb + j * (16 * KS);
            f32x4 s = {0.f, 0.f, 0.f, 0.f};
            s = MFMA16(*(const LAS bf16x8*)kp, qa, s); s = MFMA16(*(const LAS bf16x8*)(kp + 32), qb2, s); S[j] = s;
            }
        const int qpos = qb * 128 + rowoff + fr, kbase = kb0 + 16 * kt0 + 4 * fq;
        const int klo = max(qpos - 128, 0), khi = min(qpos + 128, SEQ - 1);
        int mbase = kbase - klo; const unsigned mspan = (unsigned)(khi - klo);
        asm volatile("" : "+v"(mbase));
#define ATT_MASK_TILE(j) do { _Pragma("unroll") for (int r = 0; r < 4; ++r) { const bool ok = (unsigned)(mbase + (16 * (j) + r)) <= mspan; S[j][r] = ok ? S[j][r] : -1e30f; } } while (0)
        if (edge) {
#pragma unroll
            for (int j = 0; j < 18; ++j) ATT_MASK_TILE(j);
        } else {
            ATT_MASK_TILE(0); ATT_MASK_TILE(1); ATT_MASK_TILE(16); ATT_MASK_TILE(17);
        }
#undef ATT_MASK_TILE
        float mx = sink2;
#pragma unroll
        for (int j = 0; j < 18; ++j) { mx = max3f(mx, S[j][0], S[j][1]); mx = max3f(mx, S[j][2], S[j][3]); }
        mx = fq_max(mx);
        f32x2 l2 = {0.f, 0.f};
#pragma unroll
        for (int j = 0; j < 18; ++j) { const f32x2 p0 = exp2_2((f32x2){S[j][0], S[j][1]} - mx), p1 = exp2_2((f32x2){S[j][2], S[j][3]} - mx);
            S[j] = (f32x4){p0.x, p0.y, p1.x, p1.y}; l2 += p0 + p1; }
        float l = l2.x + l2.y;
        l = fq_sum(l);
        l += fast_exp2(sink2 - mx);
        const float rl = 1.f / l;
        const LAS bf16* vpb = vtb + (16 * kt0) * VS;
        f32x4 O[4];
#pragma unroll
        for (int dt = 0; dt < 4; ++dt) O[dt] = (f32x4){0.f, 0.f, 0.f, 0.f};
#pragma unroll
        for (int jp = 0; jp < 9; ++jp) {
            u32x4 pw; pw.x = cvtpk(S[2 * jp][0], S[2 * jp][1]); pw.y = cvtpk(S[2 * jp][2], S[2 * jp][3]); pw.z = cvtpk(S[2 * jp + 1][0], S[2 * jp + 1][1]); pw.w = cvtpk(S[2 * jp + 1][2], S[2 * jp + 1][3]);
            const bf16x8 pf = __builtin_bit_cast(bf16x8, pw);
            const LAS bf16* vp = vpb + jp * (32 * VS);
#pragma unroll
            for (int dt = 0; dt < 4; ++dt) { const LAS bf16* p = vp + 32 * (dt >> 1) + ((dt & 1) ? 4 - vsw : vsw);
                O[dt] = MFMA16(cat8(trread(p), trread(p + 16 * VS)), pf, O[dt]); }
        }
        {
            const f32x4 a0 = O[0] * rl, a1 = O[1] * rl, a2 = O[2] * rl, a3 = O[3] * rl;
            u32x4 o0, o1;
            o0.x = cvtpk(a0.x * bflo(g0.x), a0.y * bfhi(g0.x)); o0.y = cvtpk(a0.z * bflo(g0.y), a0.w * bfhi(g0.y)); o0.z = cvtpk(a1.x * bflo(g0.z), a1.y * bfhi(g0.z)); o0.w = cvtpk(a1.z * bflo(g0.w), a1.w * bfhi(g0.w));
            o1.x = cvtpk(a2.x * bflo(g1.x), a2.y * bfhi(g1.x)); o1.y = cvtpk(a2.z * bflo(g1.y), a2.w * bfhi(g1.y)); o1.z = cvtpk(a3.x * bflo(g1.z), a3.y * bfhi(g1.z)); o1.w = cvtpk(a3.z * bflo(g1.w), a3.w * bfhi(g1.w));
            *(u32x4*)(Y1 + qoff + 8 * fq) = o0; *(u32x4*)(Y1 + qoff + 32 + 8 * fq) = o1;
        }
    }
    __syncthreads();
}

#define RLX_AGENT __ATOMIC_RELAXED, __HIP_MEMORY_SCOPE_AGENT
#define XB_TMO      128
#define XB_XCNT(j)  (256  + 64 * (j))
#define XB_XSUB(j)  (1280 + 64 * (j))
#define XB_XGEN(j)  (2304 + 64 * (j))
#define XB_TOP      3328
#define XB_TOPGEN   3392
#define XCD_BAR_WORDS 3456
#define XB_SPIN_CAP (1u << 18)

__device__ __forceinline__ unsigned xb_ld(unsigned* p)              { return __hip_atomic_load(p, __ATOMIC_RELAXED, __HIP_MEMORY_SCOPE_AGENT); }
__device__ __forceinline__ unsigned xb_add(unsigned* p, unsigned v) { return __hip_atomic_fetch_add(p, v, __ATOMIC_RELAXED, __HIP_MEMORY_SCOPE_AGENT); }
__device__ __forceinline__ unsigned xb_xcc_id() { return (unsigned)__builtin_amdgcn_s_getreg((3 << 11) | 20) & 0xFu; }
#define XB_SPIN(cond, bar) do { unsigned _sp = 0; while (cond) { __builtin_amdgcn_s_sleep(1); \
    if ((++_sp & 255u) == 0u) { if (xb_ld(&(bar)[XB_TMO])) break; if (_sp > XB_SPIN_CAP) { atomicAdd(&(bar)[XB_TMO], 1u); break; } } } } while (0)

struct XcdBarrier {
    unsigned* bar; unsigned x;
    volatile LAS unsigned* st;
};

__device__ __forceinline__ XcdBarrier xcd_barrier_post(unsigned* bar, volatile LAS unsigned* st) {
    XcdBarrier b; b.bar = bar; b.x = xb_xcc_id(); b.st = st;
    if (threadIdx.x == 0) (void)xb_add(&bar[XB_XCNT(b.x)], 1u);
    return b;
}
__device__ __forceinline__ void xcd_barrier_complete(unsigned* bar, unsigned x, unsigned& nloc, unsigned& nx) {
    const unsigned G = gridDim.x * gridDim.y * gridDim.z;
    unsigned sum, cnt, mine, sp = 0u;
    for (;;) {
        sum = 0u; cnt = 0u; mine = 0u;
#pragma unroll
        for (unsigned j = 0; j < 16; ++j) { const unsigned c = xb_ld(&bar[XB_XCNT(j)]); sum += c; cnt += (c > 0u) ? 1u : 0u; mine = (j == x) ? c : mine; }
        if (sum == G) break;
        __builtin_amdgcn_s_sleep(1);
        if ((++sp & 255u) == 0u) { if (xb_ld(&bar[XB_TMO])) break; if (sp > XB_SPIN_CAP) { atomicAdd(&bar[XB_TMO], 1u); break; } }
    }
    nloc = mine > 0u ? mine : 1u; nx = cnt > 0u ? cnt : 1u;
}

__device__ __forceinline__ void xcd_barrier(const XcdBarrier& b) {
    asm volatile("s_waitcnt vmcnt(0)" ::: "memory");
    __syncthreads();
    if (threadIdx.x == 0) {
        unsigned* bar = b.bar;
        __builtin_amdgcn_s_waitcnt(0);
        unsigned nloc = b.st[0], nx = b.st[1];
        if (nloc == 0u) { xcd_barrier_complete(bar, b.x, nloc, nx); b.st[0] = nloc; b.st[1] = nx; }
        const unsigned old = xb_add(&bar[XB_XSUB(b.x)], 1u);
        const unsigned gen = old / nloc;
        if (old + 1u == (gen + 1u) * nloc) {
            __builtin_amdgcn_fence(__ATOMIC_RELEASE, "agent");
            asm volatile("s_waitcnt vmcnt(0)" ::: "memory");
            const unsigned og = xb_add(&bar[XB_TOP], 1u);
            const unsigned tg = og / nx;
            if (og + 1u == (tg + 1u) * nx) xb_add(&bar[XB_TOPGEN], 1u);
            else XB_SPIN(xb_ld(&bar[XB_TOPGEN]) == tg, bar);
            __builtin_amdgcn_fence(__ATOMIC_ACQUIRE, "agent");
            xb_add(&bar[XB_XGEN(b.x)], 1u);
            asm volatile("s_waitcnt vmcnt(0)" ::: "memory");
        } else {
            XB_SPIN(xb_ld(&bar[XB_XGEN(b.x)]) == gen, bar);
            __builtin_amdgcn_fence(__ATOMIC_ACQUIRE, "agent");
            asm volatile("s_waitcnt vmcnt(0)" ::: "memory");
        }
    }
    __syncthreads();
}

#define XB_SPIN_TIGHT(cond, bar) do { unsigned _sp = 0; while (cond) { \
    if ((++_sp & 255u) == 0u) { if (xb_ld(&(bar)[XB_TMO])) break; if (_sp > XB_SPIN_CAP) { atomicAdd(&(bar)[XB_TMO], 1u); break; } } } } while (0)
#define XB_MISMATCH 192
__device__ __forceinline__ void xcd_local_barrier(const XcdBarrier& b) {
    asm volatile("s_waitcnt vmcnt(0)" ::: "memory");
    __syncthreads();
    if (threadIdx.x == 0) {
        unsigned* bar = b.bar;
        __builtin_amdgcn_s_waitcnt(0);
        const unsigned nloc = b.st[0];
        const unsigned old = xb_add(&bar[XB_XSUB(b.x)], 1u);
        const unsigned gen = old / nloc;
        if (old + 1u == (gen + 1u) * nloc) xb_add(&bar[XB_XGEN(b.x)], 1u);
        else XB_SPIN_TIGHT(xb_ld(&bar[XB_XGEN(b.x)]) == gen, bar);
        __builtin_amdgcn_fence(__ATOMIC_ACQUIRE, "agent");
        asm volatile("s_waitcnt vmcnt(0)" ::: "memory");
    }
    __syncthreads();
}

__device__ __forceinline__ void xcd_barrier_arrive(const XcdBarrier& b) {
    asm volatile("s_waitcnt vmcnt(0)" ::: "memory");
    __syncthreads();
    if (threadIdx.x == 0) {
        unsigned* bar = b.bar;
        __builtin_amdgcn_s_waitcnt(0);
        unsigned nloc = b.st[0], nx = b.st[1];
        if (nloc == 0u) { xcd_barrier_complete(bar, b.x, nloc, nx); b.st[0] = nloc; b.st[1] = nx; }
        const unsigned old = xb_add(&bar[XB_XSUB(b.x)], 1u);
        const unsigned gen = old / nloc;
        if (old + 1u == (gen + 1u) * nloc) {
            __builtin_amdgcn_fence(__ATOMIC_RELEASE, "agent");
            asm volatile("s_waitcnt vmcnt(0)" ::: "memory");
            const unsigned og = xb_add(&bar[XB_TOP], 1u);
            const unsigned tg = og / nx;
            if (og + 1u == (tg + 1u) * nx) xb_add(&bar[XB_TOPGEN], 1u);
            xb_add(&bar[XB_XGEN(b.x)], 1u);
        } else {
            XB_SPIN_TIGHT(xb_ld(&bar[XB_XGEN(b.x)]) == gen, bar);
        }
        __builtin_amdgcn_fence(__ATOMIC_ACQUIRE, "agent");
        asm volatile("s_waitcnt vmcnt(0)" ::: "memory");
    }
    __syncthreads();
}
__device__ __forceinline__ void xcd_barrier_wait_top(const XcdBarrier& b, unsigned target) {
    if (threadIdx.x == 0) {
        unsigned* bar = b.bar;
        XB_SPIN_TIGHT(xb_ld(&bar[XB_TOPGEN]) < target, bar);
        __builtin_amdgcn_fence(__ATOMIC_ACQUIRE, "agent");
        asm volatile("s_waitcnt vmcnt(0)" ::: "memory");
    }
    __syncthreads();
}

constexpr size_t WS_BAR = 22 * MiB + 256 * 1024;
constexpr int LDS_ST_OFF = 147392;

__device__ __forceinline__ XcdBarrier mkbar(const Args& a, LAS unsigned char* lds) { XcdBarrier b; b.bar = (unsigned*)(a.ws + WS_BAR); b.x = xb_xcc_id(); b.st = (volatile LAS unsigned*)(lds + LDS_ST_OFF); return b; }

struct EpiFinal {
    static constexpr bool PERM = true, AFTER_DRAIN = true;
    const bf16* x1b; float* out; float* ss; const float* gfin; unsigned char* wsb; int fast;
    __device__ __forceinline__ void fused(const f32x4 (&acc)[2][2][4][2], const pg8::Unit& u, int wr, int wc, int fr, int fq, LAS unsigned char* lds, int wid, int lane) const {
        const int row0 = u.pm * 256 + wr * 64 + fr, col0 = u.pn * 256 + 32 * wc + 8 * fq;
        f32x4 v[2][4][2][2];
#pragma unroll
        for (int ai = 0; ai < 2; ++ai)
#pragma unroll
            for (int m = 0; m < 4; ++m) { const int row = row0 + ai * 128 + m * 16; float s = 0.f;
#pragma unroll
                for (int bj = 0; bj < 2; ++bj) { const size_t off = (size_t)row * 1024 + col0 + bj * 128;
                    const u32x4 r = *(const u32x4*)(x1b + off);
                    const f32x4 v0 = (f32x4){bflo(r.x), bfhi(r.x), bflo(r.y), bfhi(r.y)} + acc[ai][bj][m][0], v1 = (f32x4){bflo(r.z), bfhi(r.z), bflo(r.w), bfhi(r.w)} + acc[ai][bj][m][1];
                    v[ai][m][bj][0] = v0; v[ai][m][bj][1] = v1;
                    s += (v0.x * v0.x + v0.y * v0.y) + (v0.z * v0.z + v0.w * v0.w) + (v1.x * v1.x + v1.y * v1.y) + (v1.z * v1.z + v1.w * v1.w); }
                s = fq_sum(s);
                if (fq == 0) ss[(size_t)row * 16 + u.pn * 4 + wc] = s; }
        { XcdBarrier b; b.bar = (unsigned*)(wsb + WS_BAR); b.x = xb_xcc_id(); b.st = (volatile LAS unsigned*)(lds + LDS_ST_OFF); if (fast) xcd_local_barrier(b); else xcd_barrier(b); }
        f32x4 g[2][2];
#pragma unroll
        for (int bj = 0; bj < 2; ++bj) { g[bj][0] = *(const f32x4*)(gfin + col0 + bj * 128); g[bj][1] = *(const f32x4*)(gfin + col0 + bj * 128 + 4); }
#pragma unroll
        for (int ai = 0; ai < 2; ++ai)
#pragma unroll
            for (int m = 0; m < 4; ++m) { const int row = row0 + ai * 128 + m * 16;
                const float rs = 1.f / sqrtf(sum16(ss + (size_t)row * 16) * (1.f / DM) + EPS);
#pragma unroll
                for (int bj = 0; bj < 2; ++bj) { const size_t off = (size_t)row * 1024 + col0 + bj * 128;
                    *(f32x4*)(out + off) = v[ai][m][bj][0] * rs * g[bj][0]; *(f32x4*)(out + off + 4) = v[ai][m][bj][1] * rs * g[bj][1]; } }
    }
};

#ifndef PH
#define PH 0xFF
#endif
__global__ void __launch_bounds__(512, 2) fwd_megakernel(Args a) {
    extern __shared__ __attribute__((aligned(16))) unsigned char lds_raw[];
    LAS unsigned char* lds = (LAS unsigned char*)lds_raw;
    cg::grid_group grid = cg::this_grid();
    unsigned char* ws = a.ws;
    const int G = gridDim.x, bid = blockIdx.x;

    volatile LAS unsigned* st = (volatile LAS unsigned*)(lds + LDS_ST_OFF);
    unsigned* barw = (unsigned*)(ws + WS_BAR);
    if (threadIdx.x < 4) st[threadIdx.x] = 0u;
    __syncthreads();
    (void)xcd_barrier_post(barw, st);
    if (threadIdx.x == 0) atomicOr(barw + 64 + (bid & 7), 1u << xb_xcc_id());
    if (a.use_cg_sync) grid.sync();
#if (PH >> 0) & 1
    p0_prep<0>(a, lds);
#endif
    xcd_barrier_arrive(mkbar(a, lds));
#if (PH >> 0) & 1
    p0_prep<1>(a, lds);
#endif
    xcd_barrier_wait_top(mkbar(a, lds), 1u);
    bool fast = (G == 256);
#pragma unroll
    for (int g8 = 0; g8 < 8; ++g8) { const unsigned m = (unsigned)__builtin_amdgcn_readfirstlane((int)xb_ld(barw + 64 + g8)); fast = fast && (m != 0u) && ((m & (m - 1u)) == 0u); }
#ifdef PROBE_FAST
    if (!fast) return;
#endif
#define LOCAL_BAR() do { if (fast) xcd_local_barrier(mkbar(a, lds)); else xcd_barrier(mkbar(a, lds)); } while (0)
#ifdef DUP_BAR
#define GRID_BAR() do { xcd_barrier(mkbar(a, lds)); xcd_barrier(mkbar(a, lds)); } while (0)
#else
#define GRID_BAR() xcd_barrier(mkbar(a, lds))
#endif
#if (PH >> 1) & 1
    {
        pg8::Gemm g{(const bf16*)(ws + WS_XB), (const bf16*)(ws + WS_W0T), MTOK, 5120, 1024}; pg8::StaticOrder S; S.init(MTOK, 5120, G, bid);
        EpiIn0 E{(const float*)(ws + WS_R0), (bf16*)(ws + WS_UG), (bf16*)(ws + WS_GV), (bf16*)(ws + WS_BX), (bf16*)(ws + WS_BG), (float*)(ws + WS_VSS)};
        pg8::gemm_phase<EpiIn0, pg8::StaticOrder, true, true>(lds, g, S, E);
    }
#endif
    if (fast) xcd_barrier_arrive(mkbar(a, lds)); else xcd_barrier(mkbar(a, lds));
#if (PH >> 2) & 1
    {
        u32x4 pf[9];
        int tid_ = threadIdx.x; asm volatile("" : "+v"(tid_));
        int kind = 0, idx = bid;
        if (idx >= 512) kind = 2;
        issue_next(a, kind, idx, tid_, pf);
        while (kind < 2) {
            int nkind = kind, nidx = idx + G;
            if (nidx >= 512) { nkind = kind + 1; nidx = bid; }
            if (fast && kind == 0 && nkind == 1) xcd_barrier_wait_top(mkbar(a, lds), 2u);
            if (kind == 0) mixer_a_unit(a, lds, unit_tile(idx), unit_grp(idx), pf, nkind, nidx);
            else           mixer_b_unit(a, lds, unit_tile(idx), unit_grp(idx), pf, nkind, nidx);
            kind = nkind; idx = nidx;
        }
    }
#endif
    LOCAL_BAR();
#if (PH >> 3) & 1
    {
        pg8::Gemm g{(const bf16*)a.out, (const bf16*)(ws + WS_WO0T), MTOK, 1024, 2048}; pg8::StaticOrder S; S.init(MTOK, 1024, G, bid);
        typedef EpiRes<true, false, true> Epi3;
        Epi3 E{(const void*)(ws + WS_XB), nullptr, (bf16*)(ws + WS_XB), (float*)(ws + WS_SS1)};
        pg8::gemm_phase<Epi3, pg8::StaticOrder, true, true>(lds, g, S, E);
#ifdef DUP_G2
        pg8::gemm_phase<Epi3, pg8::StaticOrder, true, true>(lds, g, S, E);
#endif
    }
#endif
    LOCAL_BAR();
#if (PH >> 4) & 1
    {
        pg8::Gemm g{(const bf16*)(ws + WS_XB), (const bf16*)(ws + WS_W1T), MTOK, 2560, 1024}; pg8::StaticOrder S; S.init(MTOK, 2560, G, bid);
        EpiIn1 E{(const float*)(ws + WS_SS1), (const unsigned*)(ws + WS_ROPE), (bf16*)(ws + WS_Q), (bf16*)(ws + WS_K), (bf16*)(ws + WS_VT), (bf16*)(ws + WS_G)};
        pg8::gemm_phase<EpiIn1, pg8::StaticOrder, true, true>(lds, g, S, E);
#ifdef DUP_G3
        pg8::gemm_phase<EpiIn1, pg8::StaticOrder, true, true>(lds, g, S, E);
#endif
    }
#endif
    GRID_BAR();
#if (PH >> 5) & 1
#ifndef DUP_ATT
#define DUP_ATT 1
#endif
    {
        u32x4 kr[6], vr[6];
        int tid_ = threadIdx.x; asm volatile("" : "+v"(tid_));
        attn_issue(a, bid, tid_, kr, vr);
        for (int u = bid; u < 512; u += G) attn_unit(a, lds, unit_tile(u) >> 6, unit_tile(u) & 63, unit_grp(u), kr, vr, u + G);
    }
#endif
    LOCAL_BAR();
#if (PH >> 6) & 1
    if (G == 256) {
        pg8::Gemm g{(const bf16*)(ws + WS_Y1), (const bf16*)(ws + WS_WO1T), MTOK, 1024, 1024}; pg8::StaticOrder S; S.init(MTOK, 1024, G, bid);
        EpiFinal E{(const bf16*)(ws + WS_XB), a.out, (float*)(ws + WS_SS2), a.in[13], a.ws, fast ? 1 : 0};
        pg8::gemm_phase<EpiFinal, pg8::StaticOrder, false, true>(lds, g, S, E);
#ifdef DUP_G4
        pg8::gemm_phase<EpiFinal, pg8::StaticOrder, false, true>(lds, g, S, E);
#endif
    } else {
        {
            pg8::Gemm g{(const bf16*)(ws + WS_Y1), (const bf16*)(ws + WS_WO1T), MTOK, 1024, 1024}; pg8::StaticOrder S; S.init(MTOK, 1024, G, bid);
            typedef EpiRes<true, true, false> Epi6;
            Epi6 E{(const void*)(ws + WS_XB), a.out, nullptr, (float*)(ws + WS_SS2)};
            pg8::gemm_phase<Epi6, pg8::StaticOrder, true, true>(lds, g, S, E);
        }
        GRID_BAR();
        int tid_ = threadIdx.x; asm volatile("" : "+v"(tid_));
        const int tid = tid_, lane = tid & 63, wave = __builtin_amdgcn_readfirstlane(tid >> 6), gw = bid * 8 + wave, NGW = G * 8;
        const float* ss2 = (const float*)(ws + WS_SS2); const f32x4* fn = (const f32x4*)a.in[13] + lane;
        f32x4 gn[4];
#pragma unroll
        for (int j = 0; j < 4; ++j) gn[j] = fn[64 * j];
        for (int m = gw; m < MTOK; m += NGW) {
            const float rs = 1.f / sqrtf(sum16(ss2 + (size_t)m * 16) * (1.f / DM) + EPS);
            f32x4* xr = (f32x4*)(a.out + (size_t)m * DM) + lane;
#pragma unroll
            for (int j = 0; j < 4; ++j) xr[64 * j] = xr[64 * j] * rs * gn[j];
        }
    }
#endif
}

extern "C" void kernel_launch(void* const* d_in, const int* in_sizes, int n_in, void* d_out, int out_size, void* d_ws, size_t ws_size, hipStream_t stream) {
    static int grid = 0;
    if (grid == 0) {
        if (n_in != 14 || out_size != MTOK * DM || ws_size < WS_END) { fprintf(stderr, "kernel_launch: unexpected problem shape (n_in %d out %d ws %zu)\n", n_in, out_size, ws_size); grid = -1; return; }
        int dev = 0, cus = 0, per_cu = 0;
        hipGetDevice(&dev);
        hipDeviceGetAttribute(&cus, hipDeviceAttributeMultiprocessorCount, dev);
        if (hipFuncSetAttribute((const void*)fwd_megakernel, hipFuncAttributeMaxDynamicSharedMemorySize, LDS_BYTES) != hipSuccess) { fprintf(stderr, "kernel_launch: hipFuncSetAttribute failed\n"); grid = -1; return; }
        if (hipOccupancyMaxActiveBlocksPerMultiprocessor(&per_cu, (const void*)fwd_megakernel, 512, LDS_BYTES) != hipSuccess || per_cu < 1) { fprintf(stderr, "kernel_launch: occupancy query failed (%d)\n", per_cu); (void)hipGetLastError(); grid = -1; return; }
        grid = cus * per_cu;
    }
    if (grid < 0) return;
    if (hipMemsetAsync((char*)d_ws + WS_BAR, 0, XCD_BAR_WORDS * 4, stream) != hipSuccess) { fprintf(stderr, "kernel_launch: hipMemsetAsync failed\n"); return; }
    Args a{};
    for (int i = 0; i < 14; ++i) a.in[i] = (const float*)d_in[i];
    a.out = (float*)d_out; a.ws = (unsigned char*)d_ws;
    void* args[] = {&a};
    hipError_t e = hipLaunchCooperativeKernel((const void*)fwd_megakernel, dim3(grid), dim3(512), args, LDS_BYTES, stream);
    if (e != hipSuccess) fprintf(stderr, "kernel_launch: cooperative launch failed: %s (grid %d)\n", hipGetErrorString(e), grid);
}
```
